# Optimizing an MI355X kernel written in HIP

```python
import math
import jax, jax.numpy as jnp
from jax import lax
import numpy as np

D_MODEL = 2048
BATCH = 4
SEQ = 2048
DEPTH = 1

D_MIX = D_MODEL
HEAD_DIM = 128
ATTN_WIDTH = D_MIX // 2
N_Q_HEADS = ATTN_WIDTH // HEAD_DIM
N_KV_HEADS = 2
KV_GROUP = N_Q_HEADS // N_KV_HEADS
HGRN_WIDTH = D_MIX - ATTN_WIDTH
HGRN_EXPAND = 128
N_HGRN_HEADS = HGRN_WIDTH // HGRN_EXPAND
HGRN_CHUNK = 64
Q_BLOCK = 128
GRID_W = 64
ROPE_THETA = 10000.0
ROPE_AXIS_DIM = HEAD_DIM // 2
N_EXPERTS = 32
TOP_K = 4
D_EXPERT = D_MODEL
SWIGLU_LIMIT = 7.0
SWIGLU_ALPHA = 1.702
EXPERT_BLOCK = 128
NORM_EPS = 1e-6
DEEPNORM_ALPHA = (2 * DEPTH) ** 0.25
DEEPNORM_BETA = (8 * DEPTH) ** -0.25
PROJ_SIZES = (ATTN_WIDTH, N_KV_HEADS * HEAD_DIM, N_KV_HEADS * HEAD_DIM,
              HGRN_WIDTH, HGRN_WIDTH, HGRN_WIDTH, HGRN_WIDTH, HGRN_WIDTH)
PROJ_WIDTH = sum(PROJ_SIZES)
PROJ_OFFSETS = tuple(int(o) for o in np.cumsum(PROJ_SIZES)[:-1])

kernel_name = "hymba_attn_hgrn2_gptoss_moe_deepnorm_adaln"


def layer_norm(x, g=None, b=None):
    xf = x.astype(jnp.float32)
    mu = jnp.mean(xf, axis=-1, keepdims=True)
    var = jnp.mean(jnp.square(xf - mu), axis=-1, keepdims=True)
    y = (xf - mu) * lax.rsqrt(var + NORM_EPS)
    if g is not None:
        y = y * g.astype(jnp.float32) + b.astype(jnp.float32)
    return y.astype(x.dtype)


def rms_norm(x, w):
    xf = x.astype(jnp.float32)
    y = xf * lax.rsqrt(jnp.mean(jnp.square(xf), axis=-1, keepdims=True) + NORM_EPS)
    return (y * w.astype(jnp.float32)).astype(x.dtype)


def modulate(h, shift, scale):
    return h * (1.0 + scale[:, None, :]) + shift[:, None, :]


def axial_angles(seq_len):
    rows = seq_len // GRID_W
    t = jnp.arange(seq_len, dtype=jnp.int32)
    row = (t // GRID_W - rows // 2).astype(jnp.float32)
    col = (t % GRID_W - GRID_W // 2).astype(jnp.float32)
    inv_freq = ROPE_THETA ** (-jnp.arange(0, ROPE_AXIS_DIM, 2, dtype=jnp.float32) / ROPE_AXIS_DIM)
    return row[:, None] * inv_freq[None, :], col[:, None] * inv_freq[None, :]


def rotate(xh, ang):
    c = jnp.cos(ang)[:, None, :]
    s = jnp.sin(ang)[:, None, :]
    x1, x2 = jnp.split(xh, 2, axis=-1)
    return jnp.concatenate([x1 * c - x2 * s, x2 * c + x1 * s], axis=-1)


def apply_axial_rope(x, ang_row, ang_col):
    xf = x.astype(jnp.float32)
    out = jnp.concatenate([rotate(xf[..., :ROPE_AXIS_DIM], ang_row),
                           rotate(xf[..., ROPE_AXIS_DIM:], ang_col)], axis=-1)
    return out.astype(x.dtype)


def block_attention(q, k, v):
    B, HKV, G, S, D = q.shape
    n_blocks = S // Q_BLOCK
    scale = 1.0 / math.sqrt(D)
    qb = q.reshape(B, HKV, G, n_blocks, Q_BLOCK, D).transpose(3, 0, 1, 2, 4, 5)

    def one_block(q_blk):
        s = jnp.einsum('bkgqd,bksd->bkgqs', q_blk, k, preferred_element_type=jnp.float32) * scale
        p = jax.nn.softmax(s, axis=-1)
        return jnp.einsum('bkgqs,bksd->bkgqd', p.astype(v.dtype), v)

    ob = lax.map(one_block, qb)
    return ob.transpose(1, 2, 3, 0, 4, 5).reshape(B, HKV * G, S, D)


def gla_chunked(q, k, v, log_f):
    B, H, S, DK = q.shape
    DV = v.shape[-1]
    nc = S // HGRN_CHUNK
    q, k, v, log_f = (t.reshape(B, H, nc, HGRN_CHUNK, t.shape[-1]) for t in (q, k, v, log_f))
    b = jnp.cumsum(log_f, axis=3)
    b_last = b[:, :, :, -1:, :]
    q_dec = q * jnp.exp(b)
    scores = jnp.einsum('bhnid,bhnjd->bhnij', q_dec, k * jnp.exp(-b))
    mask = jnp.tril(jnp.ones((HGRN_CHUNK, HGRN_CHUNK), dtype=bool))
    intra = jnp.einsum('bhnij,bhnje->bhnie', jnp.where(mask, scores, 0.0), v)
    u = jnp.einsum('bhncd,bhnce->bhnde', k * jnp.exp(b_last - b), v)
    decay = jnp.exp(b_last[:, :, :, 0, :])

    def step(state, inp):
        dec, uu = inp
        return dec[..., None] * state + uu, state

    _, s_prev = lax.scan(step, jnp.zeros((B, H, DK, DV), jnp.float32),
                         (jnp.moveaxis(decay, 2, 0), jnp.moveaxis(u, 2, 0)))
    s_prev = jnp.moveaxis(s_prev, 0, 2)
    inter = jnp.einsum('bhncd,bhnde->bhnce', q_dec, s_prev)
    return (intra + inter).reshape(B, H, S, DV)


def token_mixer(h, w_in, q_norm_w, k_norm_w, attn_norm_w, hgrn_lb, hgrn_norm_w, w_out, layer_idx):
    B, S, _ = h.shape
    proj = jnp.einsum('bsd,dp->bsp', h, w_in)
    q, k, v, q_r, f_fw, f_bw, i_in, g_out = jnp.split(proj, PROJ_OFFSETS, axis=-1)

    q = rms_norm(q.reshape(B, S, N_Q_HEADS, HEAD_DIM), q_norm_w)
    k = rms_norm(k.reshape(B, S, N_KV_HEADS, HEAD_DIM), k_norm_w)
    v = v.reshape(B, S, N_KV_HEADS, HEAD_DIM)
    ang_row, ang_col = axial_angles(S)
    q = apply_axial_rope(q, ang_row, ang_col)
    k = apply_axial_rope(k, ang_row, ang_col)
    q = q.transpose(0, 2, 1, 3).reshape(B, N_KV_HEADS, KV_GROUP, S, HEAD_DIM)
    o_attn = block_attention(q, k.transpose(0, 2, 1, 3), v.transpose(0, 2, 1, 3))
    o_attn = rms_norm(o_attn, attn_norm_w.reshape(N_Q_HEADS, 1, HEAD_DIM))
    o_attn = o_attn.transpose(0, 2, 1, 3).reshape(B, S, ATTN_WIDTH)

    def to_heads(t):
        return t.reshape(B, S, N_HGRN_HEADS, HGRN_EXPAND).transpose(0, 2, 1, 3).astype(jnp.float32)

    q_r = to_heads(jax.nn.silu(q_r))
    v_r = to_heads(i_in)
    lb = jnp.cumsum(jax.nn.softmax(hgrn_lb.astype(jnp.float32), axis=1), axis=1)[:, layer_idx]
    lb = lb.reshape(2, N_HGRN_HEADS, 1, HGRN_EXPAND)

    def gates(f_logit, lb_d):
        fg = lb_d + (1.0 - lb_d) * jax.nn.sigmoid(to_heads(f_logit))
        return 1.0 - fg, jnp.log(fg)

    k_fw, lf_fw = gates(f_fw, lb[0])
    k_bw, lf_bw = gates(f_bw, lb[1])
    flip = lambda t: jnp.flip(t, axis=2)
    o_r = gla_chunked(q_r, k_fw, v_r, lf_fw) + flip(
        gla_chunked(flip(q_r), flip(k_bw), flip(v_r), flip(lf_bw)))
    o_r = rms_norm(o_r, hgrn_norm_w.reshape(N_HGRN_HEADS, 1, HGRN_EXPAND))
    o_r = o_r.transpose(0, 2, 1, 3).reshape(B, S, HGRN_WIDTH) * jax.nn.silu(g_out.astype(jnp.float32))

    mixed = jnp.concatenate([o_attn.astype(h.dtype), o_r.astype(h.dtype)], axis=-1)
    return jnp.einsum('bsm,md->bsd', mixed, w_out)


def clamped_swiglu(hid):
    x_glu, x_lin = jnp.split(hid, 2, axis=-1)
    x_glu = jnp.minimum(x_glu, SWIGLU_LIMIT)
    x_lin = jnp.clip(x_lin, -SWIGLU_LIMIT, SWIGLU_LIMIT)
    return x_glu * jax.nn.sigmoid(SWIGLU_ALPHA * x_glu) * (x_lin + 1.0)


def moe_ffn(h, w_router, b_router, w1, b1, w2, b2):
    B, S, D = h.shape
    N = B * S
    A = N * TOP_K
    xf = h.reshape(N, D)
    logits = (xf @ w_router + b_router).astype(jnp.float32)
    top_v, top_i = lax.top_k(logits, TOP_K)
    gates = jax.nn.softmax(top_v, axis=-1)

    eid = top_i.reshape(A)
    tok = jnp.arange(A, dtype=jnp.int32) // TOP_K
    order = jnp.argsort(eid)
    e_s, tok_s, g_s = eid[order], tok[order], gates.reshape(A)[order]
    counts = jnp.zeros((N_EXPERTS,), jnp.int32).at[eid].add(1)
    padded = (counts + EXPERT_BLOCK - 1) // EXPERT_BLOCK * EXPERT_BLOCK
    start = jnp.cumsum(counts) - counts
    p_end = jnp.cumsum(padded)
    p_start = p_end - padded
    dest = p_start[e_s] + (jnp.arange(A, dtype=jnp.int32) - start[e_s])
    P = A + N_EXPERTS * EXPERT_BLOCK
    n_blocks = P // EXPERT_BLOCK
    buf_tok = jnp.full((P,), N, jnp.int32).at[dest].set(tok_s)
    buf_gate = jnp.zeros((P,), jnp.float32).at[dest].set(g_s)
    blk_start = jnp.arange(n_blocks, dtype=jnp.int32) * EXPERT_BLOCK
    blk_exp = jnp.minimum(jnp.sum(blk_start[:, None] >= p_end[None, :], axis=1), N_EXPERTS - 1)

    x_pad = jnp.concatenate([xf, jnp.zeros((1, D), xf.dtype)], axis=0)
    xb = x_pad[buf_tok].reshape(n_blocks, EXPERT_BLOCK, D)

    def expert_block(args):
        x_blk, e = args
        hid = x_blk @ w1[e] + b1[e]
        return clamped_swiglu(hid) @ w2[e] + b2[e]

    yb = lax.map(expert_block, (xb, blk_exp)).reshape(P, D)
    yb = yb * buf_gate[:, None].astype(yb.dtype)
    out = jnp.zeros((N + 1, D), yb.dtype).at[buf_tok].add(yb)[:N]
    return out.reshape(B, S, D)


def setup_inputs(seed: int = 0) -> dict:
    key = jax.random.key(seed)
    ks = jax.random.split(key, 21)
    f32 = jnp.float32

    def nrm(k, shape, s):
        return s * jax.random.normal(k, shape, f32)

    return {
        "x": nrm(ks[0], (BATCH, SEQ, D_MODEL), 1.0),
        "c": nrm(ks[1], (BATCH, D_MODEL), 1.0),
        "w_ada": nrm(ks[2], (DEPTH, D_MODEL, 6 * D_MODEL), D_MODEL ** -0.5),
        "b_ada": nrm(ks[3], (DEPTH, 6 * D_MODEL), 0.02),
        "w_in": nrm(ks[4], (DEPTH, D_MODEL, PROJ_WIDTH), D_MODEL ** -0.5),
        "q_norm_w": 1.0 + nrm(ks[5], (DEPTH, HEAD_DIM), 0.02),
        "k_norm_w": 1.0 + nrm(ks[6], (DEPTH, HEAD_DIM), 0.02),
        "attn_norm_w": 1.0 + nrm(ks[7], (DEPTH, ATTN_WIDTH), 0.02),
        "hgrn_lb": 1.0 + nrm(ks[8], (2, DEPTH + 1, HGRN_WIDTH), 0.1),
        "hgrn_norm_w": 1.0 + nrm(ks[9], (DEPTH, HGRN_WIDTH), 0.02),
        "w_out": nrm(ks[10], (DEPTH, D_MIX, D_MODEL), DEEPNORM_BETA * D_MIX ** -0.5),
        "ln1_g": 1.0 + nrm(ks[11], (DEPTH, D_MODEL), 0.02),
        "ln1_b": nrm(ks[12], (DEPTH, D_MODEL), 0.02),
        "w_router": nrm(ks[13], (DEPTH, D_MODEL, N_EXPERTS), D_MODEL ** -0.5),
        "b_router": nrm(ks[14], (DEPTH, N_EXPERTS), 0.01),
        "w_exp_in": nrm(ks[15], (DEPTH, N_EXPERTS, D_MODEL, 2 * D_EXPERT), D_MODEL ** -0.5),
        "b_exp_in": nrm(ks[16], (DEPTH, N_EXPERTS, 2 * D_EXPERT), 0.02),
        "w_exp_out": nrm(ks[17], (DEPTH, N_EXPERTS, D_EXPERT, D_MODEL), DEEPNORM_BETA * D_EXPERT ** -0.5),
        "b_exp_out": nrm(ks[18], (DEPTH, N_EXPERTS, D_MODEL), 0.02),
        "ln2_g": 1.0 + nrm(ks[19], (DEPTH, D_MODEL), 0.02),
        "ln2_b": nrm(ks[20], (DEPTH, D_MODEL), 0.02),
    }


def reference(x, c, w_ada, b_ada, w_in, q_norm_w, k_norm_w, attn_norm_w, hgrn_lb, hgrn_norm_w,
              w_out, ln1_g, ln1_b, w_router, b_router, w_exp_in, b_exp_in, w_exp_out, b_exp_out,
              ln2_g, ln2_b):
    c_act = jax.nn.silu(c)
    for l in range(DEPTH):
        mod = c_act @ w_ada[l] + b_ada[l]
        sh1, sc1, g1, sh2, sc2, g2 = jnp.split(mod, 6, axis=-1)
        h = modulate(layer_norm(x), sh1, sc1)
        y = token_mixer(h, w_in[l], q_norm_w[l], k_norm_w[l], attn_norm_w[l], hgrn_lb,
                        hgrn_norm_w[l], w_out[l], l)
        x = layer_norm(DEEPNORM_ALPHA * x + g1[:, None, :] * y, ln1_g[l], ln1_b[l])
        h = modulate(layer_norm(x), sh2, sc2)
        y = moe_ffn(h, w_router[l], b_router[l], w_exp_in[l], b_exp_in[l], w_exp_out[l], b_exp_out[l])
        x = layer_norm(DEEPNORM_ALPHA * x + g2[:, None, :] * y, ln2_g[l], ln2_b[l])
    return x
```

```cpp
#include <hip/hip_runtime.h>
#include <cstdio>
#include <cstdint>

#ifndef MK_SPLIT
#define MK_SPLIT 0
#endif

#define GAS __attribute__((address_space(1)))
#define LAS __attribute__((address_space(3)))
typedef unsigned short bf16_t;
typedef short bf16x8 __attribute__((ext_vector_type(8)));
typedef short s16x4 __attribute__((ext_vector_type(4)));
typedef float f32x2 __attribute__((ext_vector_type(2)));
typedef float f32x4 __attribute__((ext_vector_type(4)));
typedef float f32x16 __attribute__((ext_vector_type(16)));
typedef unsigned u32x2 __attribute__((ext_vector_type(2)));
typedef unsigned u32x4 __attribute__((ext_vector_type(4)));

constexpr int DM = 2048, NBATCH = 4, SEQ = 2048, MTOK = NBATCH * SEQ;
constexpr int PW = 6656;
constexpr int C_Q = 0, C_K = 1024, C_V = 1280, C_QR = 1536, C_FF = 2560, C_FB = 3584, C_IN = 4608, C_GO = 5632;
constexpr int NE = 32, TOPK = 4;
constexpr int ECAP = 8192, ECAP_TILES = ECAP / 256, MAXROWS = NE * ECAP;
constexpr float EPS = 1e-6f;
constexpr float DN_ALPHA = 1.189207115002721f;
constexpr int NWAVES = 8, NTHR = 512;

constexpr size_t MiB = 1u << 20;
constexpr size_t WS_CTL = 0, CTL_ZERO_BYTES = 64 * 1024;
constexpr size_t WS_MODP = 1 * MiB;
constexpr size_t WS_MOD = 3 * MiB;
constexpr size_t WS_ROUTE = 4 * MiB;
constexpr size_t WS_WRT = 6 * MiB;
constexpr size_t WS_WIN_T = 8 * MiB;
constexpr size_t WS_WOUT_T = 34 * MiB;
constexpr size_t WS_W1T = 64 * MiB;
constexpr size_t WS_W2T = 576 * MiB;
constexpr size_t WS_H = 832 * MiB;
constexpr size_t WS_H2 = 864 * MiB;
constexpr size_t WS_PROJ = 928 * MiB;
constexpr size_t WS_KV = 1032 * MiB;
constexpr size_t WS_UT = 1040 * MiB;
constexpr size_t WS_DECAY = 1168 * MiB;
constexpr size_t WS_SPREV = 1170 * MiB;
constexpr size_t WS_MIXED = 1234 * MiB;
constexpr size_t WS_Y1 = 1266 * MiB;
constexpr size_t WS_X1 = 1330 * MiB;
constexpr size_t WS_XS = 1394 * MiB;
constexpr size_t WS_ACT = 1906 * MiB;
constexpr size_t WS_YB = 2418 * MiB;
constexpr size_t WS_END = 3442 * MiB;
constexpr size_t CTL_ECNT = 32768;
constexpr size_t RT_TOKE = 0, RT_TOKG = 128 * 1024, RT_TOKR = 256 * 1024, RT_SLOT = 384 * 1024, RT_HIST = 512 * 1024, RT_SGATE = 576 * 1024;

constexpr int LDS_CTL_OFF = 156672, LDS_TAB_OFF = LDS_CTL_OFF + 256, LDS_BYTES = LDS_CTL_OFF + 2048;

__device__ __forceinline__ unsigned cvt_pk_bf16(float lo, float hi) { unsigned r; asm volatile("v_cvt_pk_bf16_f32 %0, %1, %2" : "=v"(r) : "v"(lo), "v"(hi)); return r; }
typedef __bf16 bf16x2_native __attribute__((ext_vector_type(2)));
__device__ __forceinline__ unsigned cvt_pk_bf16_safe(float lo, float hi) { const f32x2 v = {lo, hi}; const bf16x2_native r = __builtin_convertvector(v, bf16x2_native); return __builtin_bit_cast(unsigned, r); }
__device__ __forceinline__ float bf2f(unsigned short h) { return __uint_as_float((unsigned)h << 16); }
__device__ __forceinline__ float bflo(unsigned w) { return __uint_as_float(w << 16); }
__device__ __forceinline__ float bfhi(unsigned w) { return __uint_as_float(w & 0xffff0000u); }
__device__ __forceinline__ unsigned short f2bf(float f) { return (unsigned short)(cvt_pk_bf16(f, 0.f) & 0xffffu); }
__device__ __forceinline__ unsigned pk4_fp8(float a, float b, float c, float d) { int w = __builtin_amdgcn_cvt_pk_fp8_f32(a, b, 0, false); w = __builtin_amdgcn_cvt_pk_fp8_f32(c, d, w, true); return (unsigned)w; }
constexpr float W_SCALE = 64.f, ACT_SCALE = 4.f, YB_SCALE = 16.f;
__device__ __forceinline__ float wave_sum(float v) {
#pragma unroll
    for (int o = 1; o < 64; o <<= 1) v += __shfl_xor(v, o);
    return v;
}
__device__ __forceinline__ float fast_sigmoid(float x) { return __builtin_amdgcn_rcpf(1.f + __builtin_amdgcn_exp2f(-1.4426950408889634f * x)); }
__device__ __forceinline__ float fexp(float x) { return __builtin_amdgcn_exp2f(1.4426950408889634f * x); }
__device__ __forceinline__ float flog(float x) { return 0.6931471805599453f * __builtin_amdgcn_logf(x); }

#define XB_TMO      128
#define XB_XCNT(j)  (256  + 64 * (j))
#define XB_XSUB(j)  (1280 + 64 * (j))
#define XB_XGEN(j)  (2304 + 64 * (j))
#define XB_TOP      3328
#define XB_TOPGEN   3392
#define XCD_BAR_WORDS 3456
#define XB_SPIN_CAP (1u << 18)
__device__ __forceinline__ unsigned xb_ld(unsigned* p)              { return __hip_atomic_load(p, __ATOMIC_RELAXED, __HIP_MEMORY_SCOPE_AGENT); }
__device__ __forceinline__ unsigned xb_add(unsigned* p, unsigned v) { return __hip_atomic_fetch_add(p, v, __ATOMIC_RELAXED, __HIP_MEMORY_SCOPE_AGENT); }
__device__ __forceinline__ unsigned xb_xcc_id() { return (unsigned)__builtin_amdgcn_s_getreg((3 << 11) | 20) & 0xFu; }
#define XB_SPIN(cond, bar) do { unsigned _sp = 0; while (cond) { __builtin_amdgcn_s_sleep(1); \
    if ((++_sp & 255u) == 0u) { if (xb_ld(&(bar)[XB_TMO])) break; if (_sp > XB_SPIN_CAP) { atomicAdd(&(bar)[XB_TMO], 1u); break; } } } } while (0)
struct XcdBarrier { unsigned* bar; unsigned x; volatile LAS unsigned* st; };
__device__ __forceinline__ XcdBarrier xcd_barrier_post(unsigned* bar, volatile LAS unsigned* st) {
    XcdBarrier b; b.bar = bar; b.x = xb_xcc_id(); b.st = st;
    if (threadIdx.x == 0) (void)xb_add(&bar[XB_XCNT(b.x)], 1u);
    return b;
}
__device__ __forceinline__ void xcd_barrier_complete(unsigned* bar, unsigned x, unsigned& nloc, unsigned& nx) {
    const unsigned G = gridDim.x * gridDim.y * gridDim.z;
    unsigned sum, cnt, mine, sp = 0u;
    for (;;) {
        sum = 0u; cnt = 0u; mine = 0u;
#pragma unroll
        for (unsigned j = 0; j < 16; ++j) { const unsigned c = xb_ld(&bar[XB_XCNT(j)]); sum += c; cnt += (c > 0u) ? 1u : 0u; mine = (j == x) ? c : mine; }
        if (sum == G) break;
        __builtin_amdgcn_s_sleep(1);
        if ((++sp & 255u) == 0u) { if (xb_ld(&bar[XB_TMO])) break; if (sp > XB_SPIN_CAP) { atomicAdd(&bar[XB_TMO], 1u); break; } }
    }
    nloc = mine > 0u ? mine : 1u; nx = cnt > 0u ? cnt : 1u;
}
__device__ __forceinline__ void xcd_barrier(const XcdBarrier& b) {
    asm volatile("s_waitcnt vmcnt(0)" ::: "memory");
    __syncthreads();
    if (threadIdx.x == 0) {
        unsigned* bar = b.bar;
        __builtin_amdgcn_s_waitcnt(0);
        unsigned nloc = b.st[0], nx = b.st[1];
        if (nloc == 0u) { xcd_barrier_complete(bar, b.x, nloc, nx); b.st[0] = nloc; b.st[1] = nx; }
        const unsigned old = xb_add(&bar[XB_XSUB(b.x)], 1u);
        const unsigned gen = old / nloc;
        if (old + 1u == (gen + 1u) * nloc) {
            __builtin_amdgcn_fence(__ATOMIC_RELEASE, "agent");
            asm volatile("s_waitcnt vmcnt(0)" ::: "memory");
            const unsigned og = xb_add(&bar[XB_TOP], 1u);
            const unsigned tg = og / nx;
            if (og + 1u == (tg + 1u) * nx) xb_add(&bar[XB_TOPGEN], 1u);
            else XB_SPIN(xb_ld(&bar[XB_TOPGEN]) == tg, bar);
            __builtin_amdgcn_fence(__ATOMIC_ACQUIRE, "agent");
            xb_add(&bar[XB_XGEN(b.x)], 1u);
            asm volatile("s_waitcnt vmcnt(0)" ::: "memory");
        } else {
            XB_SPIN(xb_ld(&bar[XB_XGEN(b.x)]) == gen, bar);
            __builtin_amdgcn_fence(__ATOMIC_ACQUIRE, "agent");
            asm volatile("s_waitcnt vmcnt(0)" ::: "memory");
        }
    }
    __syncthreads();
}

namespace pg8 {
constexpr int BM = 256, BK = 64, HALF = 128, HTB = HALF * BK * 2, STAGE_BYTES = 8 * HTB, NXCD = 8, WGM = 8;
constexpr int GK = 2048;
__host__ __device__ __forceinline__ int lds_byte(int r, int c) { const int st = (r >> 4) * 2 + (c >> 5), rr = r & 15, cc = c & 31, ob = rr * 64 + cc * 2; return st * 1024 + (ob ^ (((ob >> 9) & 1) << 5)); }
__host__ __device__ __forceinline__ void stage_rc(int b, int& R, int& C) { const int st = b / 1024, sb = b % 1024, swz = sb ^ (((sb >> 9) & 1) << 5); R = (st >> 1) * 16 + swz / 64; C = (st & 1) * 32 + (swz % 64) / 2; }
__host__ __device__ __forceinline__ int perm32(int rho) { const int n = rho >> 4, i = rho & 15; return 8 * (i >> 2) + 4 * n + (i & 3); }

struct Unit { int pm, pn, e, half; };
template <int ROWB> struct TS { static constexpr size_t v = (size_t)BM * ROWB; };

__device__ __forceinline__ int xcd_remap(int wgid, int nwg) { const int q = nwg / NXCD, r = nwg % NXCD, xcd = wgid % NXCD, off = wgid / NXCD; return (xcd < r ? xcd * (q + 1) : r * (q + 1) + (xcd - r) * q) + off; }

template <int ROWB> struct PlainSched {
    const char* A; const char* B; int nM, nN, nwg, G, c, i0 = 0, i1 = 1 << 20;
    __device__ void window(int a, int b) { i0 = a; i1 = b; }
    __device__ void init(const void* A_, const void* B_, int M, int N, int G_, int c_) { A = (const char*)A_; B = (const char*)B_; nM = M / BM; nN = N / BM; nwg = nM * nN; G = G_; c = c_; }
    __device__ __forceinline__ bool next(int i, Unit& u) const {
        if (i + i0 >= i1) return false;
        const long L = (long)(i + i0) * G + c; if (L >= nwg) return false;
        const int wgid = xcd_remap((int)L, nwg);
        const int nig = WGM * nN, gid = wgid / nig, fm = gid * WGM, gsz = (nM - fm) < WGM ? (nM - fm) : WGM;
        u.pm = fm + ((wgid % nig) % gsz); u.pn = (wgid % nig) / gsz; u.e = 0; u.half = 0; return true;
    }
    __device__ __forceinline__ const char* aptr(const Unit& u) const { return A + (size_t)u.pm * TS<ROWB>::v; }
    __device__ __forceinline__ const char* bptr(const Unit& u) const { return B + (size_t)u.pn * TS<ROWB>::v; }
};
template <int ROWB> struct MoeSched {
    const char* A; const char* B; const LAS int* ps; int nN, nwg, G, c, i0 = 0, i1 = 1 << 20;
    __device__ void window(int a, int b) { i0 = a; i1 = b; }
    __device__ void init(const void* A_, const void* B_, const LAS int* ps_, int nN_, int G_, int c_) { A = (const char*)A_; B = (const char*)B_; ps = ps_; nN = nN_; nwg = ps_[64] * nN_; G = G_; c = c_; }
    __device__ __forceinline__ bool next(int i, Unit& u) const {
        if (i + i0 >= i1) return false;
        const long L = (long)(i + i0) * G + c; if (L >= nwg) return false;
        const int wgid = xcd_remap((int)L, nwg);
        int sidx = 0;
#pragma unroll 8
        for (int j = 1; j < 64; ++j) sidx += (wgid >= ps[j] * nN) ? 1 : 0;
        const int e = (sidx >> 3) * 4 + (sidx & 3), kind = (sidx >> 2) & 1, local = wgid - ps[sidx] * nN;
        int pn, r;
        if (kind == 0) { const int nt = ps[sidx + 1] - ps[sidx]; pn = local / nt; r = local % nt; }
        else { pn = local; r = ps[sidx - 3] - ps[sidx - 4]; }
        u.e = __builtin_amdgcn_readfirstlane(e); u.pn = __builtin_amdgcn_readfirstlane(pn); u.pm = __builtin_amdgcn_readfirstlane(e * ECAP_TILES + r); u.half = __builtin_amdgcn_readfirstlane(kind); return true;
    }
    __device__ __forceinline__ const char* aptr(const Unit& u) const { return A + (size_t)u.pm * TS<ROWB>::v; }
    __device__ __forceinline__ const char* bptr(const Unit& u) const { return B + ((size_t)u.e * nN + u.pn) * TS<ROWB>::v; }
};

struct EpiBf16Plain { static constexpr bool PERM = true; bf16_t* O; int ldc;
    __device__ __forceinline__ void operator()(const f32x4 (&acc)[2][2][4][2], const Unit& u, int wr, int wc, int fr, int fq) const {
        const int row0 = u.pm * BM + wr * 64 + fr, col0 = u.pn * BM + wc * 32 + 8 * fq;
#pragma unroll
        for (int ai = 0; ai < 2; ++ai)
#pragma unroll
            for (int m = 0; m < 4; ++m) { bf16_t* rowp = O + (size_t)(row0 + ai * HALF + m * 16) * ldc + col0;
#pragma unroll
                for (int bj = 0; bj < 2; ++bj) { const f32x4 v0 = acc[ai][bj][m][0], v1 = acc[ai][bj][m][1];
                    u32x4 w; w.x = cvt_pk_bf16(v0[0], v0[1]); w.y = cvt_pk_bf16(v0[2], v0[3]); w.z = cvt_pk_bf16(v1[0], v1[1]); w.w = cvt_pk_bf16(v1[2], v1[3]);
                    *(u32x4*)(rowp + bj * HALF) = w; } }
    }
};
struct EpiF32Plain { static constexpr bool PERM = false; float* C; int ldc;
    __device__ __forceinline__ void operator()(const f32x4 (&acc)[2][2][4][2], const Unit& u, int wr, int wc, int fr, int fq) const {
        const int row0 = u.pm * BM + wr * 64 + fr, col0 = u.pn * BM + wc * 32 + 4 * fq;
#pragma unroll
        for (int ai = 0; ai < 2; ++ai)
#pragma unroll
            for (int m = 0; m < 4; ++m) { float* rowp = C + (size_t)(row0 + ai * HALF + m * 16) * ldc + col0;
#pragma unroll
                for (int bj = 0; bj < 2; ++bj)
#pragma unroll
                    for (int n = 0; n < 2; ++n) *(f32x4*)(rowp + bj * HALF + n * 16) = acc[ai][bj][m][n]; }
    }
};
struct EpiSwiglu { static constexpr bool PERM = true; unsigned char* O; const float* b1;
    __device__ __forceinline__ void operator()(const f32x4 (&acc)[2][2][4][2], const Unit& u, int wr, int wc, int fr, int fq) const {
        const int row0 = u.pm * BM + wr * 64 + fr, col0 = u.pn * HALF + wc * 32 + 8 * fq;
        const float* bg = b1 + (size_t)u.e * 4096 + col0;
        f32x4 bgv[2], blv[2];
#pragma unroll
        for (int n = 0; n < 2; ++n) { bgv[n] = *(const f32x4*)(bg + 4 * n); blv[n] = *(const f32x4*)(bg + 2048 + 4 * n); }
#pragma unroll
        for (int ai = 0; ai < 2; ++ai) if (!(ai == 1 && u.half))
#pragma unroll
            for (int m = 0; m < 4; ++m) { unsigned char* rowp = O + (size_t)(row0 + ai * HALF + m * 16) * 2048 + col0;
                float r[8];
#pragma unroll
                for (int n = 0; n < 2; ++n) { const f32x4 g = acc[ai][0][m][n] * (1.f / W_SCALE) + bgv[n], l = acc[ai][1][m][n] * (1.f / W_SCALE) + blv[n];
#pragma unroll
                    for (int j = 0; j < 4; ++j) { const float gg = fminf(g[j], 7.0f), ll = fminf(fmaxf(l[j], -7.0f), 7.0f);
                        r[n * 4 + j] = ACT_SCALE * gg * fast_sigmoid(1.702f * gg) * (ll + 1.0f); } }
                u32x2 w; w.x = pk4_fp8(r[0], r[1], r[2], r[3]); w.y = pk4_fp8(r[4], r[5], r[6], r[7]);
                *(u32x2*)rowp = w; }
    }
};
struct EpiGate { static constexpr bool PERM = true; unsigned char* O; const float* b2; const float* sgate;
    __device__ __forceinline__ void operator()(const f32x4 (&acc)[2][2][4][2], const Unit& u, int wr, int wc, int fr, int fq) const {
        const int row0 = u.pm * BM + wr * 64 + fr, col0 = u.pn * BM + wc * 32 + 8 * fq;
        const float* bb = b2 + (size_t)u.e * 2048 + col0;
        f32x4 bv[2][2];
#pragma unroll
        for (int bj = 0; bj < 2; ++bj)
#pragma unroll
            for (int n = 0; n < 2; ++n) bv[bj][n] = *(const f32x4*)(bb + bj * HALF + 4 * n);
        float gts[2][4];
#pragma unroll
        for (int ai = 0; ai < 2; ++ai)
#pragma unroll
            for (int m = 0; m < 4; ++m) gts[ai][m] = sgate[row0 + ai * HALF + m * 16];
#pragma unroll
        for (int ai = 0; ai < 2; ++ai) if (!(ai == 1 && u.half))
#pragma unroll
            for (int m = 0; m < 4; ++m) { const int row = row0 + ai * HALF + m * 16; const float gt = gts[ai][m] * YB_SCALE; unsigned char* rowp = O + (size_t)row * 2048 + col0;
#pragma unroll
                for (int bj = 0; bj < 2; ++bj) { const f32x4 v0 = (acc[ai][bj][m][0] * (1.f / (W_SCALE * ACT_SCALE)) + bv[bj][0]) * gt, v1 = (acc[ai][bj][m][1] * (1.f / (W_SCALE * ACT_SCALE)) + bv[bj][1]) * gt;
                    u32x2 w; w.x = pk4_fp8(v0[0], v0[1], v0[2], v0[3]); w.y = pk4_fp8(v1[0], v1[1], v1[2], v1[3]);
                    *(u32x2*)(rowp + bj * HALF) = w; } }
    }
};

typedef int i32x4 __attribute__((ext_vector_type(4)));
typedef int i32x8 __attribute__((ext_vector_type(8)));
__device__ __forceinline__ bf16x8 lo8(i32x8 v) { const i32x4 a = __builtin_shufflevector(v, v, 0, 1, 2, 3); return __builtin_bit_cast(bf16x8, a); }
__device__ __forceinline__ bf16x8 hi8(i32x8 v) { const i32x4 a = __builtin_shufflevector(v, v, 4, 5, 6, 7); return __builtin_bit_cast(bf16x8, a); }
__device__ __forceinline__ i32x8 cat8(bf16x8 lo, bf16x8 hi) { const i32x4 a = __builtin_bit_cast(i32x4, lo), b = __builtin_bit_cast(i32x4, hi); return __builtin_shufflevector(a, b, 0, 1, 2, 3, 4, 5, 6, 7); }
template <class Epi, class Sched, bool FP8>
__device__ __forceinline__ void gemm_phase(LAS unsigned char* lds, const Sched& S, const Epi& E) {
    int tid_ = threadIdx.x; asm volatile("" : "+v"(tid_));
    const int tid = tid_, wid = __builtin_amdgcn_readfirstlane(tid >> 6), lane = tid & 63, wr = wid >> 2, wc = wid & 3, fr = lane & 15, fq = lane >> 4;
    constexpr int K = FP8 ? GK / 2 : GK, nt = K / BK;
    unsigned voffA[2], voffB[2];
#pragma unroll
    for (int i = 0; i < 2; ++i) { int R, C; stage_rc(tid * 16 + i * 8192, R, C); const int Rb = Epi::PERM ? ((R & ~31) + perm32(R & 31)) : R;
        voffA[i] = (unsigned)(R * K + C) * 2u; voffB[i] = (unsigned)(Rb * K + C) * 2u; }
    constexpr size_t kstep = (size_t)(BK * 2);
    constexpr size_t hstep = (size_t)HALF * K * 2;
    const unsigned ldsw = (unsigned)wid * 1024u;
    const int aoff = lds_byte(wr * 64 + fr, fq * 8), boff = lds_byte(wc * 32 + fr, fq * 8);
#define PG8_SA(b, h) (((b) * 2 + (h)) * HTB)
#define PG8_SB(b, h) ((4 + (b) * 2 + (h)) * HTB)
#define PG8_STAGE(bufoff, gbase, voff) do { _Pragma("unroll") for (int _i = 0; _i < 2; ++_i) \
        __builtin_amdgcn_global_load_lds((const unsigned*)((const char*)(gbase) + (voff)[_i]), (LAS unsigned*)(lds + (bufoff) + ldsw + _i * 8192), 16, 0, 0); } while (0)
#define PG8_LDA(dst, b, h) do { _Pragma("unroll") for (int m = 0; m < 4; ++m) dst[m] = cat8(*(const LAS bf16x8*)(lds + PG8_SA(b, h) + aoff + m * 2048), *(const LAS bf16x8*)(lds + PG8_SA(b, h) + aoff + m * 2048 + 1024)); } while (0)
#define PG8_LDB(dst, b, h) do { _Pragma("unroll") for (int n = 0; n < 2; ++n) dst[n] = cat8(*(const LAS bf16x8*)(lds + PG8_SB(b, h) + boff + n * 2048), *(const LAS bf16x8*)(lds + PG8_SB(b, h) + boff + n * 2048 + 1024)); } while (0)
#define PG8_MMA(ai, bj, At, Bt) do { __builtin_amdgcn_s_setprio(1); _Pragma("unroll") for (int m = 0; m < 4; ++m) _Pragma("unroll") for (int n = 0; n < 2; ++n) { \
        if constexpr (FP8) asm volatile("v_mfma_scale_f32_16x16x128_f8f6f4 %0, %1, %2, %0, %3, %3 op_sel_hi:[0,0,0]" : "+v"(acc[ai][bj][m][n]) : "v"(Bt[n]), "v"(At[m]), "v"(fp8_one));   \
        else { acc[ai][bj][m][n] = __builtin_amdgcn_mfma_f32_16x16x32_bf16(lo8(Bt[n]), lo8(At[m]), acc[ai][bj][m][n], 0, 0, 0); \
               acc[ai][bj][m][n] = __builtin_amdgcn_mfma_f32_16x16x32_bf16(hi8(Bt[n]), hi8(At[m]), acc[ai][bj][m][n], 0, 0, 0); } } \
        __builtin_amdgcn_s_setprio(0); } while (0)
#define PG8_WAIT_V(n) asm volatile("s_waitcnt vmcnt(" #n ")" ::: "memory")
#define PG8_WAIT_L(n) asm volatile("s_waitcnt lgkmcnt(" #n ")" ::: "memory")
#define PG8_BAR __builtin_amdgcn_s_barrier()
#define PG8_SCHED __builtin_amdgcn_sched_barrier(0)
#define PG8_USE_AT if constexpr (FP8) asm volatile("" :: "v"(At[0]), "v"(At[1]), "v"(At[2]), "v"(At[3]))
    Unit cur, nxt; int ui = 0;
    if (!S.next(0, cur)) return;
    f32x4 acc[2][2][4][2];
#pragma unroll
    for (int a = 0; a < 2; ++a)
#pragma unroll
        for (int b = 0; b < 2; ++b)
#pragma unroll
            for (int m = 0; m < 4; ++m)
#pragma unroll
                for (int n = 0; n < 2; ++n) acc[a][b][m][n] = (f32x4){0.f, 0.f, 0.f, 0.f};
    i32x8 At[4], B0[2], B1[2]; const int fp8_one = 0x7F7F7F7F; (void)fp8_one;
    const char* cA = S.aptr(cur); const char* cB = S.bptr(cur);
    PG8_STAGE(PG8_SB(0, 0), cB, voffB); PG8_STAGE(PG8_SB(0, 1), cB + hstep, voffB); PG8_STAGE(PG8_SA(0, 0), cA, voffA); PG8_STAGE(PG8_SA(0, 1), cA + hstep, voffA);
    if (wr == 1) PG8_BAR;
    PG8_WAIT_V(2); PG8_BAR;
    PG8_STAGE(PG8_SB(1, 0), cB + kstep, voffB); PG8_STAGE(PG8_SA(1, 0), cA + kstep, voffA); PG8_STAGE(PG8_SB(1, 1), cB + hstep + kstep, voffB);
    PG8_WAIT_V(6); PG8_BAR;
    for (;;) {
        const bool has_next = S.next(ui + 1, nxt);
        const char* nA = has_next ? S.aptr(nxt) : cA; const char* nB = has_next ? S.bptr(nxt) : cB;
        for (int t = 0; t < nt; t += 2) {
            const bool last = (t == nt - 2);
            const char* a1 = cA + (size_t)(t + 1) * kstep;
            const char* a2 = last ? nA : cA + (size_t)(t + 2) * kstep; const char* b2 = last ? nB : cB + (size_t)(t + 2) * kstep;
            const char* a3 = a2 + kstep; const char* b3 = b2 + kstep;
            PG8_LDB(B0, 0, 0); PG8_LDB(B1, 0, 1); PG8_SCHED; PG8_LDA(At, 0, 0); PG8_STAGE(PG8_SA(1, 1), a1 + hstep, voffA);
            PG8_WAIT_V(8); PG8_WAIT_L(0); PG8_BAR; PG8_MMA(0, 0, At, B0); PG8_MMA(0, 1, At, B1); PG8_BAR; PG8_SCHED;
            PG8_LDA(At, 0, 1); PG8_STAGE(PG8_SB(0, 0), b2, voffB); PG8_STAGE(PG8_SB(0, 1), b2 + hstep, voffB); PG8_STAGE(PG8_SA(0, 0), a2, voffA);
            PG8_WAIT_V(8); PG8_WAIT_L(0); PG8_BAR; PG8_USE_AT; if (!cur.half) { PG8_MMA(1, 0, At, B0); PG8_MMA(1, 1, At, B1); } PG8_BAR; PG8_SCHED;
            PG8_LDB(B0, 1, 0); PG8_LDB(B1, 1, 1); PG8_SCHED; PG8_LDA(At, 1, 0); PG8_STAGE(PG8_SA(0, 1), a2 + hstep, voffA);
            PG8_WAIT_V(8); PG8_WAIT_L(0); PG8_BAR; PG8_MMA(0, 0, At, B0); PG8_MMA(0, 1, At, B1); PG8_BAR; PG8_SCHED;
            PG8_LDA(At, 1, 1); PG8_STAGE(PG8_SB(1, 0), b3, voffB); PG8_STAGE(PG8_SB(1, 1), b3 + hstep, voffB); PG8_STAGE(PG8_SA(1, 0), a3, voffA);
            PG8_WAIT_V(8); PG8_WAIT_L(0); PG8_BAR; PG8_USE_AT; if (!cur.half) { PG8_MMA(1, 0, At, B0); PG8_MMA(1, 1, At, B1); } PG8_BAR; PG8_SCHED;
        }
        if (wr == 0) PG8_BAR;
        E(acc, cur, wr, wc, fr, fq);
        if (!has_next) break;
#pragma unroll
        for (int a = 0; a < 2; ++a)
#pragma unroll
            for (int b = 0; b < 2; ++b)
#pragma unroll
                for (int m = 0; m < 4; ++m)
#pragma unroll
                    for (int n = 0; n < 2; ++n) acc[a][b][m][n] = (f32x4){0.f, 0.f, 0.f, 0.f};
        cur = nxt; cA = nA; cB = nB; ++ui;
        if (wr == 1) PG8_BAR;
    }
    PG8_WAIT_V(0);
    PG8_BAR;
#undef PG8_SA
#undef PG8_SB
#undef PG8_STAGE
#undef PG8_LDA
#undef PG8_LDB
#undef PG8_MMA
#undef PG8_WAIT_V
#undef PG8_WAIT_L
#undef PG8_BAR
#undef PG8_SCHED
#undef PG8_USE_AT
}
}

namespace att {
constexpr int D = 128, NW = 8, QBLK = 32, KVBLK = 64;
constexpr float SCALE = 0.088388347648318440f;
constexpr float THR = 8.f;
constexpr int LDQ = PW, LDK = 512, LDO = 2048;
constexpr size_t SHM_V = KVBLK * D * 2, SHM_K = KVBLK * D * 2, SHM_ATTN = 2 * SHM_V + 2 * SHM_K + NW * 64 * 4;
#define KSWZ(row, colB) ((row) * 256 + ((colB) ^ (((row) & 7) << 4)))
#define SBAR() __builtin_amdgcn_sched_barrier(0)
__device__ __forceinline__ int crow(int r, int hi) { return (r & 3) + 8 * (r >> 2) + 4 * hi; }
__device__ __forceinline__ void partialSM(f32x16& p0, f32x16& p1, float& m_reg, float& mn, float& alpha) {
  constexpr float C = SCALE * 1.4426950408889634f;
  float pmax = p0[0]; for (int r = 1; r < 16; ++r) pmax = fmaxf(pmax, p0[r]); for (int r = 0; r < 16; ++r) pmax = fmaxf(pmax, p1[r]);
  { auto rr = __builtin_amdgcn_permlane32_swap(__float_as_uint(pmax), __float_as_uint(pmax), false, false);
    pmax = fmaxf(__uint_as_float(rr[0]), __uint_as_float(rr[1])); }
  if (__builtin_expect(__all(pmax - m_reg <= THR / SCALE), 1)) { mn = m_reg; alpha = 1.f; }
  else { mn = fmaxf(m_reg, pmax); alpha = __builtin_amdgcn_exp2f((m_reg - mn) * C); m_reg = mn; }
  float mnC = -mn * C;
  for (int r = 0; r < 16; ++r) p0[r] = fmaf(p0[r], C, mnC); for (int r = 0; r < 16; ++r) p1[r] = fmaf(p1[r], C, mnC);
  for (int r = 0; r < 16; ++r) p0[r] = __builtin_amdgcn_exp2f(p0[r]);
}
__device__ __forceinline__ void finishSM(f32x16& p0, f32x16& p1, float alpha, float& l_reg, bf16x8& pa0, bf16x8& pa1, bf16x8& pa2, bf16x8& pa3) {
  for (int r = 0; r < 16; ++r) p1[r] = __builtin_amdgcn_exp2f(p1[r]);
  float ps = 0; for (int r = 0; r < 16; ++r) ps += p0[r]; for (int r = 0; r < 16; ++r) ps += p1[r];
  { auto rr = __builtin_amdgcn_permlane32_swap(__float_as_uint(ps), __float_as_uint(ps), false, false);
    ps = __uint_as_float(rr[0]) + __uint_as_float(rr[1]); }
  l_reg = l_reg * alpha + ps;
#define PK4(P, BASE, OUT) do { unsigned a0 = cvt_pk_bf16(P[BASE + 0], P[BASE + 1]), a1 = cvt_pk_bf16(P[BASE + 2], P[BASE + 3]);   \
    unsigned b0 = cvt_pk_bf16(P[BASE + 4], P[BASE + 5]), b1 = cvt_pk_bf16(P[BASE + 6], P[BASE + 7]);                              \
    auto r0 = __builtin_amdgcn_permlane32_swap(a0, b0, false, false); auto r1 = __builtin_amdgcn_permlane32_swap(a1, b1, false, false); \
    u32x4 w = {r0[0], r1[0], r0[1], r1[1]}; OUT = *reinterpret_cast<bf16x8*>(&w); } while (0)
  PK4(p0, 0, pa0); PK4(p0, 8, pa1); PK4(p1, 0, pa2); PK4(p1, 8, pa3);
#undef PK4
}
__device__ __forceinline__ void qkt(f32x16& p0, f32x16& p1, const bf16_t* Ks, const bf16x8* qr, int r32, int hi) {
  p0 = f32x16{}; p1 = f32x16{};
  for (int d0 = 0; d0 < 8; ++d0) { int cb = (d0 * 16 + hi * 8) * 2;
    bf16x8 b0 = *reinterpret_cast<const bf16x8*>((const char*)Ks + KSWZ(r32, cb));
    bf16x8 b1 = *reinterpret_cast<const bf16x8*>((const char*)Ks + KSWZ(32 + r32, cb));
    p0 = __builtin_amdgcn_mfma_f32_32x32x16_bf16(b0, qr[d0], p0, 0, 0, 0);
    p1 = __builtin_amdgcn_mfma_f32_32x32x16_bf16(b1, qr[d0], p1, 0, 0, 0); }
}
__device__ __forceinline__ int v_st(int k, int c) { const int kk = (k & ~0xC) | ((k & 4) << 1) | ((k & 8) >> 1); return ((kk >> 3) * 4 + (c >> 5)) * 512 + ((kk & 7) * 32 + (c & 31)) * 2; }
__device__ __forceinline__ int v_rd_base(int lane) { return ((lane & 3) << 3) | (((lane >> 2) & 3) << 6) | (((lane >> 4) & 1) << 5) | (((lane >> 5) & 1) << 8); }
constexpr int v_rd_off(int d0, int ks, int half) { return d0 * 512 + ks * 4096 + half * 2048; }
template <int OFF> __device__ __forceinline__ s16x4 tr_read(int vb) {
  s16x4 r; asm volatile("ds_read_b64_tr_b16 %0, %1 offset:%2" : "=&v"(r) : "v"(vb), "i"(OFF) : "memory"); return r;
}
template <int D0> __device__ __forceinline__ void pv_one(f32x16& od, int vb, bf16x8 pa0, bf16x8 pa1, bf16x8 pa2, bf16x8 pa3) {
  const s16x4 l0 = tr_read<v_rd_off(D0, 0, 0)>(vb), h0 = tr_read<v_rd_off(D0, 0, 1)>(vb), l1 = tr_read<v_rd_off(D0, 1, 0)>(vb), h1 = tr_read<v_rd_off(D0, 1, 1)>(vb);
  const s16x4 l2 = tr_read<v_rd_off(D0, 2, 0)>(vb), h2 = tr_read<v_rd_off(D0, 2, 1)>(vb), l3 = tr_read<v_rd_off(D0, 3, 0)>(vb), h3 = tr_read<v_rd_off(D0, 3, 1)>(vb);
  asm volatile("s_waitcnt lgkmcnt(0)" ::: "memory"); SBAR();
#define PK(L, H) (bf16x8){L[0], L[1], L[2], L[3], H[0], H[1], H[2], H[3]}
  od = __builtin_amdgcn_mfma_f32_32x32x16_bf16(pa0, PK(l0, h0), od, 0, 0, 0);
  od = __builtin_amdgcn_mfma_f32_32x32x16_bf16(pa1, PK(l1, h1), od, 0, 0, 0);
  od = __builtin_amdgcn_mfma_f32_32x32x16_bf16(pa2, PK(l2, h2), od, 0, 0, 0);
  od = __builtin_amdgcn_mfma_f32_32x32x16_bf16(pa3, PK(l3, h3), od, 0, 0, 0);
#undef PK
}
__device__ __forceinline__ void pv_d0(f32x16* o, int vb, bf16x8 pa0, bf16x8 pa1, bf16x8 pa2, bf16x8 pa3) {
  pv_one<0>(o[0], vb, pa0, pa1, pa2, pa3); pv_one<1>(o[1], vb, pa0, pa1, pa2, pa3); pv_one<2>(o[2], vb, pa0, pa1, pa2, pa3); pv_one<3>(o[3], vb, pa0, pa1, pa2, pa3);
}
__device__ __forceinline__ void load_q(bf16x8* qr, const bf16_t* Qw, const float* qnw, int pos, int hi) {
  float qf[64]; float ssq = 0.f;
#pragma unroll
  for (int d0 = 0; d0 < 8; ++d0) { const u32x4 raw = *reinterpret_cast<const u32x4*>(Qw + d0 * 16);
#pragma unroll
    for (int i = 0; i < 4; ++i) { const float a = bflo(raw[i]), b = bfhi(raw[i]); qf[d0 * 8 + 2 * i] = a; qf[d0 * 8 + 2 * i + 1] = b; ssq += a * a + b * b; } }
  ssq += __shfl_xor(ssq, 32);
  const float rn = __builtin_amdgcn_rsqf(ssq * (1.f / 128.f) + EPS);
#pragma unroll
  for (int d0 = 0; d0 < 8; ++d0) { const f32x4 w0 = *reinterpret_cast<const f32x4*>(qnw + d0 * 16 + hi * 8), w1 = *reinterpret_cast<const f32x4*>(qnw + d0 * 16 + hi * 8 + 4);
#pragma unroll
    for (int i = 0; i < 4; ++i) { qf[d0 * 8 + i] *= rn * w0[i]; qf[d0 * 8 + 4 + i] *= rn * w1[i]; } }
  const float prow = (float)(pos / 64 - 16), pcol = (float)(pos % 64 - 32);
#pragma unroll
  for (int d0 = 0; d0 < 2; ++d0)
#pragma unroll
    for (int i = 0; i < 8; ++i) { const int j = d0 * 16 + hi * 8 + i;
      const float invf = __builtin_amdgcn_exp2f(-(float)j * 0.41524101186092029f);
      float rv = prow * invf * 0.15915494309189535f; rv -= rintf(rv);
      float s = __builtin_amdgcn_sinf(rv), c = __builtin_amdgcn_cosf(rv);
      float x1 = qf[d0 * 8 + i], x2 = qf[(d0 + 2) * 8 + i]; qf[d0 * 8 + i] = x1 * c - x2 * s; qf[(d0 + 2) * 8 + i] = x2 * c + x1 * s;
      rv = pcol * invf * 0.15915494309189535f; rv -= rintf(rv);
      s = __builtin_amdgcn_sinf(rv); c = __builtin_amdgcn_cosf(rv);
      x1 = qf[(d0 + 4) * 8 + i]; x2 = qf[(d0 + 6) * 8 + i]; qf[(d0 + 4) * 8 + i] = x1 * c - x2 * s; qf[(d0 + 6) * 8 + i] = x2 * c + x1 * s; }
#pragma unroll
  for (int d0 = 0; d0 < 8; ++d0) { u32x4 w = {cvt_pk_bf16(qf[d0 * 8 + 0], qf[d0 * 8 + 1]), cvt_pk_bf16(qf[d0 * 8 + 2], qf[d0 * 8 + 3]), cvt_pk_bf16(qf[d0 * 8 + 4], qf[d0 * 8 + 5]), cvt_pk_bf16(qf[d0 * 8 + 6], qf[d0 * 8 + 7])};
    qr[d0] = *reinterpret_cast<bf16x8*>(&w); }
}
__device__ __forceinline__ void attn_unit(const bf16_t* __restrict__ Qb, const bf16_t* __restrict__ Kh, const bf16_t* __restrict__ Vh,
                                          bf16_t* __restrict__ Ob, const float* qnw, const float* anw, int pos0, int seq, char* lds) {
  int tid_ = threadIdx.x; asm volatile("" : "+v"(tid_));
  asm volatile("" : "+s"(qnw), "+s"(anw));
  const int tid = tid_, wid = tid >> 6, lane = tid & 63, r32 = lane & 31, hi = lane >> 5;
  bf16_t* V_lds = (bf16_t*)lds; bf16_t* K_lds = (bf16_t*)(lds + 2 * SHM_V);
  float* ws = (float*)(lds + 2 * SHM_V + 2 * SHM_K) + wid * 64; float* li_l = ws; float* al_l = ws + 32;
  float m_reg = -1e30f, l_reg = 0; f32x16 o[4] = {}; bf16x8 qr[8];
  load_q(qr, Qb + (long)(wid * QBLK + r32) * LDQ + hi * 8, qnw, pos0 + wid * QBLK + r32, hi);
  const int sr = tid >> 4, sc = (tid & 15) * 8, vst0 = v_st(sr, sc), vst1 = v_st(32 + sr, sc);
  const int vb0 = (int)(uintptr_t)V_lds + v_rd_base(lane);
  struct { bf16x8 vs0, vs1, ks0, ks1; } sr_[2];
#define LD8(p) (*reinterpret_cast<const bf16x8*>(p))
#define SLOAD(i, k0) do { sr_[i].vs0 = LD8(&Vh[(long)((k0) + sr) * LDK + sc]); sr_[i].vs1 = LD8(&Vh[(long)((k0) + 32 + sr) * LDK + sc]); \
    sr_[i].ks0 = LD8(&Kh[(long)((k0) + sr) * LDK + sc]); sr_[i].ks1 = LD8(&Kh[(long)((k0) + 32 + sr) * LDK + sc]); } while (0)
#define SWRITE(b, i) do { *(bf16x8*)((char*)V_lds + (b) * SHM_V + vst0) = sr_[i].vs0;          \
    *(bf16x8*)((char*)V_lds + (b) * SHM_V + vst1) = sr_[i].vs1; int kc = sc * 2;               \
    *(bf16x8*)((char*)K_lds + (b) * SHM_K + KSWZ(sr, kc)) = sr_[i].ks0;                       \
    *(bf16x8*)((char*)K_lds + (b) * SHM_K + KSWZ(32 + sr, kc)) = sr_[i].ks1; } while (0)
#define SWAIT() asm volatile("s_waitcnt vmcnt(4)" ::: "memory")
#define RESC(a) do { if (__any((a) < 1.f)) { if (hi == 0) al_l[r32] = (a); asm volatile("s_waitcnt lgkmcnt(0)" ::: "memory"); \
    for (int d = 0; d < 4; ++d) for (int r = 0; r < 16; ++r) o[d][r] *= al_l[crow(r, hi)]; } } while (0)
  f32x16 pA0, pA1, pB0, pB1; float mnA, mnB, alA, alB; bf16x8 pa0, pa1, pa2, pa3; const int NT = seq / KVBLK;
  constexpr int SE = 0, SO = 1;
  SLOAD(SE, 0); asm volatile("s_waitcnt vmcnt(0)" ::: "memory"); SWRITE(0, SE); __syncthreads();
  qkt(pA0, pA1, K_lds, qr, r32, hi); partialSM(pA0, pA1, m_reg, mnA, alA);
  SLOAD(SO, KVBLK); if (2 < NT) SLOAD(SE, 2 * KVBLK);
  SWAIT(); SWRITE(1, SO); __syncthreads();
  for (int j = 1; j + 1 < NT; j += 2) {
    SBAR(); qkt(pB0, pB1, (bf16_t*)((char*)K_lds + SHM_K), qr, r32, hi);
    finishSM(pA0, pA1, alA, l_reg, pa0, pa1, pa2, pa3); SBAR();
    SLOAD(SO, (j + 2) * KVBLK); SBAR();
    pv_d0(o, vb0, pa0, pa1, pa2, pa3); partialSM(pB0, pB1, m_reg, mnB, alB);
    __syncthreads(); SWAIT(); SWRITE(0, SE);
    RESC(alB); __syncthreads();
    SBAR(); qkt(pA0, pA1, K_lds, qr, r32, hi);
    finishSM(pB0, pB1, alB, l_reg, pa0, pa1, pa2, pa3); SBAR();
    if (j + 3 < NT) SLOAD(SE, (j + 3) * KVBLK); SBAR();
    pv_d0(o, vb0 + (int)SHM_V, pa0, pa1, pa2, pa3); partialSM(pA0, pA1, m_reg, mnA, alA);
    __syncthreads(); SWAIT(); SWRITE(1, SO);
    RESC(alA); __syncthreads();
  }
  SBAR(); qkt(pB0, pB1, (bf16_t*)((char*)K_lds + SHM_K), qr, r32, hi);
  finishSM(pA0, pA1, alA, l_reg, pa0, pa1, pa2, pa3); SBAR();
  pv_d0(o, vb0, pa0, pa1, pa2, pa3); partialSM(pB0, pB1, m_reg, mnB, alB);
  __syncthreads(); RESC(alB);
  finishSM(pB0, pB1, alB, l_reg, pa0, pa1, pa2, pa3); SBAR();
  pv_d0(o, vb0 + (int)SHM_V, pa0, pa1, pa2, pa3);
  if (hi == 0) li_l[r32] = l_reg; asm volatile("s_waitcnt lgkmcnt(0)" ::: "memory");
  bf16_t* Ow = Ob + (long)(wid * QBLK) * LDO;
  char* ost = lds + 69632 + wid * 8704;
  float aw[4];
#pragma unroll
  for (int d0 = 0; d0 < 4; ++d0) aw[d0] = anw[d0 * 32 + r32];
#pragma unroll
  for (int r = 0; r < 16; ++r) { const int orow = crow(r, hi); const float rli = __builtin_amdgcn_rcpf(li_l[orow]);
    float ss = 0.f;
#pragma unroll
    for (int d0 = 0; d0 < 4; ++d0) { const float v = o[d0][r] * rli; o[d0][r] = v; ss += v * v; }
#pragma unroll
    for (int x = 1; x < 32; x <<= 1) ss += __shfl_xor(ss, x);
    const float rs = __builtin_amdgcn_rsqf(ss * (1.f / 128.f) + EPS);
#pragma unroll
    for (int d0 = 0; d0 < 4; ++d0) *(unsigned short*)(ost + orow * 272 + (d0 * 32 + r32) * 2) = f2bf(o[d0][r] * rs * aw[d0]); }
  asm volatile("s_waitcnt lgkmcnt(0)" ::: "memory");
#pragma unroll
  for (int q = 0; q < 8; ++q) { const int id = q * 64 + lane, row = id >> 4, ch = id & 15;
    const u32x4 w = *(const u32x4*)(ost + row * 272 + ch * 16);
    *(u32x4*)(Ow + (long)row * LDO + ch * 8) = w; }
  __syncthreads();
#undef LD8
#undef SLOAD
#undef SWRITE
#undef SWAIT
#undef RESC
}
}

struct Frame {
    LAS unsigned char* lds; int tid, lane, wave, G, bid;
    const float *x, *c, *w_ada, *b_ada, *w_in, *q_norm_w, *k_norm_w, *attn_norm_w, *hgrn_lb, *hgrn_norm_w, *w_out, *ln1_g, *ln1_b, *w_router, *b_router, *w1, *b1, *w2, *b2, *ln2_g, *ln2_b;
    float* out; unsigned char* ws;
};

__device__ __forceinline__ void p0_adaln(Frame& F) {
    LAS float* sc = (LAS float*)F.lds;
    LAS float* red = sc + 1024;
    float* modp = (float*)(F.ws + WS_MODP);
    for (int it = F.bid; it < 768; it += F.G) {
        const int cc = it % 96, ks = it / 96, c0 = cc * 128, k0 = ks * 256;
        __syncthreads();
        for (int i = F.tid; i < 1024; i += NTHR) { const int b = i >> 8, k = i & 255; const float v = F.c[b * 2048 + k0 + k]; sc[i] = v / (1.f + __expf(-v)); }
        __syncthreads();
        const int col4 = F.tid & 31, kr = F.tid >> 5;
        f32x4 a0 = {0, 0, 0, 0}, a1 = a0, a2 = a0, a3 = a0;
#pragma unroll 8
        for (int i = 0; i < 16; ++i) { const int k = kr + 16 * i; const f32x4 w = __builtin_nontemporal_load((const f32x4*)(F.w_ada + (size_t)(k0 + k) * 12288 + c0 + 4 * col4));
            a0 += w * sc[k]; a1 += w * sc[256 + k]; a2 += w * sc[512 + k]; a3 += w * sc[768 + k]; }
        *(LAS f32x4*)(red + (kr * 4 + 0) * 128 + 4 * col4) = a0; *(LAS f32x4*)(red + (kr * 4 + 1) * 128 + 4 * col4) = a1;
        *(LAS f32x4*)(red + (kr * 4 + 2) * 128 + 4 * col4) = a2; *(LAS f32x4*)(red + (kr * 4 + 3) * 128 + 4 * col4) = a3;
        __syncthreads();
        { const int b = F.tid >> 7, col = F.tid & 127; float s = 0.f;
#pragma unroll
          for (int r = 0; r < 16; ++r) s += red[(r * 4 + b) * 128 + col];
          modp[(size_t)(ks * 4 + b) * 12288 + c0 + col] = s; }
    }
    __syncthreads();
}
struct TrItem { const float* src; bf16_t* dst; int N; };
__device__ __forceinline__ TrItem tr_decode(Frame& F, int it, int& k0, int& n0, int& drow0) {
    TrItem t; int kt, ntile;
    if (it < 832) { t.src = F.w_in; t.N = PW; t.dst = (bf16_t*)(F.ws + WS_WIN_T); ntile = 52; kt = it / ntile; n0 = (it % ntile) * 128; drow0 = n0; }
    else if (it < 1088) { it -= 832; t.src = F.w_out; t.N = 2048; t.dst = (bf16_t*)(F.ws + WS_WOUT_T); ntile = 16; kt = it / ntile; n0 = (it % ntile) * 128; drow0 = n0; }
    else if (it < 1088 + 16384) { it -= 1088; const int e = it >> 9; it &= 511; t.src = F.w1 + (size_t)e * 2048 * 4096; t.N = 4096; t.dst = (bf16_t*)(F.ws + WS_W1T + (size_t)e * 4096 * 2048);
        kt = it >> 5; n0 = (it & 31) * 128; drow0 = n0 < 2048 ? (n0 >> 7) * 256 : ((n0 - 2048) >> 7) * 256 + 128; }
    else { it -= 1088 + 16384; const int e = it >> 8; it &= 255; t.src = F.w2 + (size_t)e * 2048 * 2048; t.N = 2048; t.dst = (bf16_t*)(F.ws + WS_W2T + (size_t)e * 2048 * 2048);
        kt = it >> 4; n0 = (it & 15) * 128; drow0 = n0; }
    k0 = kt * 128; return t;
}
struct TrParm { const float* src; unsigned char* dst; int N, k0, n0, dr0; };
__device__ __forceinline__ TrParm tr_parm(Frame& F, int it) { TrParm q; int k0, n0, dr0; const TrItem t = tr_decode(F, it, k0, n0, dr0); q.src = t.src; q.dst = (unsigned char*)t.dst; q.N = t.N; q.k0 = k0; q.n0 = n0; q.dr0 = dr0; return q; }
template <bool FP8>
__device__ __forceinline__ void tr_emit(Frame& F, const f32x4 (&cur)[8], const TrParm& q, LAS unsigned char* tl, int n4, int kg) {
    if constexpr (FP8) {
#pragma unroll
        for (int i = 0; i < 4; ++i) { u32x2 w; w.x = pk4_fp8(cur[0][i] * W_SCALE, cur[1][i] * W_SCALE, cur[2][i] * W_SCALE, cur[3][i] * W_SCALE); w.y = pk4_fp8(cur[4][i] * W_SCALE, cur[5][i] * W_SCALE, cur[6][i] * W_SCALE, cur[7][i] * W_SCALE);
            const int n = 4 * n4 + i; *(LAS u32x2*)(tl + n * 128 + ((kg ^ (2 * (n4 & 7))) * 8)) = w; }
        __syncthreads();
#pragma unroll
        for (int qq = 0; qq < 2; ++qq) { const int id = F.tid + NTHR * qq, n = id >> 3, pc = id & 7, kgl = (2 * pc) ^ (2 * ((n >> 2) & 7));
            const u32x4 w = *(LAS u32x4*)(tl + n * 128 + pc * 16);
            __builtin_nontemporal_store(w, (u32x4*)(q.dst + (size_t)(q.dr0 + n) * 2048 + q.k0 + 8 * kgl)); }
    } else {
#pragma unroll
        for (int i = 0; i < 4; ++i) { u32x4 w; w.x = cvt_pk_bf16(cur[0][i], cur[1][i]); w.y = cvt_pk_bf16(cur[2][i], cur[3][i]); w.z = cvt_pk_bf16(cur[4][i], cur[5][i]); w.w = cvt_pk_bf16(cur[6][i], cur[7][i]);
            const int n = 4 * n4 + i; *(LAS u32x4*)(tl + n * 256 + ((kg ^ (n4 & 15)) * 16)) = w; }
        __syncthreads();
#pragma unroll
        for (int qq = 0; qq < 4; ++qq) { const int id = F.tid + NTHR * qq, n = id >> 4, pc = id & 15, kgl = pc ^ ((n >> 2) & 15);
            const u32x4 w = *(LAS u32x4*)(tl + n * 256 + pc * 16);
            *(u32x4*)(q.dst + ((size_t)(q.dr0 + n) * 2048 + q.k0 + 8 * kgl) * 2) = w; }
    }
}
#define TR_LOAD(buf, q) do { _Pragma("unroll") for (int j_ = 0; j_ < 8; ++j_) buf[j_] = __builtin_nontemporal_load((const f32x4*)((q).src + (size_t)((q).k0 + 8 * kg + j_) * (q).N + (q).n0 + 4 * n4)); } while (0)
template <bool FP8>
__device__ __forceinline__ void conv_items(Frame& F, int it0, int it1, int idx = -1, int stride = 0) {
    const int n4 = F.tid & 31, kg = F.tid >> 5, G = stride > 0 ? stride : F.G;
    int nx = it0 + (idx >= 0 ? idx : F.bid); if (nx >= it1) return;
    TrParm qa = tr_parm(F, nx), qb = qa, qc = qa, qd = qa; f32x4 a[8], b[8], c[8], d[8];
    bool va = true, vb, vc, vd;
    TR_LOAD(a, qa); nx += G;
    vb = nx < it1; if (vb) { qb = tr_parm(F, nx); TR_LOAD(b, qb); } nx += G;
    vc = nx < it1; if (vc) { qc = tr_parm(F, nx); TR_LOAD(c, qc); } nx += G;
    vd = nx < it1; if (vd) { qd = tr_parm(F, nx); TR_LOAD(d, qd); } nx += G;
    for (;;) {
        tr_emit<FP8>(F, a, qa, F.lds, n4, kg);
        va = nx < it1; if (va) { qa = tr_parm(F, nx); TR_LOAD(a, qa); } nx += G;
        if (!vb) break;
        tr_emit<FP8>(F, b, qb, F.lds + 32768, n4, kg);
        vb = nx < it1; if (vb) { qb = tr_parm(F, nx); TR_LOAD(b, qb); } nx += G;
        if (!vc) break;
        tr_emit<FP8>(F, c, qc, F.lds, n4, kg);
        vc = nx < it1; if (vc) { qc = tr_parm(F, nx); TR_LOAD(c, qc); } nx += G;
        if (!vd) break;
        tr_emit<FP8>(F, d, qd, F.lds + 32768, n4, kg);
        vd = nx < it1; if (vd) { qd = tr_parm(F, nx); TR_LOAD(d, qd); } nx += G;
        if (!va) break;
    }
    __syncthreads();
}
constexpr int CVQ_W2T = 1536;
constexpr int CV0 = 1088;
constexpr int CVQ_P0 = 0, CVQ_P2 = 7168, CVQ_P2T = 3456, CVQ_P3 = 512, CVQ_P4 = 3584, CVQ_P5 = 512, CVQ_P6 = 1152;
static_assert(CVQ_P0 + CVQ_P2 + CVQ_P2T + CVQ_P3 + CVQ_P4 + CVQ_P5 + CVQ_P6 == 16384, "w1 conversion quotas");
constexpr int CV_P2 = CV0 + CVQ_P0, CV_P2T = CV_P2 + CVQ_P2, CV_P3 = CV_P2T + CVQ_P2T, CV_P4 = CV_P3 + CVQ_P3, CV_P5 = CV_P4 + CVQ_P4, CV_P6 = CV_P5 + CVQ_P5, CV_W2 = CV_P6 + CVQ_P6, CV_END = CV_W2 + 8192;
__device__ __forceinline__ void p0_router_w(Frame& F) {
    bf16_t* hi = (bf16_t*)(F.ws + WS_WRT); bf16_t* lo = hi + 32 * 2048;
    for (int i = F.bid * NTHR + F.tid; i < 2048 * 32; i += F.G * NTHR) { const int k = i >> 5, e = i & 31; const float w = F.w_router[i];
        const unsigned short h = f2bf(w); hi[e * 2048 + k] = h; lo[e * 2048 + k] = f2bf(w - bf2f(h)); }
}

__device__ __forceinline__ void p1_ln_mod(Frame& F) {
    const float* modp = (const float*)(F.ws + WS_MODP); float* mod = (float*)(F.ws + WS_MOD);
    for (int i = F.bid * NTHR + F.tid; i < 4 * 12288; i += F.G * NTHR) { float s = F.b_ada[i % 12288];
#pragma unroll
        for (int ks = 0; ks < 8; ++ks) s += modp[(size_t)ks * 49152 + i];
        mod[i] = s; }
    LAS float* sh = (LAS float*)F.lds; LAS float* sc = sh + 2048;
    bf16_t* H = (bf16_t*)(F.ws + WS_H);
    for (int rt = F.bid; rt < 256; rt += F.G) {
        const int b = rt >> 6;
        __syncthreads();
        for (int cidx = F.tid; cidx < 4096; cidx += NTHR) { const int col = b * 12288 + cidx; float s = F.b_ada[cidx];
#pragma unroll
            for (int ks = 0; ks < 8; ++ks) s += modp[(size_t)ks * 49152 + col];
            if (cidx < 2048) sh[cidx] = s; else sc[cidx - 2048] = 1.f + s; }
        __syncthreads();
        for (int r = 0; r < 4; ++r) { const int row = rt * 32 + F.wave * 4 + r;
            const f32x4* xr = (const f32x4*)(F.x + (size_t)row * DM) + F.lane;
            f32x4 v[8]; float s = 0.f;
#pragma unroll
            for (int j = 0; j < 8; ++j) { v[j] = __builtin_nontemporal_load(xr + 64 * j); s += (v[j][0] + v[j][1]) + (v[j][2] + v[j][3]); }
            const float mean = wave_sum(s) * (1.f / DM); float s2 = 0.f;
#pragma unroll
            for (int j = 0; j < 8; ++j) { v[j] = v[j] - mean; s2 += (v[j][0] * v[j][0] + v[j][1] * v[j][1]) + (v[j][2] * v[j][2] + v[j][3] * v[j][3]); }
            const float rstd = __builtin_amdgcn_rsqf(wave_sum(s2) * (1.f / DM) + EPS);
            u32x2* o8 = (u32x2*)(H + (size_t)row * DM) + F.lane;
#pragma unroll
            for (int j = 0; j < 8; ++j) { const f32x4 a = *(LAS f32x4*)(sc + 4 * F.lane + 256 * j), bsh = *(LAS f32x4*)(sh + 4 * F.lane + 256 * j);
                const f32x4 h = v[j] * rstd * a + bsh; u32x2 w; w.x = cvt_pk_bf16(h[0], h[1]); w.y = cvt_pk_bf16(h[2], h[3]); o8[64 * j] = w; }
        }
    }
    __syncthreads();
}

__device__ __forceinline__ void p3_kprep(Frame& F) {
    const bf16_t* PROJ = (const bf16_t*)(F.ws + WS_PROJ); bf16_t* KV = (bf16_t*)(F.ws + WS_KV);
    const int l = F.lane & 31, kvh = F.lane >> 5;
    const float kw0 = F.k_norm_w[l], kw1 = F.k_norm_w[l + 32], kw2 = F.k_norm_w[64 + l], kw3 = F.k_norm_w[96 + l];
    const float invf = __builtin_amdgcn_exp2f(-(float)l * 0.41524101186092029f);
    for (int m0 = (F.bid * NWAVES + F.wave) * 4; m0 < MTOK; m0 += F.G * NWAVES * 4) {
        unsigned short kx[4][4], vx[4][4];
#pragma unroll
        for (int q = 0; q < 4; ++q) { const bf16_t* src = PROJ + (size_t)(m0 + q) * PW + C_K + kvh * 128; const bf16_t* sv = PROJ + (size_t)(m0 + q) * PW + C_V + kvh * 128;
#pragma unroll
            for (int i = 0; i < 4; ++i) { kx[q][i] = src[l + 32 * i]; vx[q][i] = sv[l + 32 * i]; } }
#pragma unroll
        for (int q = 0; q < 4; ++q) { const int m = m0 + q;
            float x0 = bf2f(kx[q][0]), x1 = bf2f(kx[q][1]), x2 = bf2f(kx[q][2]), x3 = bf2f(kx[q][3]);
            float ss = x0 * x0 + x1 * x1 + x2 * x2 + x3 * x3;
#pragma unroll
            for (int o = 1; o < 32; o <<= 1) ss += __shfl_xor(ss, o);
            const float rn = __builtin_amdgcn_rsqf(ss * (1.f / 128.f) + EPS);
            x0 *= rn * kw0; x1 *= rn * kw1; x2 *= rn * kw2; x3 *= rn * kw3;
            const int t = m & 2047; const float prow = (float)(t / 64 - 16), pcol = (float)(t % 64 - 32);
            float rv = prow * invf * 0.15915494309189535f; rv -= rintf(rv);
            float sn = __builtin_amdgcn_sinf(rv), c = __builtin_amdgcn_cosf(rv);
            const float y0 = x0 * c - x1 * sn, y1 = x1 * c + x0 * sn;
            rv = pcol * invf * 0.15915494309189535f; rv -= rintf(rv);
            sn = __builtin_amdgcn_sinf(rv); c = __builtin_amdgcn_cosf(rv);
            const float y2 = x2 * c - x3 * sn, y3 = x3 * c + x2 * sn;
            bf16_t* dk = KV + (size_t)m * 512 + kvh * 128;
            dk[l] = f2bf(y0); dk[l + 32] = f2bf(y1); dk[64 + l] = f2bf(y2); dk[96 + l] = f2bf(y3);
            bf16_t* dv = KV + (size_t)m * 512 + 256 + kvh * 128;
            dv[l] = vx[q][0]; dv[l + 32] = vx[q][1]; dv[l + 64] = vx[q][2]; dv[l + 96] = vx[q][3]; }
    }
}

template <int DIR>
__device__ __forceinline__ void gate_scan(const LAS unsigned char* zraw  , float lb, LAS float* segbuf, int d, int seg, float (&bb)[16], float (&kk)[16], float& total) {
    float lf[16];
#pragma unroll
    for (int ii = 0; ii < 16; ++ii) { const float z = bf2f(*(const LAS unsigned short*)(zraw + (16 * seg + ii) * 272 + d * 2)); const float fg = lb + (1.f - lb) * fast_sigmoid(z); lf[ii] = flog(fg); kk[ii] = 1.f - fg; }
    float run = 0.f;
    if (DIR == 0) {
#pragma unroll
        for (int ii = 0; ii < 16; ++ii) { run += lf[ii]; bb[ii] = run; }
    } else {
#pragma unroll
        for (int ii = 15; ii >= 0; --ii) { run += lf[ii]; bb[ii] = run; }
    }
    segbuf[seg * 128 + d] = run;
    __syncthreads();
    const float s0 = segbuf[d], s1 = segbuf[128 + d], s2 = segbuf[256 + d], s3 = segbuf[384 + d];
    total = (s0 + s1) + (s2 + s3);
    float off;
    if (DIR == 0) off = (seg > 0 ? s0 : 0.f) + (seg > 1 ? s1 : 0.f) + (seg > 2 ? s2 : 0.f);
    else off = (seg < 3 ? s3 : 0.f) + (seg < 2 ? s2 : 0.f) + (seg < 1 ? s1 : 0.f);
#pragma unroll
    for (int ii = 0; ii < 16; ++ii) bb[ii] += off;
    __syncthreads();
}
__device__ __forceinline__ void pack16_store(LAS unsigned char* p, const float (&v)[16]) {
    u32x4 w0, w1;
    w0.x = cvt_pk_bf16(v[0], v[1]); w0.y = cvt_pk_bf16(v[2], v[3]); w0.z = cvt_pk_bf16(v[4], v[5]); w0.w = cvt_pk_bf16(v[6], v[7]);
    w1.x = cvt_pk_bf16(v[8], v[9]); w1.y = cvt_pk_bf16(v[10], v[11]); w1.z = cvt_pk_bf16(v[12], v[13]); w1.w = cvt_pk_bf16(v[14], v[15]);
    *(LAS u32x4*)p = w0; *(LAS u32x4*)(p + 16) = w1;
}
__device__ __forceinline__ float hgrn_lower_bound(const float* hgrn_lb, int dir, int col) { const float a0 = hgrn_lb[dir * 2048 + col], a1 = hgrn_lb[dir * 2048 + 1024 + col]; return 1.f / (1.f + __expf(a1 - a0)); }

#define HG_TILE_LD(r0, r1, base) do { r0 = *(const u32x4*)((base) + (size_t)(F.tid >> 4) * PW + (F.tid & 15) * 8); r1 = *(const u32x4*)((base) + (size_t)((F.tid >> 4) + 32) * PW + (F.tid & 15) * 8); } while (0)
#define HG_TILE_LDNT(r0, r1, base) do { r0 = __builtin_nontemporal_load((const u32x4*)((base) + (size_t)(F.tid >> 4) * PW + (F.tid & 15) * 8)); r1 = __builtin_nontemporal_load((const u32x4*)((base) + (size_t)((F.tid >> 4) + 32) * PW + (F.tid & 15) * 8)); } while (0)
#define HG_TILE_ST(raw, r0, r1) do { *(LAS u32x4*)((raw) + (F.tid >> 4) * 272 + (F.tid & 15) * 16) = r0; *(LAS u32x4*)((raw) + ((F.tid >> 4) + 32) * 272 + (F.tid & 15) * 16) = r1; } while (0)
__device__ __forceinline__ void p3_hgrn_u(Frame& F, int ui0, int ui1) {
    const bf16_t* PROJ = (const bf16_t*)(F.ws + WS_PROJ);
    bf16_t* UT = (bf16_t*)(F.ws + WS_UT); float* DEC = (float*)(F.ws + WS_DECAY);
    LAS unsigned char* KDT = F.lds; LAS unsigned char* VT = F.lds + 18432; LAS float* SEG = (LAS float*)(F.lds + 36864);
    LAS unsigned char* RZ0 = F.lds + 40960; LAS unsigned char* RZ1 = RZ0 + 17408; LAS unsigned char* RV = RZ1 + 17408;
    const int d = F.tid & 127, seg = F.tid >> 7;
    const int we = F.wave >> 1, wd = F.wave & 1, fr = F.lane & 15, fq = F.lane >> 4;
    for (int ui = ui0; ui < ui1; ++ui) { const int u = F.bid + ui * F.G; if (u >= 1024) break;
        const int bh = u >> 5, n = u & 31, b = bh >> 3, h = bh & 7; const size_t m0 = (size_t)b * SEQ + n * 64;
        { u32x4 a0, a1, b0, b1, c0, c1; const bf16_t* base = PROJ + m0 * PW + h * 128;
          HG_TILE_LD(a0, a1, base + C_FF); HG_TILE_LD(b0, b1, base + C_FB); HG_TILE_LD(c0, c1, base + C_IN);
          HG_TILE_ST(RZ0, a0, a1); HG_TILE_ST(RZ1, b0, b1); HG_TILE_ST(RV, c0, c1); }
        __syncthreads();
        { float vv[16];
#pragma unroll
          for (int ii = 0; ii < 16; ++ii) vv[ii] = bf2f(*(const LAS unsigned short*)(RV + (16 * seg + ii) * 272 + d * 2));
          pack16_store(VT + d * 144 + seg * 32, vv); }
#pragma unroll
        for (int dir = 0; dir < 2; ++dir) {
            float bb[16], kk[16], total; const float lb = hgrn_lower_bound(F.hgrn_lb, dir, h * 128 + d);
            if (dir == 0) gate_scan<0>(RZ0, lb, SEG, d, seg, bb, kk, total); else gate_scan<1>(RZ1, lb, SEG, d, seg, bb, kk, total);
            float kd[16];
#pragma unroll
            for (int ii = 0; ii < 16; ++ii) kd[ii] = kk[ii] * fexp(total - bb[ii]);
            pack16_store(KDT + d * 144 + seg * 32, kd);
            const int ud = u * 2 + dir;
            if (seg == 0) DEC[(size_t)ud * 128 + d] = fexp(total);
            __syncthreads();
            f32x4 acc[2][4];
#pragma unroll
            for (int te = 0; te < 2; ++te)
#pragma unroll
                for (int td = 0; td < 4; ++td) acc[te][td] = (f32x4){0.f, 0.f, 0.f, 0.f};
#pragma unroll
            for (int ks = 0; ks < 2; ++ks) {
                bf16x8 bv[2], av[4];
#pragma unroll
                for (int te = 0; te < 2; ++te) bv[te] = *(const LAS bf16x8*)(VT + (32 * we + 16 * te + fr) * 144 + (ks * 4 + fq) * 16);
#pragma unroll
                for (int td = 0; td < 4; ++td) av[td] = *(const LAS bf16x8*)(KDT + (64 * wd + 16 * td + fr) * 144 + (ks * 4 + fq) * 16);
#pragma unroll
                for (int te = 0; te < 2; ++te)
#pragma unroll
                    for (int td = 0; td < 4; ++td) acc[te][td] = __builtin_amdgcn_mfma_f32_16x16x32_bf16(av[td], bv[te], acc[te][td], 0, 0, 0);
            }
            bf16_t* ut = UT + (size_t)ud * 16384;
#pragma unroll
            for (int te = 0; te < 2; ++te)
#pragma unroll
                for (int td = 0; td < 4; ++td) { u32x2 w; w.x = cvt_pk_bf16_safe(acc[te][td][0], acc[te][td][1]); w.y = cvt_pk_bf16_safe(acc[te][td][2], acc[te][td][3]);
                    *(u32x2*)(ut + (size_t)(32 * we + 16 * te + fr) * 128 + 64 * wd + 16 * td + 4 * fq) = w; }
            __syncthreads();
        }
    }
}

__device__ __forceinline__ void p4_scan(Frame& F) {
    const bf16_t* UT = (const bf16_t*)(F.ws + WS_UT); const float* DEC = (const float*)(F.ws + WS_DECAY); bf16_t* SP = (bf16_t*)(F.ws + WS_SPREV);
    LAS float* DL = (LAS float*)F.lds;
    const int el = F.tid >> 5, d4 = F.tid & 31;
    for (int item = F.bid; item < 512; item += F.G) {
        const int sq = item >> 3, e = (item & 7) * 16 + el, bh = sq >> 1, dir = sq & 1;
        u32x2 uw[32];
#pragma unroll
        for (int n = 0; n < 32; ++n) { const size_t ud = (size_t)(bh * 32 + n) * 2 + dir; uw[n] = __builtin_nontemporal_load((const u32x2*)(UT + ud * 16384 + e * 128 + 4 * d4)); }
        __syncthreads();
#pragma unroll
        for (int q = 0; q < 2; ++q) { const int id = F.tid + NTHR * q, n = id >> 5, c4 = id & 31; const size_t ud = (size_t)(bh * 32 + n) * 2 + dir;
            *(LAS f32x4*)(DL + n * 128 + 4 * c4) = *(const f32x4*)(DEC + ud * 128 + 4 * c4); }
        __syncthreads();
        f32x4 st = {0.f, 0.f, 0.f, 0.f};
#pragma unroll
        for (int j = 0; j < 32; ++j) { const int n = dir == 0 ? j : 31 - j; const size_t ud = (size_t)(bh * 32 + n) * 2 + dir;
            u32x2 w; w.x = cvt_pk_bf16_safe(st[0], st[1]); w.y = cvt_pk_bf16_safe(st[2], st[3]);
            *(u32x2*)(SP + ud * 16384 + e * 128 + 4 * d4) = w;
            const u32x2 un = dir == 0 ? uw[j] : uw[31 - j];
            const f32x4 dd = *(const LAS f32x4*)(DL + n * 128 + 4 * d4);
            st = dd * st + (f32x4){bflo(un.x), bfhi(un.x), bflo(un.y), bfhi(un.y)}; }
    }
    __syncthreads();
}

__device__ __forceinline__ void p5_hgrn_out(Frame& F, int ui0, int ui1) {
    const bf16_t* PROJ = (const bf16_t*)(F.ws + WS_PROJ); const bf16_t* SPREV = (const bf16_t*)(F.ws + WS_SPREV); bf16_t* MIXED = (bf16_t*)(F.ws + WS_MIXED);
    LAS unsigned char* QD = F.lds; LAS unsigned char* KD = F.lds + 17408; LAS unsigned char* RZ0 = F.lds + 34816; LAS unsigned char* RZ1 = F.lds + 52224;
    LAS unsigned char* PP = F.lds + 69632; LAS unsigned char* VT = F.lds + 78848; LAS unsigned char* SPL = F.lds + 97280;
    LAS float* SEG = (LAS float*)(F.lds + 132096); LAS float* SSQ = (LAS float*)(F.lds + 134144);
    LAS unsigned char* RQ = QD; LAS unsigned char* RV = KD;
    const int d = F.tid & 127, seg = F.tid >> 7, fr = F.lane & 15, fq = F.lane >> 4;
    const int it = F.wave & 3, eh = F.wave >> 2;
    for (int ui = ui0; ui < ui1; ++ui) { const int u = F.bid + ui * F.G; if (u >= 1024) break;
        const int bh = u >> 5, n = u & 31, b = bh >> 3, h = bh & 7; const size_t m0 = (size_t)b * SEQ + n * 64;
        const int i = 16 * it + fr;
        u32x4 sp1[4]; u32x2 graw[4]; f32x4 nwv[4];
        { u32x4 a0, a1, b0, b1, c0, c1, d0, d1, sp0[4]; const bf16_t* base = PROJ + m0 * PW + h * 128;
          HG_TILE_LDNT(a0, a1, base + C_FF); HG_TILE_LDNT(b0, b1, base + C_FB); HG_TILE_LDNT(c0, c1, base + C_QR); HG_TILE_LDNT(d0, d1, base + C_IN);
          const bf16_t* spa = SPREV + (size_t)(u * 2) * 16384;
#pragma unroll
          for (int q = 0; q < 4; ++q) { const int id = F.tid + NTHR * q; sp0[q] = __builtin_nontemporal_load((const u32x4*)(spa + (id >> 4) * 128 + (id & 15) * 8)); }
#pragma unroll
          for (int q = 0; q < 4; ++q) { const int id = F.tid + NTHR * q; sp1[q] = __builtin_nontemporal_load((const u32x4*)(spa + 16384 + (id >> 4) * 128 + (id & 15) * 8)); }
#pragma unroll
          for (int te = 0; te < 4; ++te) { graw[te] = *(const u32x2*)(PROJ + (m0 + i) * PW + C_GO + h * 128 + 64 * eh + 16 * te + 4 * fq); nwv[te] = *(const f32x4*)(F.hgrn_norm_w + h * 128 + 64 * eh + 16 * te + 4 * fq); }
          HG_TILE_ST(RZ0, a0, a1); HG_TILE_ST(RZ1, b0, b1); HG_TILE_ST(RQ, c0, c1); HG_TILE_ST(RV, d0, d1);
#pragma unroll
          for (int q = 0; q < 4; ++q) { const int id = F.tid + NTHR * q; *(LAS u32x4*)(SPL + (id >> 4) * 272 + (id & 15) * 16) = sp0[q]; } }
        __syncthreads();
        float qs[16];
        { float vv[16];
#pragma unroll
          for (int ii = 0; ii < 16; ++ii) { vv[ii] = bf2f(*(const LAS unsigned short*)(RV + (16 * seg + ii) * 272 + d * 2)); const float q = bf2f(*(const LAS unsigned short*)(RQ + (16 * seg + ii) * 272 + d * 2)); qs[ii] = q * fast_sigmoid(q); }
          pack16_store(VT + d * 144 + seg * 32, vv); }
        f32x4 o[4];
#pragma unroll
        for (int te = 0; te < 4; ++te) o[te] = (f32x4){0.f, 0.f, 0.f, 0.f};
#pragma unroll
        for (int dir = 0; dir < 2; ++dir) {
            float bb[16], kk[16], total; const float lb = hgrn_lower_bound(F.hgrn_lb, dir, h * 128 + d);
            if (dir == 0) gate_scan<0>(RZ0, lb, SEG, d, seg, bb, kk, total); else gate_scan<1>(RZ1, lb, SEG, d, seg, bb, kk, total);
#pragma unroll
            for (int ii = 0; ii < 16; ++ii) { const int ir = 16 * seg + ii;
                *(LAS unsigned short*)(QD + ir * 272 + d * 2) = f2bf(qs[ii] * fexp(bb[ii]));
                *(LAS unsigned short*)(KD + ir * 272 + d * 2) = f2bf(kk[ii] * fexp(-bb[ii])); }
            if (dir == 1) {
#pragma unroll
                for (int q = 0; q < 4; ++q) { const int id = F.tid + NTHR * q; *(LAS u32x4*)(SPL + (id >> 4) * 272 + (id & 15) * 16) = sp1[q]; } }
            __syncthreads();
#pragma unroll
            for (int jj = 0; jj < 2; ++jj) { const int jt = 2 * eh + jj; f32x4 sacc = {0.f, 0.f, 0.f, 0.f};
#pragma unroll
                for (int ks = 0; ks < 4; ++ks) { const bf16x8 a = *(const LAS bf16x8*)(KD + (16 * jt + fr) * 272 + (ks * 4 + fq) * 16), bq = *(const LAS bf16x8*)(QD + (16 * it + fr) * 272 + (ks * 4 + fq) * 16);
                    sacc = __builtin_amdgcn_mfma_f32_16x16x32_bf16(a, bq, sacc, 0, 0, 0); }
                const int j0 = 16 * jt + 4 * fq; float pv[4];
#pragma unroll
                for (int r = 0; r < 4; ++r) { const int j = j0 + r; const bool keep = dir == 0 ? (j <= i) : (j >= i); pv[r] = keep ? sacc[r] : 0.f; }
                u32x2 w; w.x = cvt_pk_bf16(pv[0], pv[1]); w.y = cvt_pk_bf16(pv[2], pv[3]);
                *(LAS u32x2*)(PP + i * 144 + j0 * 2) = w; }
            __syncthreads();
#pragma unroll
            for (int ks = 0; ks < 2; ++ks) { const bf16x8 bp = *(const LAS bf16x8*)(PP + (16 * it + fr) * 144 + (ks * 4 + fq) * 16);
#pragma unroll
                for (int te = 0; te < 4; ++te) { const bf16x8 a = *(const LAS bf16x8*)(VT + (64 * eh + 16 * te + fr) * 144 + (ks * 4 + fq) * 16);
                    o[te] = __builtin_amdgcn_mfma_f32_16x16x32_bf16(a, bp, o[te], 0, 0, 0); } }
#pragma unroll
            for (int ks = 0; ks < 4; ++ks) { const bf16x8 bq = *(const LAS bf16x8*)(QD + (16 * it + fr) * 272 + (ks * 4 + fq) * 16);
#pragma unroll
                for (int te = 0; te < 4; ++te) { const bf16x8 a = *(const LAS bf16x8*)(SPL + (64 * eh + 16 * te + fr) * 272 + (ks * 4 + fq) * 16);
                    o[te] = __builtin_amdgcn_mfma_f32_16x16x32_bf16(a, bq, o[te], 0, 0, 0); } }
            __syncthreads();
        }
        float ss = 0.f;
#pragma unroll
        for (int te = 0; te < 4; ++te) ss += (o[te][0] * o[te][0] + o[te][1] * o[te][1]) + (o[te][2] * o[te][2] + o[te][3] * o[te][3]);
        ss += __shfl_xor(ss, 16); ss += __shfl_xor(ss, 32);
        if (fq == 0) SSQ[eh * 64 + i] = ss;
        __syncthreads();
        const float rs = __builtin_amdgcn_rsqf((SSQ[i] + SSQ[64 + i]) * (1.f / 128.f) + EPS);
#pragma unroll
        for (int te = 0; te < 4; ++te) { const int e = 64 * eh + 16 * te + 4 * fq; const f32x4 nw = nwv[te];
            const float g0 = bflo(graw[te].x), g1 = bfhi(graw[te].x), g2 = bflo(graw[te].y), g3 = bfhi(graw[te].y);
            u32x2 w; w.x = cvt_pk_bf16(o[te][0] * rs * nw[0] * g0 * fast_sigmoid(g0), o[te][1] * rs * nw[1] * g1 * fast_sigmoid(g1));
            w.y = cvt_pk_bf16(o[te][2] * rs * nw[2] * g2 * fast_sigmoid(g2), o[te][3] * rs * nw[3] * g3 * fast_sigmoid(g3));
            *(u32x2*)(MIXED + (m0 + i) * DM + 1024 + h * 128 + e) = w; }
        __syncthreads();
    }
}

__device__ __forceinline__ void p7_post_mixer(Frame& F) {
    const float* mod = (const float*)(F.ws + WS_MOD); const bf16_t* Y1 = (const bf16_t*)(F.ws + WS_Y1); bf16_t* X1 = (bf16_t*)(F.ws + WS_X1); unsigned char* H2 = F.ws + WS_H2;
    const bf16_t* WRH = (const bf16_t*)(F.ws + WS_WRT); const bf16_t* WRL = WRH + 32 * 2048;
    int* SLOT = (int*)(F.ws + WS_ROUTE + RT_SLOT); float* SGATE = (float*)(F.ws + WS_ROUTE + RT_SGATE); unsigned* ECNT = (unsigned*)(F.ws + WS_CTL + CTL_ECNT); unsigned char* XS = F.ws + WS_XS;
    LAS unsigned char* HTH = F.lds; LAS unsigned char* HTL = F.lds + 65792;
    LAS float* RED = (LAS float*)(F.lds + 131584); LAS float* LOG = (LAS float*)(F.lds + 147968); LAS int* LE = (LAS int*)(F.lds + 152064); LAS int* LR = LE + 128; LAS float* LG = (LAS float*)(LR + 128); LAS int* EB = (LAS int*)(LG + 128);
    const int fr = F.lane & 15, fq = F.lane >> 4;
    for (int rt = F.bid; rt < 256; rt += F.G) {
        const int b = rt >> 6; const float* mb = mod + (size_t)b * 12288;
        for (int pass = 0; pass < 2; ++pass) {
            for (int rr = 0; rr < 2; ++rr) { const int lr = 2 * F.wave + rr, row = rt * 32 + pass * 16 + lr;
                const f32x4* xr = (const f32x4*)(F.x + (size_t)row * DM) + F.lane; const u32x2* yr = (const u32x2*)(Y1 + (size_t)row * DM) + F.lane;
                f32x4 v[8]; float s = 0.f;
#pragma unroll
                for (int j = 0; j < 8; ++j) { const f32x4 g1 = *((const f32x4*)(mb + 4096) + F.lane + 64 * j); const u32x2 yw = yr[64 * j]; const f32x4 yv = {bflo(yw.x), bfhi(yw.x), bflo(yw.y), bfhi(yw.y)}; v[j] = __builtin_nontemporal_load(xr + 64 * j) * DN_ALPHA + g1 * yv; s += (v[j][0] + v[j][1]) + (v[j][2] + v[j][3]); }
                float mean = wave_sum(s) * (1.f / DM), s2 = 0.f;
#pragma unroll
                for (int j = 0; j < 8; ++j) { v[j] = v[j] - mean; s2 += (v[j][0] * v[j][0] + v[j][1] * v[j][1]) + (v[j][2] * v[j][2] + v[j][3] * v[j][3]); }
                float rstd = __builtin_amdgcn_rsqf(wave_sum(s2) * (1.f / DM) + EPS);
                s = 0.f;
                f32x4 pg[8], pb[8];
#pragma unroll
                for (int j = 0; j < 8; ++j) { pg[j] = *((const f32x4*)F.ln1_g + F.lane + 64 * j); pb[j] = *((const f32x4*)F.ln1_b + F.lane + 64 * j); }
#pragma unroll
                for (int j = 0; j < 8; ++j) { const f32x4 g = pg[j], bb = pb[j];
                    v[j] = v[j] * rstd * g + bb; { u32x2 xw; xw.x = cvt_pk_bf16(v[j][0], v[j][1]); xw.y = cvt_pk_bf16(v[j][2], v[j][3]); __builtin_nontemporal_store(xw, (u32x2*)(X1 + (size_t)row * DM) + F.lane + 64 * j); } s += (v[j][0] + v[j][1]) + (v[j][2] + v[j][3]); }
                mean = wave_sum(s) * (1.f / DM); s2 = 0.f;
#pragma unroll
                for (int j = 0; j < 8; ++j) { v[j] = v[j] - mean; s2 += (v[j][0] * v[j][0] + v[j][1] * v[j][1]) + (v[j][2] * v[j][2] + v[j][3] * v[j][3]); }
                rstd = __builtin_amdgcn_rsqf(wave_sum(s2) * (1.f / DM) + EPS);
#pragma unroll
                for (int j = 0; j < 8; ++j) { pg[j] = *((const f32x4*)(mb + 6144) + F.lane + 64 * j); pb[j] = *((const f32x4*)(mb + 8192) + F.lane + 64 * j); }
#pragma unroll
                for (int j = 0; j < 8; ++j) { const f32x4 sh = pg[j], sc = pb[j];
                    const f32x4 h = v[j] * rstd * (sc + 1.f) + sh;
                    u32x2 wh; wh.x = cvt_pk_bf16(h[0], h[1]); wh.y = cvt_pk_bf16(h[2], h[3]);
                    u32x2 wl; wl.x = cvt_pk_bf16(h[0] - bflo(wh.x), h[1] - bfhi(wh.x)); wl.y = cvt_pk_bf16(h[2] - bflo(wh.y), h[3] - bfhi(wh.y));
                    *((unsigned*)(H2 + (size_t)row * DM) + F.lane + 64 * j) = pk4_fp8(h[0], h[1], h[2], h[3]);
                    *(LAS u32x2*)(HTH + lr * 4112 + (4 * F.lane + 256 * j) * 2) = wh; *(LAS u32x2*)(HTL + lr * 4112 + (4 * F.lane + 256 * j) * 2) = wl; }
            }
            __syncthreads();
            { f32x4 acc[2] = {{0.f, 0.f, 0.f, 0.f}, {0.f, 0.f, 0.f, 0.f}};
#pragma unroll 2
              for (int ks = 0; ks < 8; ++ks) { const int k0 = 256 * F.wave + 32 * ks + 8 * fq;
                  const bf16x8 ah = *(const LAS bf16x8*)(HTH + fr * 4112 + k0 * 2), al = *(const LAS bf16x8*)(HTL + fr * 4112 + k0 * 2);
#pragma unroll
                  for (int et = 0; et < 2; ++et) { const bf16x8 bh = *(const bf16x8*)(WRH + (size_t)(et * 16 + fr) * 2048 + k0), bl = *(const bf16x8*)(WRL + (size_t)(et * 16 + fr) * 2048 + k0);
                      acc[et] = __builtin_amdgcn_mfma_f32_16x16x32_bf16(ah, bh, acc[et], 0, 0, 0);
                      acc[et] = __builtin_amdgcn_mfma_f32_16x16x32_bf16(al, bh, acc[et], 0, 0, 0);
                      acc[et] = __builtin_amdgcn_mfma_f32_16x16x32_bf16(ah, bl, acc[et], 0, 0, 0); } }
#pragma unroll
              for (int et = 0; et < 2; ++et)
#pragma unroll
                  for (int j = 0; j < 4; ++j) RED[(F.wave * 16 + 4 * fq + j) * 32 + et * 16 + fr] = acc[et][j]; }
            __syncthreads();
            { const int tok = F.tid >> 5, e = F.tid & 31; float s = F.b_router[e];
#pragma unroll
              for (int w = 0; w < 8; ++w) s += RED[(w * 16 + tok) * 32 + e];
              LOG[(pass * 16 + tok) * 32 + e] = s; }
            __syncthreads();
        }
        if (F.tid < 32) { const int t = rt * 32 + F.tid; unsigned taken = 0u; float tv[4]; int tix[4];
#pragma unroll
            for (int k = 0; k < 4; ++k) { float best = -3.0e38f; int bi = 0;
                for (int e = 0; e < 32; ++e) { const float v = LOG[F.tid * 32 + e]; if (!((taken >> e) & 1u) && v > best) { best = v; bi = e; } }
                taken |= 1u << bi; tv[k] = best; tix[k] = bi; }
            float ex[4], sum = 0.f;
#pragma unroll
            for (int k = 0; k < 4; ++k) { ex[k] = __expf(tv[k] - tv[0]); sum += ex[k]; }
            const float inv = 1.f / sum;
#pragma unroll
            for (int k = 0; k < 4; ++k) { LG[F.tid * 4 + k] = ex[k] * inv; LE[F.tid * 4 + k] = tix[k]; } }
        __syncthreads();
        if (F.tid < 32) { int cnt = 0; for (int a = 0; a < 128; ++a) if (LE[a] == F.tid) { LR[a] = cnt; ++cnt; }
            EB[F.tid] = cnt > 0 ? (int)__hip_atomic_fetch_add(ECNT + F.tid, (unsigned)cnt, __ATOMIC_RELAXED, __HIP_MEMORY_SCOPE_AGENT) : 0; }
        asm volatile("s_waitcnt vmcnt(0)" ::: "memory");
        __syncthreads();
        if (F.tid < 128) { const int e = LE[F.tid], slot = e * ECAP + EB[e] + LR[F.tid]; SLOT[rt * 128 + F.tid] = slot; SGATE[slot] = LG[F.tid]; LE[F.tid] = slot; }
        __syncthreads();
        { u32x4 rv[4][2];
#pragma unroll
          for (int i = 0; i < 4; ++i) { const u32x4* src = (const u32x4*)(H2 + (size_t)(rt * 32 + F.wave * 4 + i) * DM) + F.lane; rv[i][0] = __builtin_nontemporal_load(src); rv[i][1] = __builtin_nontemporal_load(src + 64); }
#pragma unroll
          for (int i = 0; i < 4; ++i)
#pragma unroll
              for (int k = 0; k < 4; ++k) { u32x4* dst = (u32x4*)(XS + (size_t)LE[(F.wave * 4 + i) * 4 + k] * DM) + F.lane; dst[0] = rv[i][0]; dst[64] = rv[i][1]; } }
        __syncthreads();
    }
}

__device__ __forceinline__ void route_tables(Frame& F) {
    const unsigned* ECNT = (const unsigned*)(F.ws + WS_CTL + CTL_ECNT); LAS int* tab = (LAS int*)(F.lds + LDS_TAB_OFF);
    __syncthreads();
    if (F.tid < 32) tab[F.tid] = (int)ECNT[F.tid];
    __syncthreads();
    if (F.tid == 0) { int t = 0;
        for (int g = 0; g < 8; ++g) {
            for (int j = 0; j < 4; ++j) { const int cnt = tab[4 * g + j], nt = (cnt + 255) >> 8, hf = (nt > 0 && cnt - (nt - 1) * 256 <= 128) ? 1 : 0; tab[64 + 8 * g + j] = t; t += nt - hf; }
            for (int j = 0; j < 4; ++j) { const int cnt = tab[4 * g + j], nt = (cnt + 255) >> 8, hf = (nt > 0 && cnt - (nt - 1) * 256 <= 128) ? 1 : 0; tab[64 + 8 * g + 4 + j] = t; t += hf; } }
        tab[128] = t; }
    __syncthreads();
}
__device__ __forceinline__ void p11_final(Frame& F) {
    const float* mod = (const float*)(F.ws + WS_MOD); const bf16_t* X1 = (const bf16_t*)(F.ws + WS_X1); const unsigned char* YB = F.ws + WS_YB; const int* SLOT = (const int*)(F.ws + WS_ROUTE + RT_SLOT);
    for (int row = F.bid * NWAVES + F.wave; row < MTOK; row += F.G * NWAVES) {
        const int b = row >> 11; const float* g2p = mod + (size_t)b * 12288 + 10240;
        const int s0 = SLOT[row * 4 + 0], s1 = SLOT[row * 4 + 1], s2i = SLOT[row * 4 + 2], s3 = SLOT[row * 4 + 3];
        const unsigned* y0 = (const unsigned*)(YB + (size_t)s0 * DM) + F.lane; const unsigned* y1 = (const unsigned*)(YB + (size_t)s1 * DM) + F.lane;
        const unsigned* y2 = (const unsigned*)(YB + (size_t)s2i * DM) + F.lane; const unsigned* y3 = (const unsigned*)(YB + (size_t)s3 * DM) + F.lane;
        const u32x2* xr = (const u32x2*)(X1 + (size_t)row * DM) + F.lane;
        f32x4 v[8]; float s = 0.f;
#pragma unroll
        for (int j = 0; j < 8; ++j) { const int a = (int)y0[64 * j], bq = (int)y1[64 * j], c = (int)y2[64 * j], dq = (int)y3[64 * j];
            const f32x2 a0 = __builtin_amdgcn_cvt_pk_f32_fp8(a, false), a1 = __builtin_amdgcn_cvt_pk_f32_fp8(a, true), b0 = __builtin_amdgcn_cvt_pk_f32_fp8(bq, false), b1 = __builtin_amdgcn_cvt_pk_f32_fp8(bq, true);
            const f32x2 c0 = __builtin_amdgcn_cvt_pk_f32_fp8(c, false), c1 = __builtin_amdgcn_cvt_pk_f32_fp8(c, true), d0 = __builtin_amdgcn_cvt_pk_f32_fp8(dq, false), d1 = __builtin_amdgcn_cvt_pk_f32_fp8(dq, true);
            f32x4 y; y[0] = ((a0.x + b0.x) + (c0.x + d0.x)) * (1.f / YB_SCALE); y[1] = ((a0.y + b0.y) + (c0.y + d0.y)) * (1.f / YB_SCALE);
            y[2] = ((a1.x + b1.x) + (c1.x + d1.x)) * (1.f / YB_SCALE); y[3] = ((a1.y + b1.y) + (c1.y + d1.y)) * (1.f / YB_SCALE);
            const f32x4 g2 = *((const f32x4*)g2p + F.lane + 64 * j);
            const u32x2 xw = xr[64 * j]; const f32x4 xv = {bflo(xw.x), bfhi(xw.x), bflo(xw.y), bfhi(xw.y)};
            v[j] = xv * DN_ALPHA + g2 * y; s += (v[j][0] + v[j][1]) + (v[j][2] + v[j][3]); }
        const float mean = wave_sum(s) * (1.f / DM); float s2 = 0.f;
#pragma unroll
        for (int j = 0; j < 8; ++j) { v[j] = v[j] - mean; s2 += (v[j][0] * v[j][0] + v[j][1] * v[j][1]) + (v[j][2] * v[j][2] + v[j][3] * v[j][3]); }
        const float rstd = __builtin_amdgcn_rsqf(wave_sum(s2) * (1.f / DM) + EPS);
        f32x4 pg[8], pb[8];
#pragma unroll
        for (int j = 0; j < 8; ++j) { pg[j] = *((const f32x4*)F.ln2_g + F.lane + 64 * j); pb[j] = *((const f32x4*)F.ln2_b + F.lane + 64 * j); }
#pragma unroll
        for (int j = 0; j < 8; ++j) __builtin_nontemporal_store(v[j] * rstd * pg[j] + pb[j], (f32x4*)(F.out + (size_t)row * DM) + F.lane + 64 * j);
    }
}

constexpr int NPHASE = 12;
struct Args { const float* in[21]; float* out; unsigned char* ws; int ph_lo, ph_hi; };
__global__ void __launch_bounds__(NTHR, 2) mega_fwd(Args args) {
    extern __shared__ __attribute__((aligned(16))) unsigned char lds_raw[];
    typedef const __attribute__((address_space(4))) Args* KArgP;
#define MKFRAME() Frame F; { int t_ = threadIdx.x; asm volatile("" : "+v"(t_)); KArgP ap = (KArgP)__builtin_amdgcn_kernarg_segment_ptr(); asm volatile("" : "+s"(ap)); \
    F.lds = (LAS unsigned char*)lds_raw; F.tid = t_; F.lane = t_ & 63; F.wave = __builtin_amdgcn_readfirstlane(t_ >> 6); F.G = gridDim.x; F.bid = blockIdx.x; \
    F.x = ap->in[0]; F.c = ap->in[1]; F.w_ada = ap->in[2]; F.b_ada = ap->in[3]; F.w_in = ap->in[4]; F.q_norm_w = ap->in[5]; F.k_norm_w = ap->in[6]; F.attn_norm_w = ap->in[7]; \
    F.hgrn_lb = ap->in[8]; F.hgrn_norm_w = ap->in[9]; F.w_out = ap->in[10]; F.ln1_g = ap->in[11]; F.ln1_b = ap->in[12]; F.w_router = ap->in[13]; F.b_router = ap->in[14]; \
    F.w1 = ap->in[15]; F.b1 = ap->in[16]; F.w2 = ap->in[17]; F.b2 = ap->in[18]; F.ln2_g = ap->in[19]; F.ln2_b = ap->in[20]; F.out = ap->out; F.ws = ap->ws; }
    for (int u = threadIdx.x; u < (LDS_BYTES - LDS_CTL_OFF) / 4; u += NTHR) ((LAS unsigned*)((LAS unsigned char*)lds_raw + LDS_CTL_OFF))[u] = 0u;
    __syncthreads();
#if MK_SPLIT
#define GRID_BAR() do { } while (0)
#else
    (void)xcd_barrier_post((unsigned*)(args.ws + WS_CTL) + 1024, (volatile LAS unsigned*)((LAS unsigned char*)lds_raw + LDS_CTL_OFF));
#define GRID_BAR() do { KArgP bp_ = (KArgP)__builtin_amdgcn_kernarg_segment_ptr(); asm volatile("" : "+s"(bp_)); XcdBarrier b_; b_.bar = (unsigned*)(bp_->ws + WS_CTL) + 1024; b_.x = xb_xcc_id(); b_.st = (volatile LAS unsigned*)((LAS unsigned char*)lds_raw + LDS_CTL_OFF); xcd_barrier(b_); } while (0)
#endif
#ifndef PH_MASK
#define PH_MASK 0xFFF
#endif
#define IN(k) ((((PH_MASK) >> (k)) & 1) && args.ph_lo <= (k) && (k) < args.ph_hi)
#define SEAM(k) do { if (IN(k) && IN((k) + 1 + ((k) == 7 ? 1 : 0))) GRID_BAR(); } while (0)
#define SG() (((int)blockIdx.x >> 3) & 3)
    if (IN(0)) { MKFRAME(); p0_adaln(F); p0_router_w(F); conv_items<false>(F, 0, 1088); conv_items<true>(F, CV0, CV_P2); } SEAM(0);
    if (IN(1)) { MKFRAME(); p1_ln_mod(F); } SEAM(1);
    if (IN(2)) { MKFRAME(); const int sg = SG(); pg8::PlainSched<4096> S; S.init(F.ws + WS_H, F.ws + WS_WIN_T, MTOK, PW, F.G, F.bid); pg8::EpiBf16Plain E{(bf16_t*)(F.ws + WS_PROJ), PW};
        S.window(0, sg); pg8::gemm_phase<pg8::EpiBf16Plain, pg8::PlainSched<4096>, false>(F.lds, S, E);
        conv_items<true>(F, CV_P2, CV_P2T);
        S.window(sg, 1 << 20); pg8::gemm_phase<pg8::EpiBf16Plain, pg8::PlainSched<4096>, false>(F.lds, S, E);
        { const int full = S.nwg / F.G, rem = S.nwg - full * F.G;
          if (rem > 0 && F.bid >= rem) conv_items<true>(F, CV_P2T, CV_P3, F.bid - rem, F.G - rem);
          else if (rem == 0) conv_items<true>(F, CV_P2T, CV_P3); } } SEAM(2);
    if (IN(3)) { MKFRAME(); const int sg = SG(); p3_kprep(F); p3_hgrn_u(F, 0, sg); conv_items<true>(F, CV_P3, CV_P4); p3_hgrn_u(F, sg, 1 << 20); } SEAM(3);
    if (IN(4)) { { MKFRAME(); if (SG() < 2) { conv_items<true>(F, CV_P4, CV_P5); p4_scan(F); } }
        { MKFRAME();
        const bf16_t* PROJ = (const bf16_t*)(F.ws + WS_PROJ); const bf16_t* KV = (const bf16_t*)(F.ws + WS_KV); bf16_t* MIXED = (bf16_t*)(F.ws + WS_MIXED);
        for (int u = F.bid; u < 256; u += F.G) { const int qb = u & 7, h = (u >> 3) & 7, b = u >> 6, kvh = h >> 2; const size_t m0 = (size_t)b * SEQ + qb * 256;
            att::attn_unit(PROJ + m0 * PW + C_Q + h * 128, KV + (size_t)b * SEQ * 512 + kvh * 128, KV + (size_t)b * SEQ * 512 + 256 + kvh * 128,
                           MIXED + m0 * DM + h * 128, F.q_norm_w, F.attn_norm_w + h * 128, qb * 256, SEQ, (char*)lds_raw); } }
        { MKFRAME(); if (SG() >= 2) { conv_items<true>(F, CV_P4, CV_P5); p4_scan(F); } }
    } SEAM(4);
    if (IN(5)) { MKFRAME(); const int sg = SG(); p5_hgrn_out(F, 0, sg); conv_items<true>(F, CV_P5, CV_P6); p5_hgrn_out(F, sg, 1 << 20); } SEAM(5);
    if (IN(6)) { MKFRAME(); const int sg = SG(); pg8::PlainSched<4096> S; S.init(F.ws + WS_MIXED, F.ws + WS_WOUT_T, MTOK, DM, F.G, F.bid); pg8::EpiBf16Plain E{(bf16_t*)(F.ws + WS_Y1), DM};
        if (sg < 2) conv_items<true>(F, CV_P6, CV_W2);
        pg8::gemm_phase<pg8::EpiBf16Plain, pg8::PlainSched<4096>, false>(F.lds, S, E);
        if (sg >= 2) conv_items<true>(F, CV_P6, CV_W2); } SEAM(6);
    if (IN(7)) { MKFRAME(); p7_post_mixer(F); } SEAM(7);
    if (IN(9)) { MKFRAME(); const int sg = SG(); route_tables(F); pg8::MoeSched<2048> S; S.init(F.ws + WS_XS, F.ws + WS_W1T, (const LAS int*)(F.lds + LDS_TAB_OFF) + 64, 16, F.G, F.bid);
        pg8::EpiSwiglu E{F.ws + WS_ACT, F.b1};
        const int rem9 = S.nwg % F.G, nshort = (rem9 > 0) ? F.G - rem9 : 0;
        const int w2t = (nshort * 12 < CVQ_W2T) ? nshort * 12 : CVQ_W2T;
        const int sg8 = ((int)blockIdx.x >> 3) & 7;
        S.window(0, sg8); pg8::gemm_phase<pg8::EpiSwiglu, pg8::MoeSched<2048>, true>(F.lds, S, E);
        conv_items<true>(F, CV_W2, CV_END - w2t);
        S.window(sg8, 1 << 20); pg8::gemm_phase<pg8::EpiSwiglu, pg8::MoeSched<2048>, true>(F.lds, S, E);
        if (w2t > 0 && F.bid >= rem9) conv_items<true>(F, CV_END - w2t, CV_END, F.bid - rem9, nshort); } SEAM(9);
    if (IN(10)) { MKFRAME(); route_tables(F); pg8::MoeSched<2048> S; S.init(F.ws + WS_ACT, F.ws + WS_W2T, (const LAS int*)(F.lds + LDS_TAB_OFF) + 64, 8, F.G, F.bid);
        pg8::EpiGate E{F.ws + WS_YB, F.b2, (const float*)(F.ws + WS_ROUTE + RT_SGATE)};
        pg8::gemm_phase<pg8::EpiGate, pg8::MoeSched<2048>, true>(F.lds, S, E); } SEAM(10);
    if (IN(11)) { MKFRAME(); p11_final(F); }
#undef IN
#undef SEAM
}

extern "C" void kernel_launch(void* const* d_in, const int* in_sizes, int n_in, void* d_out, int out_size, void* d_ws, size_t ws_size, hipStream_t stream) {
    static int grid = 0;
    if (grid == 0) {
        if (n_in != 21 || out_size != MTOK * DM || ws_size < WS_END) { fprintf(stderr, "kernel_launch: unexpected shapes (n_in %d out %d ws %zu, need ws >= %zu)\n", n_in, out_size, ws_size, (size_t)WS_END); grid = -1; return; }
        int dev = 0, cus = 0, per_cu = 0;
        if (hipGetDevice(&dev) != hipSuccess || hipDeviceGetAttribute(&cus, hipDeviceAttributeMultiprocessorCount, dev) != hipSuccess) { grid = -1; return; }
        if (hipFuncSetAttribute((const void*)mega_fwd, hipFuncAttributeMaxDynamicSharedMemorySize, LDS_BYTES) != hipSuccess) { fprintf(stderr, "kernel_launch: hipFuncSetAttribute failed\n"); grid = -1; return; }
        if (hipOccupancyMaxActiveBlocksPerMultiprocessor(&per_cu, (const void*)mega_fwd, NTHR, LDS_BYTES) != hipSuccess || per_cu < 1) { fprintf(stderr, "kernel_launch: occupancy query says %d\n", per_cu); (void)hipGetLastError(); }
        grid = cus;
    }
    if (grid < 0) return;
    (void)hipMemsetAsync((char*)d_ws + WS_CTL, 0, CTL_ZERO_BYTES, stream);
    Args a{};
    for (int i = 0; i < 21; ++i) a.in[i] = (const float*)d_in[i];
    a.out = (float*)d_out; a.ws = (unsigned char*)d_ws;
#if MK_SPLIT
#ifndef REP_MASK
#define REP_MASK 0
#endif
    for (int p = 0; p < NPHASE; ++p) { a.ph_lo = p; a.ph_hi = p + 1; hipLaunchKernelGGL(mega_fwd, dim3(grid), dim3(NTHR), LDS_BYTES, stream, a);
        if ((REP_MASK >> p) & 1) hipLaunchKernelGGL(mega_fwd, dim3(grid), dim3(NTHR), LDS_BYTES, stream, a); }
#else
    a.ph_lo = 0; a.ph_hi = NPHASE; hipLaunchKernelGGL(mega_fwd, dim3(grid), dim3(NTHR), LDS_BYTES, stream, a);
#endif
    const hipError_t le = hipPeekAtLastError();
    if (le != hipSuccess) fprintf(stderr, "kernel_launch: launch failed: %s\n", hipGetErrorName(le));
}
```

```cpp
#include <hip/hip_runtime.h>
#include <cstdio>
#include <cstdint>

#ifndef MK_SPLIT
#define MK_SPLIT 0
#endif

#define GAS __attribute__((address_space(1)))
#define LAS __attribute__((address_space(3)))
typedef unsigned short bf16_t;
typedef short bf16x8 __attribute__((ext_vector_type(8)));
typedef short s16x4 __attribute__((ext_vector_type(4)));
typedef float f32x2 __attribute__((ext_vector_type(2)));
typedef float f32x4 __attribute__((ext_vector_type(4)));
typedef float f32x16 __attribute__((ext_vector_type(16)));
typedef unsigned u32x2 __attribute__((ext_vector_type(2)));
typedef unsigned u32x4 __attribute__((ext_vector_type(4)));

constexpr int DM = 2048, NBATCH = 4, SEQ = 2048, MTOK = NBATCH * SEQ;
constexpr int PW = 6656;
constexpr int C_Q = 0, C_K = 1024, C_V = 1280, C_QR = 1536, C_FF = 2560, C_FB = 3584, C_IN = 4608, C_GO = 5632;
constexpr int NE = 32, TOPK = 4;
constexpr int ECAP = 8192, ECAP_TILES = ECAP / 256, MAXROWS = NE * ECAP;
constexpr float EPS = 1e-6f;
constexpr float DN_ALPHA = 1.189207115002721f;
constexpr int NWAVES = 8, NTHR = 512;

constexpr size_t MiB = 1u << 20;
constexpr size_t WS_CTL = 0, CTL_ZERO_BYTES = 64 * 1024;
constexpr size_t WS_MODP = 1 * MiB;
constexpr size_t WS_MOD = 3 * MiB;
constexpr size_t WS_ROUTE = 4 * MiB;
constexpr size_t WS_WRT = 6 * MiB;
constexpr size_t WS_WIN_T = 8 * MiB;
constexpr size_t WS_WOUT_T = 34 * MiB;
constexpr size_t WS_W1T = 64 * MiB;
constexpr size_t WS_W2T = 576 * MiB;
constexpr size_t WS_H = 832 * MiB;
constexpr size_t WS_H2 = 864 * MiB;
constexpr size_t WS_PROJ = 928 * MiB;
constexpr size_t WS_KV = 1032 * MiB;
constexpr size_t WS_UT = 1040 * MiB;
constexpr size_t WS_DECAY = 1168 * MiB;
constexpr size_t WS_SPREV = 1170 * MiB;
constexpr size_t WS_MIXED = 1234 * MiB;
constexpr size_t WS_Y1 = 1266 * MiB;
constexpr size_t WS_X1 = 1330 * MiB;
constexpr size_t WS_XS = 1394 * MiB;
constexpr size_t WS_ACT = 1906 * MiB;
constexpr size_t WS_YB = 2418 * MiB;
constexpr size_t WS_END = 3442 * MiB;
constexpr size_t CTL_ECNT = 32768;
constexpr size_t RT_TOKE = 0, RT_TOKG = 128 * 1024, RT_TOKR = 256 * 1024, RT_SLOT = 384 * 1024, RT_HIST = 512 * 1024, RT_SGATE = 576 * 1024;

constexpr int LDS_CTL_OFF = 156672, LDS_TAB_OFF = LDS_CTL_OFF + 256, LDS_BYTES = LDS_CTL_OFF + 2048;

__device__ __forceinline__ unsigned cvt_pk_bf16(float lo, float hi) { unsigned r; asm volatile("v_cvt_pk_bf16_f32 %0, %1, %2" : "=v"(r) : "v"(lo), "v"(hi)); return r; }
typedef __bf16 bf16x2_native __attribute__((ext_vector_type(2)));
__device__ __forceinline__ unsigned cvt_pk_bf16_safe(float lo, float hi) { const f32x2 v = {lo, hi}; const bf16x2_native r = __builtin_convertvector(v, bf16x2_native); return __builtin_bit_cast(unsigned, r); }
__device__ __forceinline__ float bf2f(unsigned short h) { return __uint_as_float((unsigned)h << 16); }
__device__ __forceinline__ float bflo(unsigned w) { return __uint_as_float(w << 16); }
__device__ __forceinline__ float bfhi(unsigned w) { return __uint_as_float(w & 0xffff0000u); }
__device__ __forceinline__ unsigned short f2bf(float f) { return (unsigned short)(cvt_pk_bf16(f, 0.f) & 0xffffu); }
__device__ __forceinline__ unsigned pk4_fp8(float a, float b, float c, float d) { int w = __builtin_amdgcn_cvt_pk_fp8_f32(a, b, 0, false); w = __builtin_amdgcn_cvt_pk_fp8_f32(c, d, w, true); return (unsigned)w; }
constexpr float W_SCALE = 64.f, ACT_SCALE = 4.f, YB_SCALE = 16.f;
__device__ __forceinline__ float wave_sum(float v) {
#pragma unroll
    for (int o = 1; o < 64; o <<= 1) v += __shfl_xor(v, o);
    return v;
}
__device__ __forceinline__ float fast_sigmoid(float x) { return __builtin_amdgcn_rcpf(1.f + __builtin_amdgcn_exp2f(-1.4426950408889634f * x)); }
__device__ __forceinline__ float fexp(float x) { return __builtin_amdgcn_exp2f(1.4426950408889634f * x); }
__device__ __forceinline__ float flog(float x) { return 0.6931471805599453f * __builtin_amdgcn_logf(x); }

#define XB_TMO      128
#define XB_XCNT(j)  (256  + 64 * (j))
#define XB_XSUB(j)  (1280 + 64 * (j))
#define XB_XGEN(j)  (2304 + 64 * (j))
#define XB_TOP      3328
#define XB_TOPGEN   3392
#define XCD_BAR_WORDS 3456
#define XB_SPIN_CAP (1u << 18)
__device__ __forceinline__ unsigned xb_ld(unsigned* p)              { return __hip_atomic_load(p, __ATOMIC_RELAXED, __HIP_MEMORY_SCOPE_AGENT); }
__device__ __forceinline__ unsigned xb_add(unsigned* p, unsigned v) { return __hip_atomic_fetch_add(p, v, __ATOMIC_RELAXED, __HIP_MEMORY_SCOPE_AGENT); }
__device__ __forceinline__ unsigned xb_xcc_id() { return (unsigned)__builtin_amdgcn_s_getreg((3 << 11) | 20) & 0xFu; }
#define XB_SPIN(cond, bar) do { unsigned _sp = 0; while (cond) { __builtin_amdgcn_s_sleep(1); \
    if ((++_sp & 255u) == 0u) { if (xb_ld(&(bar)[XB_TMO])) break; if (_sp > XB_SPIN_CAP) { atomicAdd(&(bar)[XB_TMO], 1u); break; } } } } while (0)
struct XcdBarrier { unsigned* bar; unsigned x; volatile LAS unsigned* st; };
__device__ __forceinline__ XcdBarrier xcd_barrier_post(unsigned* bar, volatile LAS unsigned* st) {
    XcdBarrier b; b.bar = bar; b.x = xb_xcc_id(); b.st = st;
    if (threadIdx.x == 0) (void)xb_add(&bar[XB_XCNT(b.x)], 1u);
    return b;
}
__device__ __forceinline__ void xcd_barrier_complete(unsigned* bar, unsigned x, unsigned& nloc, unsigned& nx) {
    const unsigned G = gridDim.x * gridDim.y * gridDim.z;
    unsigned sum, cnt, mine, sp = 0u;
    for (;;) {
        sum = 0u; cnt = 0u; mine = 0u;
#pragma unroll
        for (unsigned j = 0; j < 16; ++j) { const unsigned c = xb_ld(&bar[XB_XCNT(j)]); sum += c; cnt += (c > 0u) ? 1u : 0u; mine = (j == x) ? c : mine; }
        if (sum == G) break;
        __builtin_amdgcn_s_sleep(1);
        if ((++sp & 255u) == 0u) { if (xb_ld(&bar[XB_TMO])) break; if (sp > XB_SPIN_CAP) { atomicAdd(&bar[XB_TMO], 1u); break; } }
    }
    nloc = mine > 0u ? mine : 1u; nx = cnt > 0u ? cnt : 1u;
}
__device__ __forceinline__ void xcd_barrier(const XcdBarrier& b) {
    asm volatile("s_waitcnt vmcnt(0)" ::: "memory");
    __syncthreads();
    if (threadIdx.x == 0) {
        unsigned* bar = b.bar;
        __builtin_amdgcn_s_waitcnt(0);
        unsigned nloc = b.st[0], nx = b.st[1];
        if (nloc == 0u) { xcd_barrier_complete(bar, b.x, nloc, nx); b.st[0] = nloc; b.st[1] = nx; }
        const unsigned old = xb_add(&bar[XB_XSUB(b.x)], 1u);
        const unsigned gen = old / nloc;
        if (old + 1u == (gen + 1u) * nloc) {
            __builtin_amdgcn_fence(__ATOMIC_RELEASE, "agent");
            asm volatile("s_waitcnt vmcnt(0)" ::: "memory");
            const unsigned og = xb_add(&bar[XB_TOP], 1u);
            const unsigned tg = og / nx;
            if (og + 1u == (tg + 1u) * nx) xb_add(&bar[XB_TOPGEN], 1u);
            else XB_SPIN(xb_ld(&bar[XB_TOPGEN]) == tg, bar);
            __builtin_amdgcn_fence(__ATOMIC_ACQUIRE, "agent");
            xb_add(&bar[XB_XGEN(b.x)], 1u);
            asm volatile("s_waitcnt vmcnt(0)" ::: "memory");
        } else {
            XB_SPIN(xb_ld(&bar[XB_XGEN(b.x)]) == gen, bar);
            __builtin_amdgcn_fence(__ATOMIC_ACQUIRE, "agent");
            asm volatile("s_waitcnt vmcnt(0)" ::: "memory");
        }
    }
    __syncthreads();
}

namespace pg8 {
constexpr int BM = 256, BK = 64, HALF = 128, HTB = HALF * BK * 2, STAGE_BYTES = 8 * HTB, NXCD = 8, WGM = 8;
constexpr int GK = 2048;
__host__ __device__ __forceinline__ int lds_byte(int r, int c) { const int st = (r >> 4) * 2 + (c >> 5), rr = r & 15, cc = c & 31, ob = rr * 64 + cc * 2; return st * 1024 + (ob ^ (((ob >> 9) & 1) << 5)); }
__host__ __device__ __forceinline__ void stage_rc(int b, int& R, int& C) { const int st = b / 1024, sb = b % 1024, swz = sb ^ (((sb >> 9) & 1) << 5); R = (st >> 1) * 16 + swz / 64; C = (st & 1) * 32 + (swz % 64) / 2; }
__host__ __device__ __forceinline__ int perm32(int rho) { const int n = rho >> 4, i = rho & 15; return 8 * (i >> 2) + 4 * n + (i & 3); }

struct Unit { int pm, pn, e, half; };
template <int ROWB> struct TS { static constexpr size_t v = (size_t)BM * ROWB; };

__device__ __forceinline__ int xcd_remap(int wgid, int nwg) { const int q = nwg / NXCD, r = nwg % NXCD, xcd = wgid % NXCD, off = wgid / NXCD; return (xcd < r ? xcd * (q + 1) : r * (q + 1) + (xcd - r) * q) + off; }

template <int ROWB> struct PlainSched {
    const char* A; const char* B; int nM, nN, nwg, G, c, i0 = 0, i1 = 1 << 20;
    __device__ void window(int a, int b) { i0 = a; i1 = b; }
    __device__ void init(const void* A_, const void* B_, int M, int N, int G_, int c_) { A = (const char*)A_; B = (const char*)B_; nM = M / BM; nN = N / BM; nwg = nM * nN; G = G_; c = c_; }
    __device__ __forceinline__ bool next(int i, Unit& u) const {
        if (i + i0 >= i1) return false;
        const long L = (long)(i + i0) * G + c; if (L >= nwg) return false;
        const int wgid = xcd_remap((int)L, nwg);
        const int nig = WGM * nN, gid = wgid / nig, fm = gid * WGM, gsz = (nM - fm) < WGM ? (nM - fm) : WGM;
        u.pm = fm + ((wgid % nig) % gsz); u.pn = (wgid % nig) / gsz; u.e = 0; u.half = 0; return true;
    }
    __device__ __forceinline__ const char* aptr(const Unit& u) const { return A + (size_t)u.pm * TS<ROWB>::v; }
    __device__ __forceinline__ const char* bptr(const Unit& u) const { return B + (size_t)u.pn * TS<ROWB>::v; }
};
template <int ROWB> struct MoeSched {
    const char* A; const char* B; const LAS int* ps; int nN, nwg, G, c, i0 = 0, i1 = 1 << 20;
    __device__ void window(int a, int b) { i0 = a; i1 = b; }
    __device__ void init(const void* A_, const void* B_, const LAS int* ps_, int nN_, int G_, int c_) { A = (const char*)A_; B = (const char*)B_; ps = ps_; nN = nN_; nwg = ps_[64] * nN_; G = G_; c = c_; }
    __device__ __forceinline__ bool next(int i, Unit& u) const {
        if (i + i0 >= i1) return false;
        const long L = (long)(i + i0) * G + c; if (L >= nwg) return false;
        const int wgid = xcd_remap((int)L, nwg);
        int sidx = 0;
#pragma unroll 8
        for (int j = 1; j < 64; ++j) sidx += (wgid >= ps[j] * nN) ? 1 : 0;
        const int e = (sidx >> 3) * 4 + (sidx & 3), kind = (sidx >> 2) & 1, local = wgid - ps[sidx] * nN;
        int pn, r;
        if (kind == 0) { const int nt = ps[sidx + 1] - ps[sidx]; pn = local / nt; r = local % nt; }
        else { pn = local; r = ps[sidx - 3] - ps[sidx - 4]; }
        u.e = __builtin_amdgcn_readfirstlane(e); u.pn = __builtin_amdgcn_readfirstlane(pn); u.pm = __builtin_amdgcn_readfirstlane(e * ECAP_TILES + r); u.half = __builtin_amdgcn_readfirstlane(kind); return true;
    }
    __device__ __forceinline__ const char* aptr(const Unit& u) const { return A + (size_t)u.pm * TS<ROWB>::v; }
    __device__ __forceinline__ const char* bptr(const Unit& u) const { return B + ((size_t)u.e * nN + u.pn) * TS<ROWB>::v; }
};

struct EpiBf16Plain { static constexpr bool PERM = true; bf16_t* O; int ldc;
    __device__ __forceinline__ void operator()(const f32x4 (&acc)[2][2][4][2], const Unit& u, int wr, int wc, int fr, int fq) const {
        const int row0 = u.pm * BM + wr * 64 + fr, col0 = u.pn * BM + wc * 32 + 8 * fq;
#pragma unroll
        for (int ai = 0; ai < 2; ++ai)
#pragma unroll
            for (int m = 0; m < 4; ++m) { bf16_t* rowp = O + (size_t)(row0 + ai * HALF + m * 16) * ldc + col0;
#pragma unroll
                for (int bj = 0; bj < 2; ++bj) { const f32x4 v0 = acc[ai][bj][m][0], v1 = acc[ai][bj][m][1];
                    u32x4 w; w.x = cvt_pk_bf16(v0[0], v0[1]); w.y = cvt_pk_bf16(v0[2], v0[3]); w.z = cvt_pk_bf16(v1[0], v1[1]); w.w = cvt_pk_bf16(v1[2], v1[3]);
                    *(u32x4*)(rowp + bj * HALF) = w; } }
    }
};
struct EpiF32Plain { static constexpr bool PERM = false; float* C; int ldc;
    __device__ __forceinline__ void operator()(const f32x4 (&acc)[2][2][4][2], const Unit& u, int wr, int wc, int fr, int fq) const {
        const int row0 = u.pm * BM + wr * 64 + fr, col0 = u.pn * BM + wc * 32 + 4 * fq;
#pragma unroll
        for (int ai = 0; ai < 2; ++ai)
#pragma unroll
            for (int m = 0; m < 4; ++m) { float* rowp = C + (size_t)(row0 + ai * HALF + m * 16) * ldc + col0;
#pragma unroll
                for (int bj = 0; bj < 2; ++bj)
#pragma unroll
                    for (int n = 0; n < 2; ++n) *(f32x4*)(rowp + bj * HALF + n * 16) = acc[ai][bj][m][n]; }
    }
};
struct EpiSwiglu { static constexpr bool PERM = true; unsigned char* O; const float* b1;
    __device__ __forceinline__ void operator()(const f32x4 (&acc)[2][2][4][2], const Unit& u, int wr, int wc, int fr, int fq) const {
        const int row0 = u.pm * BM + wr * 64 + fr, col0 = u.pn * HALF + wc * 32 + 8 * fq;
        const float* bg = b1 + (size_t)u.e * 4096 + col0;
        f32x4 bgv[2], blv[2];
#pragma unroll
        for (int n = 0; n < 2; ++n) { bgv[n] = *(const f32x4*)(bg + 4 * n); blv[n] = *(const f32x4*)(bg + 2048 + 4 * n); }
#pragma unroll
        for (int ai = 0; ai < 2; ++ai) if (!(ai == 1 && u.half))
#pragma unroll
            for (int m = 0; m < 4; ++m) { unsigned char* rowp = O + (size_t)(row0 + ai * HALF + m * 16) * 2048 + col0;
                float r[8];
#pragma unroll
                for (int n = 0; n < 2; ++n) { const f32x4 g = acc[ai][0][m][n] * (1.f / W_SCALE) + bgv[n], l = acc[ai][1][m][n] * (1.f / W_SCALE) + blv[n];
#pragma unroll
                    for (int j = 0; j < 4; ++j) { const float gg = fminf(g[j], 7.0f), ll = fminf(fmaxf(l[j], -7.0f), 7.0f);
                        r[n * 4 + j] = ACT_SCALE * gg * fast_sigmoid(1.702f * gg) * (ll + 1.0f); } }
                u32x2 w; w.x = pk4_fp8(r[0], r[1], r[2], r[3]); w.y = pk4_fp8(r[4], r[5], r[6], r[7]);
                *(u32x2*)rowp = w; }
    }
};
struct EpiGate { static constexpr bool PERM = true; unsigned char* O; const float* b2; const float* sgate;
    __device__ __forceinline__ void operator()(const f32x4 (&acc)[2][2][4][2], const Unit& u, int wr, int wc, int fr, int fq) const {
        const int row0 = u.pm * BM + wr * 64 + fr, col0 = u.pn * BM + wc * 32 + 8 * fq;
        const float* bb = b2 + (size_t)u.e * 2048 + col0;
        f32x4 bv[2][2];
#pragma unroll
        for (int bj = 0; bj < 2; ++bj)
#pragma unroll
            for (int n = 0; n < 2; ++n) bv[bj][n] = *(const f32x4*)(bb + bj * HALF + 4 * n);
        float gts[2][4];
#pragma unroll
        for (int ai = 0; ai < 2; ++ai)
#pragma unroll
            for (int m = 0; m < 4; ++m) gts[ai][m] = sgate[row0 + ai * HALF + m * 16];
#pragma unroll
        for (int ai = 0; ai < 2; ++ai) if (!(ai == 1 && u.half))
#pragma unroll
            for (int m = 0; m < 4; ++m) { const int row = row0 + ai * HALF + m * 16; const float gt = gts[ai][m] * YB_SCALE; unsigned char* rowp = O + (size_t)row * 2048 + col0;
#pragma unroll
                for (int bj = 0; bj < 2; ++bj) { const f32x4 v0 = (acc[ai][bj][m][0] * (1.f / (W_SCALE * ACT_SCALE)) + bv[bj][0]) * gt, v1 = (acc[ai][bj][m][1] * (1.f / (W_SCALE * ACT_SCALE)) + bv[bj][1]) * gt;
                    u32x2 w; w.x = pk4_fp8(v0[0], v0[1], v0[2], v0[3]); w.y = pk4_fp8(v1[0], v1[1], v1[2], v1[3]);
                    *(u32x2*)(rowp + bj * HALF) = w; } }
    }
};

typedef int i32x4 __attribute__((ext_vector_type(4)));
typedef int i32x8 __attribute__((ext_vector_type(8)));
__device__ __forceinline__ bf16x8 lo8(i32x8 v) { const i32x4 a = __builtin_shufflevector(v, v, 0, 1, 2, 3); return __builtin_bit_cast(bf16x8, a); }
__device__ __forceinline__ bf16x8 hi8(i32x8 v) { const i32x4 a = __builtin_shufflevector(v, v, 4, 5, 6, 7); return __builtin_bit_cast(bf16x8, a); }
__device__ __forceinline__ i32x8 cat8(bf16x8 lo, bf16x8 hi) { const i32x4 a = __builtin_bit_cast(i32x4, lo), b = __builtin_bit_cast(i32x4, hi); return __builtin_shufflevector(a, b, 0, 1, 2, 3, 4, 5, 6, 7); }
template <class Epi, class Sched, bool FP8>
__device__ __forceinline__ void gemm_phase(LAS unsigned char* lds, const Sched& S, const Epi& E) {
    int tid_ = threadIdx.x; asm volatile("" : "+v"(tid_));
    const int tid = tid_, wid = __builtin_amdgcn_readfirstlane(tid >> 6), lane = tid & 63, wr = wid >> 2, wc = wid & 3, fr = lane & 15, fq = lane >> 4;
    constexpr int K = FP8 ? GK / 2 : GK, nt = K / BK;
    unsigned voffA[2], voffB[2];
#pragma unroll
    for (int i = 0; i < 2; ++i) { int R, C; stage_rc(tid * 16 + i * 8192, R, C); const int Rb = Epi::PERM ? ((R & ~31) + perm32(R & 31)) : R;
        voffA[i] = (unsigned)(R * K + C) * 2u; voffB[i] = (unsigned)(Rb * K + C) * 2u; }
    constexpr size_t kstep = (size_t)(BK * 2);
    constexpr size_t hstep = (size_t)HALF * K * 2;
    const unsigned ldsw = (unsigned)wid * 1024u;
    const int aoff = lds_byte(wr * 64 + fr, fq * 8), boff = lds_byte(wc * 32 + fr, fq * 8);
#define PG8_SA(b, h) (((b) * 2 + (h)) * HTB)
#define PG8_SB(b, h) ((4 + (b) * 2 + (h)) * HTB)
#define PG8_STAGE(bufoff, gbase, voff) do { _Pragma("unroll") for (int _i = 0; _i < 2; ++_i) \
        __builtin_amdgcn_global_load_lds((const unsigned*)((const char*)(gbase) + (voff)[_i]), (LAS unsigned*)(lds + (bufoff) + ldsw + _i * 8192), 16, 0, 0); } while (0)
#define PG8_LDA(dst, b, h) do { _Pragma("unroll") for (int m = 0; m < 4; ++m) dst[m] = cat8(*(const LAS bf16x8*)(lds + PG8_SA(b, h) + aoff + m * 2048), *(const LAS bf16x8*)(lds + PG8_SA(b, h) + aoff + m * 2048 + 1024)); } while (0)
#define PG8_LDB(dst, b, h) do { _Pragma("unroll") for (int n = 0; n < 2; ++n) dst[n] = cat8(*(const LAS bf16x8*)(lds + PG8_SB(b, h) + boff + n * 2048), *(const LAS bf16x8*)(lds + PG8_SB(b, h) + boff + n * 2048 + 1024)); } while (0)
#define PG8_MMA(ai, bj, At, Bt) do { __builtin_amdgcn_s_setprio(1); _Pragma("unroll") for (int m = 0; m < 4; ++m) _Pragma("unroll") for (int n = 0; n < 2; ++n) { \
        if constexpr (FP8) asm volatile("v_mfma_scale_f32_16x16x128_f8f6f4 %0, %1, %2, %0, %3, %3 op_sel_hi:[0,0,0]" : "+v"(acc[ai][bj][m][n]) : "v"(Bt[n]), "v"(At[m]), "v"(fp8_one));   \
        else { acc[ai][bj][m][n] = __builtin_amdgcn_mfma_f32_16x16x32_bf16(lo8(Bt[n]), lo8(At[m]), acc[ai][bj][m][n], 0, 0, 0); \
               acc[ai][bj][m][n] = __builtin_amdgcn_mfma_f32_16x16x32_bf16(hi8(Bt[n]), hi8(At[m]), acc[ai][bj][m][n], 0, 0, 0); } } \
        __builtin_amdgcn_s_setprio(0); } while (0)
#define PG8_WAIT_V(n) asm volatile("s_waitcnt vmcnt(" #n ")" ::: "memory")
#define PG8_WAIT_L(n) asm volatile("s_waitcnt lgkmcnt(" #n ")" ::: "memory")
#define PG8_BAR __builtin_amdgcn_s_barrier()
#define PG8_SCHED __builtin_amdgcn_sched_barrier(0)
#define PG8_USE_AT if constexpr (FP8) asm volatile("" :: "v"(At[0]), "v"(At[1]), "v"(At[2]), "v"(At[3]))
    Unit cur, nxt; int ui = 0;
    if (!S.next(0, cur)) return;
    f32x4 acc[2][2][4][2];
#pragma unroll
    for (int a = 0; a < 2; ++a)
#pragma unroll
        for (int b = 0; b < 2; ++b)
#pragma unroll
            for (int m = 0; m < 4; ++m)
#pragma unroll
                for (int n = 0; n < 2; ++n) acc[a][b][m][n] = (f32x4){0.f, 0.f, 0.f, 0.f};
    i32x8 At[4], B0[2], B1[2]; const int fp8_one = 0x7F7F7F7F; (void)fp8_one;
    const char* cA = S.aptr(cur); const char* cB = S.bptr(cur);
    PG8_STAGE(PG8_SB(0, 0), cB, voffB); PG8_STAGE(PG8_SB(0, 1), cB + hstep, voffB); PG8_STAGE(PG8_SA(0, 0), cA, voffA); PG8_STAGE(PG8_SA(0, 1), cA + hstep, voffA);
    if (wr == 1) PG8_BAR;
    PG8_WAIT_V(2); PG8_BAR;
    PG8_STAGE(PG8_SB(1, 0), cB + kstep, voffB); PG8_STAGE(PG8_SA(1, 0), cA + kstep, voffA); PG8_STAGE(PG8_SB(1, 1), cB + hstep + kstep, voffB);
    PG8_WAIT_V(6); PG8_BAR;
    for (;;) {
        const bool has_next = S.next(ui + 1, nxt);
        const char* nA = has_next ? S.aptr(nxt) : cA; const char* nB = has_next ? S.bptr(nxt) : cB;
        for (int t = 0; t < nt; t += 2) {
            const bool last = (t == nt - 2);
            const char* a1 = cA + (size_t)(t + 1) * kstep;
            const char* a2 = last ? nA : cA + (size_t)(t + 2) * kstep; const char* b2 = last ? nB : cB + (size_t)(t + 2) * kstep;
            const char* a3 = a2 + kstep; const char* b3 = b2 + kstep;
            PG8_LDB(B0, 0, 0); PG8_LDB(B1, 0, 1); PG8_SCHED; PG8_LDA(At, 0, 0); PG8_STAGE(PG8_SA(1, 1), a1 + hstep, voffA);
            PG8_WAIT_V(8); PG8_WAIT_L(0); PG8_BAR; PG8_MMA(0, 0, At, B0); PG8_MMA(0, 1, At, B1); PG8_BAR; PG8_SCHED;
            PG8_LDA(At, 0, 1); PG8_STAGE(PG8_SB(0, 0), b2, voffB); PG8_STAGE(PG8_SB(0, 1), b2 + hstep, voffB); PG8_STAGE(PG8_SA(0, 0), a2, voffA);
            PG8_WAIT_V(8); PG8_WAIT_L(0); PG8_BAR; PG8_USE_AT; if (!cur.half) { PG8_MMA(1, 0, At, B0); PG8_MMA(1, 1, At, B1); } PG8_BAR; PG8_SCHED;
            PG8_LDB(B0, 1, 0); PG8_LDB(B1, 1, 1); PG8_SCHED; PG8_LDA(At, 1, 0); PG8_STAGE(PG8_SA(0, 1), a2 + hstep, voffA);
            PG8_WAIT_V(8); PG8_WAIT_L(0); PG8_BAR; PG8_MMA(0, 0, At, B0); PG8_MMA(0, 1, At, B1); PG8_BAR; PG8_SCHED;
            PG8_LDA(At, 1, 1); PG8_STAGE(PG8_SB(1, 0), b3, voffB); PG8_STAGE(PG8_SB(1, 1), b3 + hstep, voffB); PG8_STAGE(PG8_SA(1, 0), a3, voffA);
            PG8_WAIT_V(8); PG8_WAIT_L(0); PG8_BAR; PG8_USE_AT; if (!cur.half) { PG8_MMA(1, 0, At, B0); PG8_MMA(1, 1, At, B1); } PG8_BAR; PG8_SCHED;
        }
        if (wr == 0) PG8_BAR;
        E(acc, cur, wr, wc, fr, fq);
        if (!has_next) break;
#pragma unroll
        for (int a = 0; a < 2; ++a)
#pragma unroll
            for (int b = 0; b < 2; ++b)
#pragma unroll
                for (int m = 0; m < 4; ++m)
#pragma unroll
                    for (int n = 0; n < 2; ++n) acc[a][b][m][n] = (f32x4){0.f, 0.f, 0.f, 0.f};
        cur = nxt; cA = nA; cB = nB; ++ui;
        if (wr == 1) PG8_BAR;
    }
    PG8_WAIT_V(0);
    PG8_BAR;
#undef PG8_SA
#undef PG8_SB
#undef PG8_STAGE
#undef PG8_LDA
#undef PG8_LDB
#undef PG8_MMA
#undef PG8_WAIT_V
#undef PG8_WAIT_L
#undef PG8_BAR
#undef PG8_SCHED
#undef PG8_USE_AT
}
}

namespace att {
constexpr int D = 128, NW = 8, QBLK = 32, KVBLK = 64;
constexpr float SCALE = 0.088388347648318440f;
constexpr float THR = 8.f;
constexpr int LDQ = PW, LDK = 512, LDO = 2048;
constexpr size_t SHM_V = KVBLK * D * 2, SHM_K = KVBLK * D * 2, SHM_ATTN = 2 * SHM_V + 2 * SHM_K + NW * 64 * 4;
#define KSWZ(row, colB) ((row) * 256 + ((colB) ^ (((row) & 7) << 4)))
#define SBAR() __builtin_amdgcn_sched_barrier(0)
__device__ __forceinline__ int crow(int r, int hi) { return (r & 3) + 8 * (r >> 2) + 4 * hi; }
__device__ __forceinline__ void partialSM(f32x16& p0, f32x16& p1, float& m_reg, float& mn, float& alpha) {
  constexpr float C = SCALE * 1.4426950408889634f;
  float pmax = p0[0]; for (int r = 1; r < 16; ++r) pmax = fmaxf(pmax, p0[r]); for (int r = 0; r < 16; ++r) pmax = fmaxf(pmax, p1[r]);
  { auto rr = __builtin_amdgcn_permlane32_swap(__float_as_uint(pmax), __float_as_uint(pmax), false, false);
    pmax = fmaxf(__uint_as_float(rr[0]), __uint_as_float(rr[1])); }
  if (__builtin_expect(__all(pmax - m_reg <= THR / SCALE), 1)) { mn = m_reg; alpha = 1.f; }
  else { mn = fmaxf(m_reg, pmax); alpha = __builtin_amdgcn_exp2f((m_reg - mn) * C); m_reg = mn; }
  float mnC = -mn * C;
  for (int r = 0; r < 16; ++r) p0[r] = fmaf(p0[r], C, mnC); for (int r = 0; r < 16; ++r) p1[r] = fmaf(p1[r], C, mnC);
  for (int r = 0; r < 16; ++r) p0[r] = __builtin_amdgcn_exp2f(p0[r]);
}
__device__ __forceinline__ void finishSM(f32x16& p0, f32x16& p1, float alpha, float& l_reg, bf16x8& pa0, bf16x8& pa1, bf16x8& pa2, bf16x8& pa3) {
  for (int r = 0; r < 16; ++r) p1[r] = __builtin_amdgcn_exp2f(p1[r]);
  float ps = 0; for (int r = 0; r < 16; ++r) ps += p0[r]; for (int r = 0; r < 16; ++r) ps += p1[r];
  { auto rr = __builtin_amdgcn_permlane32_swap(__float_as_uint(ps), __float_as_uint(ps), false, false);
    ps = __uint_as_float(rr[0]) + __uint_as_float(rr[1]); }
  l_reg = l_reg * alpha + ps;
#define PK4(P, BASE, OUT) do { unsigned a0 = cvt_pk_bf16(P[BASE + 0], P[BASE + 1]), a1 = cvt_pk_bf16(P[BASE + 2], P[BASE + 3]);   \
    unsigned b0 = cvt_pk_bf16(P[BASE + 4], P[BASE + 5]), b1 = cvt_pk_bf16(P[BASE + 6], P[BASE + 7]);                              \
    auto r0 = __builtin_amdgcn_permlane32_swap(a0, b0, false, false); auto r1 = __builtin_amdgcn_permlane32_swap(a1, b1, false, false); \
    u32x4 w = {r0[0], r1[0], r0[1], r1[1]}; OUT = *reinterpret_cast<bf16x8*>(&w); } while (0)
  PK4(p0, 0, pa0); PK4(p0, 8, pa1); PK4(p1, 0, pa2); PK4(p1, 8, pa3);
#undef PK4
}
__device__ __forceinline__ void qkt(f32x16& p0, f32x16& p1, const bf16_t* Ks, const bf16x8* qr, int r32, int hi) {
  p0 = f32x16{}; p1 = f32x16{};
  for (int d0 = 0; d0 < 8; ++d0) { int cb = (d0 * 16 + hi * 8) * 2;
    bf16x8 b0 = *reinterpret_cast<const bf16x8*>((const char*)Ks + KSWZ(r32, cb));
    bf16x8 b1 = *reinterpret_cast<const bf16x8*>((const char*)Ks + KSWZ(32 + r32, cb));
    p0 = __builtin_amdgcn_mfma_f32_32x32x16_bf16(b0, qr[d0], p0, 0, 0, 0);
    p1 = __builtin_amdgcn_mfma_f32_32x32x16_bf16(b1, qr[d0], p1, 0, 0, 0); }
}
__device__ __forceinline__ int v_st(int k, int c) { const int kk = (k & ~0xC) | ((k & 4) << 1) | ((k & 8) >> 1); return ((kk >> 3) * 4 + (c >> 5)) * 512 + ((kk & 7) * 32 + (c & 31)) * 2; }
__device__ __forceinline__ int v_rd_base(int lane) { return ((lane & 3) << 3) | (((lane >> 2) & 3) << 6) | (((lane >> 4) & 1) << 5) | (((lane >> 5) & 1) << 8); }
constexpr int v_rd_off(int d0, int ks, int half) { return d0 * 512 + ks * 4096 + half * 2048; }
template <int OFF> __device__ __forceinline__ s16x4 tr_read(int vb) {
  s16x4 r; asm volatile("ds_read_b64_tr_b16 %0, %1 offset:%2" : "=&v"(r) : "v"(vb), "i"(OFF) : "memory"); return r;
}
template <int D0> __device__ __forceinline__ void pv_one(f32x16& od, int vb, bf16x8 pa0, bf16x8 pa1, bf16x8 pa2, bf16x8 pa3) {
  const s16x4 l0 = tr_read<v_rd_off(D0, 0, 0)>(vb), h0 = tr_read<v_rd_off(D0, 0, 1)>(vb), l1 = tr_read<v_rd_off(D0, 1, 0)>(vb), h1 = tr_read<v_rd_off(D0, 1, 1)>(vb);
  const s16x4 l2 = tr_read<v_rd_off(D0, 2, 0)>(vb), h2 = tr_read<v_rd_off(D0, 2, 1)>(vb), l3 = tr_read<v_rd_off(D0, 3, 0)>(vb), h3 = tr_read<v_rd_off(D0, 3, 1)>(vb);
  asm volatile("s_waitcnt lgkmcnt(0)" ::: "memory"); SBAR();
#define PK(L, H) (bf16x8){L[0], L[1], L[2], L[3], H[0], H[1], H[2], H[3]}
  od = __builtin_amdgcn_mfma_f32_32x32x16_bf16(pa0, PK(l0, h0), od, 0, 0, 0);
  od = __builtin_amdgcn_mfma_f32_32x32x16_bf16(pa1, PK(l1, h1), od, 0, 0, 0);
  od = __builtin_amdgcn_mfma_f32_32x32x16_bf16(pa2, PK(l2, h2), od, 0, 0, 0);
  od = __builtin_amdgcn_mfma_f32_32x32x16_bf16(pa3, PK(l3, h3), od, 0, 0, 0);
#undef PK
}
__device__ __forceinline__ void pv_d0(f32x16* o, int vb, bf16x8 pa0, bf16x8 pa1, bf16x8 pa2, bf16x8 pa3) {
  pv_one<0>(o[0], vb, pa0, pa1, pa2, pa3); pv_one<1>(o[1], vb, pa0, pa1, pa2, pa3); pv_one<2>(o[2], vb, pa0, pa1, pa2, pa3); pv_one<3>(o[3], vb, pa0, pa1, pa2, pa3);
}
__device__ __forceinline__ void load_q(bf16x8* qr, const bf16_t* Qw, const float* qnw, int pos, int hi) {
  float qf[64]; float ssq = 0.f;
#pragma unroll
  for (int d0 = 0; d0 < 8; ++d0) { const u32x4 raw = *reinterpret_cast<const u32x4*>(Qw + d0 * 16);
#pragma unroll
    for (int i = 0; i < 4; ++i) { const float a = bflo(raw[i]), b = bfhi(raw[i]); qf[d0 * 8 + 2 * i] = a; qf[d0 * 8 + 2 * i + 1] = b; ssq += a * a + b * b; } }
  ssq += __shfl_xor(ssq, 32);
  const float rn = __builtin_amdgcn_rsqf(ssq * (1.f / 128.f) + EPS);
#pragma unroll
  for (int d0 = 0; d0 < 8; ++d0) { const f32x4 w0 = *reinterpret_cast<const f32x4*>(qnw + d0 * 16 + hi * 8), w1 = *reinterpret_cast<const f32x4*>(qnw + d0 * 16 + hi * 8 + 4);
#pragma unroll
    for (int i = 0; i < 4; ++i) { qf[d0 * 8 + i] *= rn * w0[i]; qf[d0 * 8 + 4 + i] *= rn * w1[i]; } }
  const float prow = (float)(pos / 64 - 16), pcol = (float)(pos % 64 - 32);
#pragma unroll
  for (int d0 = 0; d0 < 2; ++d0)
#pragma unroll
    for (int i = 0; i < 8; ++i) { const int j = d0 * 16 + hi * 8 + i;
      const float invf = __builtin_amdgcn_exp2f(-(float)j * 0.41524101186092029f);
      float rv = prow * invf * 0.15915494309189535f; rv -= rintf(rv);
      float s = __builtin_amdgcn_sinf(rv), c = __builtin_amdgcn_cosf(rv);
      float x1 = qf[d0 * 8 + i], x2 = qf[(d0 + 2) * 8 + i]; qf[d0 * 8 + i] = x1 * c - x2 * s; qf[(d0 + 2) * 8 + i] = x2 * c + x1 * s;
      rv = pcol * invf * 0.15915494309189535f; rv -= rintf(rv);
      s = __builtin_amdgcn_sinf(rv); c = __builtin_amdgcn_cosf(rv);
      x1 = qf[(d0 + 4) * 8 + i]; x2 = qf[(d0 + 6) * 8 + i]; qf[(d0 + 4) * 8 + i] = x1 * c - x2 * s; qf[(d0 + 6) * 8 + i] = x2 * c + x1 * s; }
#pragma unroll
  for (int d0 = 0; d0 < 8; ++d0) { u32x4 w = {cvt_pk_bf16(qf[d0 * 8 + 0], qf[d0 * 8 + 1]), cvt_pk_bf16(qf[d0 * 8 + 2], qf[d0 * 8 + 3]), cvt_pk_bf16(qf[d0 * 8 + 4], qf[d0 * 8 + 5]), cvt_pk_bf16(qf[d0 * 8 + 6], qf[d0 * 8 + 7])};
    qr[d0] = *reinterpret_cast<bf16x8*>(&w); }
}
__device__ __forceinline__ void attn_unit(const bf16_t* __restrict__ Qb, const bf16_t* __restrict__ Kh, const bf16_t* __restrict__ Vh,
                                          bf16_t* __restrict__ Ob, const float* qnw, const float* anw, int pos0, int seq, char* lds) {
  int tid_ = threadIdx.x; asm volatile("" : "+v"(tid_));
  asm volatile("" : "+s"(qnw), "+s"(anw));
  const int tid = tid_, wid = tid >> 6, lane = tid & 63, r32 = lane & 31, hi = lane >> 5;
  bf16_t* V_lds = (bf16_t*)lds; bf16_t* K_lds = (bf16_t*)(lds + 2 * SHM_V);
  float* ws = (float*)(lds + 2 * SHM_V + 2 * SHM_K) + wid * 64; float* li_l = ws; float* al_l = ws + 32;
  float m_reg = -1e30f, l_reg = 0; f32x16 o[4] = {}; bf16x8 qr[8];
  load_q(qr, Qb + (long)(wid * QBLK + r32) * LDQ + hi * 8, qnw, pos0 + wid * QBLK + r32, hi);
  const int sr = tid >> 4, sc = (tid & 15) * 8, vst0 = v_st(sr, sc), vst1 = v_st(32 + sr, sc);
  const int vb0 = (int)(uintptr_t)V_lds + v_rd_base(lane);
  struct { bf16x8 vs0, vs1, ks0, ks1; } sr_[2];
#define LD8(p) (*reinterpret_cast<const bf16x8*>(p))
#define SLOAD(i, k0) do { sr_[i].vs0 = LD8(&Vh[(long)((k0) + sr) * LDK + sc]); sr_[i].vs1 = LD8(&Vh[(long)((k0) + 32 + sr) * LDK + sc]); \
    sr_[i].ks0 = LD8(&Kh[(long)((k0) + sr) * LDK + sc]); sr_[i].ks1 = LD8(&Kh[(long)((k0) + 32 + sr) * LDK + sc]); } while (0)
#define SWRITE(b, i) do { *(bf16x8*)((char*)V_lds + (b) * SHM_V + vst0) = sr_[i].vs0;          \
    *(bf16x8*)((char*)V_lds + (b) * SHM_V + vst1) = sr_[i].vs1; int kc = sc * 2;               \
    *(bf16x8*)((char*)K_lds + (b) * SHM_K + KSWZ(sr, kc)) = sr_[i].ks0;                       \
    *(bf16x8*)((char*)K_lds + (b) * SHM_K + KSWZ(32 + sr, kc)) = sr_[i].ks1; } while (0)
#define SWAIT() asm volatile("s_waitcnt vmcnt(4)" ::: "memory")
#define RESC(a) do { if (__any((a) < 1.f)) { if (hi == 0) al_l[r32] = (a); asm volatile("s_waitcnt lgkmcnt(0)" ::: "memory"); \
    for (int d = 0; d < 4; ++d) for (int r = 0; r < 16; ++r) o[d][r] *= al_l[crow(r, hi)]; } } while (0)
  f32x16 pA0, pA1, pB0, pB1; float mnA, mnB, alA, alB; bf16x8 pa0, pa1, pa2, pa3; const int NT = seq / KVBLK;
  constexpr int SE = 0, SO = 1;
  SLOAD(SE, 0); asm volatile("s_waitcnt vmcnt(0)" ::: "memory"); SWRITE(0, SE); __syncthreads();
  qkt(pA0, pA1, K_lds, qr, r32, hi); partialSM(pA0, pA1, m_reg, mnA, alA);
  SLOAD(SO, KVBLK); if (2 < NT) SLOAD(SE, 2 * KVBLK);
  SWAIT(); SWRITE(1, SO); __syncthreads();
  for (int j = 1; j + 1 < NT; j += 2) {
    SBAR(); qkt(pB0, pB1, (bf16_t*)((char*)K_lds + SHM_K), qr, r32, hi);
    finishSM(pA0, pA1, alA, l_reg, pa0, pa1, pa2, pa3); SBAR();
    SLOAD(SO, (j + 2) * KVBLK); SBAR();
    pv_d0(o, vb0, pa0, pa1, pa2, pa3); partialSM(pB0, pB1, m_reg, mnB, alB);
    __syncthreads(); SWAIT(); SWRITE(0, SE);
    RESC(alB); __syncthreads();
    SBAR(); qkt(pA0, pA1, K_lds, qr, r32, hi);
    finishSM(pB0, pB1, alB, l_reg, pa0, pa1, pa2, pa3); SBAR();
    if (j + 3 < NT) SLOAD(SE, (j + 3) * KVBLK); SBAR();
    pv_d0(o, vb0 + (int)SHM_V, pa0, pa1, pa2, pa3); partialSM(pA0, pA1, m_reg, mnA, alA);
    __syncthreads(); SWAIT(); SWRITE(1, SO);
    RESC(alA); __syncthreads();
  }
  SBAR(); qkt(pB0, pB1, (bf16_t*)((char*)K_lds + SHM_K), qr, r32, hi);
  finishSM(pA0, pA1, alA, l_reg, pa0, pa1, pa2, pa3); SBAR();
  pv_d0(o, vb0, pa0, pa1, pa2, pa3); partialSM(pB0, pB1, m_reg, mnB, alB);
  __syncthreads(); RESC(alB);
  finishSM(pB0, pB1, alB, l_reg, pa0, pa1, pa2, pa3); SBAR();
  pv_d0(o, vb0 + (int)SHM_V, pa0, pa1, pa2, pa3);
  if (hi == 0) li_l[r32] = l_reg; asm volatile("s_waitcnt lgkmcnt(0)" ::: "memory");
  bf16_t* Ow = Ob + (long)(wid * QBLK) * LDO;
  char* ost = lds + 69632 + wid * 8704;
  float aw[4];
#pragma unroll
  for (int d0 = 0; d0 < 4; ++d0) aw[d0] = anw[d0 * 32 + r32];
#pragma unroll
  for (int r = 0; r < 16; ++r) { const int orow = crow(r, hi); const float rli = __builtin_amdgcn_rcpf(li_l[orow]);
    float ss = 0.f;
#pragma unroll
    for (int d0 = 0; d0 < 4; ++d0) { const float v = o[d0][r] * rli; o[d0][r] = v; ss += v * v; }
#pragma unroll
    for (int x = 1; x < 32; x <<= 1) ss += __shfl_xor(ss, x);
    const float rs = __builtin_amdgcn_rsqf(ss * (1.f / 128.f) + EPS);
#pragma unroll
    for (int d0 = 0; d0 < 4; ++d0) *(unsigned short*)(ost + orow * 272 + (d0 * 32 + r32) * 2) = f2bf(o[d0][r] * rs * aw[d0]); }
  asm volatile("s_waitcnt lgkmcnt(0)" ::: "memory");
#pragma unroll
  for (int q = 0; q < 8; ++q) { const int id = q * 64 + lane, row = id >> 4, ch = id & 15;
    const u32x4 w = *(const u32x4*)(ost + row * 272 + ch * 16);
    *(u32x4*)(Ow + (long)row * LDO + ch * 8) = w; }
  __syncthreads();
#undef LD8
#undef SLOAD
#undef SWRITE
#undef SWAIT
#undef RESC
}
}

struct Frame {
    LAS unsigned char* lds; int tid, lane, wave, G, bid;
    const float *x, *c, *w_ada, *b_ada, *w_in, *q_norm_w, *k_norm_w, *attn_norm_w, *hgrn_lb, *hgrn_norm_w, *w_out, *ln1_g, *ln1_b, *w_router, *b_router, *w1, *b1, *w2, *b2, *ln2_g, *ln2_b;
    float* out; unsigned char* ws;
};

__device__ __forceinline__ void p0_adaln(Frame& F) {
    LAS float* sc = (LAS float*)F.lds;
    LAS float* red = sc + 1024;
    float* modp = (float*)(F.ws + WS_MODP);
    for (int it = F.bid; it < 768; it += F.G) {
        const int cc = it % 96, ks = it / 96, c0 = cc * 128, k0 = ks * 256;
        __syncthreads();
        for (int i = F.tid; i < 1024; i += NTHR) { const int b = i >> 8, k = i & 255; const float v = F.c[b * 2048 + k0 + k]; sc[i] = v / (1.f + __expf(-v)); }
        __syncthreads();
        const int col4 = F.tid & 31, kr = F.tid >> 5;
        f32x4 a0 = {0, 0, 0, 0}, a1 = a0, a2 = a0, a3 = a0;
#pragma unroll 8
        for (int i = 0; i < 16; ++i) { const int k = kr + 16 * i; const f32x4 w = __builtin_nontemporal_load((const f32x4*)(F.w_ada + (size_t)(k0 + k) * 12288 + c0 + 4 * col4));
            a0 += w * sc[k]; a1 += w * sc[256 + k]; a2 += w * sc[512 + k]; a3 += w * sc[768 + k]; }
        *(LAS f32x4*)(red + (kr * 4 + 0) * 128 + 4 * col4) = a0; *(LAS f32x4*)(red + (kr * 4 + 1) * 128 + 4 * col4) = a1;
        *(LAS f32x4*)(red + (kr * 4 + 2) * 128 + 4 * col4) = a2; *(LAS f32x4*)(red + (kr * 4 + 3) * 128 + 4 * col4) = a3;
        __syncthreads();
        { const int b = F.tid >> 7, col = F.tid & 127; float s = 0.f;
#pragma unroll
          for (int r = 0; r < 16; ++r) s += red[(r * 4 + b) * 128 + col];
          modp[(size_t)(ks * 4 + b) * 12288 + c0 + col] = s; }
    }
    __syncthreads();
}
struct TrItem { const float* src; bf16_t* dst; int N; };
__device__ __forceinline__ TrItem tr_decode(Frame& F, int it, int& k0, int& n0, int& drow0) {
    TrItem t; int kt, ntile;
    if (it < 832) { t.src = F.w_in; t.N = PW; t.dst = (bf16_t*)(F.ws + WS_WIN_T); ntile = 52; kt = it / ntile; n0 = (it % ntile) * 128; drow0 = n0; }
    else if (it < 1088) { it -= 832; t.src = F.w_out; t.N = 2048; t.dst = (bf16_t*)(F.ws + WS_WOUT_T); ntile = 16; kt = it / ntile; n0 = (it % ntile) * 128; drow0 = n0; }
    else if (it < 1088 + 16384) { it -= 1088; const int e = it >> 9; it &= 511; t.src = F.w1 + (size_t)e * 2048 * 4096; t.N = 4096; t.dst = (bf16_t*)(F.ws + WS_W1T + (size_t)e * 4096 * 2048);
        kt = it >> 5; n0 = (it & 31) * 128; drow0 = n0 < 2048 ? (n0 >> 7) * 256 : ((n0 - 2048) >> 7) * 256 + 128; }
    else { it -= 1088 + 16384; const int e = it >> 8; it &= 255; t.src = F.w2 + (size_t)e * 2048 * 2048; t.N = 2048; t.dst = (bf16_t*)(F.ws + WS_W2T + (size_t)e * 2048 * 2048);
        kt = it >> 4; n0 = (it & 15) * 128; drow0 = n0; }
    k0 = kt * 128; return t;
}
struct TrParm { const float* src; unsigned char* dst; int N, k0, n0, dr0; };
__device__ __forceinline__ TrParm tr_parm(Frame& F, int it) { TrParm q; int k0, n0, dr0; const TrItem t = tr_decode(F, it, k0, n0, dr0); q.src = t.src; q.dst = (unsigned char*)t.dst; q.N = t.N; q.k0 = k0; q.n0 = n0; q.dr0 = dr0; return q; }
template <bool FP8>
__device__ __forceinline__ void tr_emit(Frame& F, const f32x4 (&cur)[8], const TrParm& q, LAS unsigned char* tl, int n4, int kg) {
    if constexpr (FP8) {
#pragma unroll
        for (int i = 0; i < 4; ++i) { u32x2 w; w.x = pk4_fp8(cur[0][i] * W_SCALE, cur[1][i] * W_SCALE, cur[2][i] * W_SCALE, cur[3][i] * W_SCALE); w.y = pk4_fp8(cur[4][i] * W_SCALE, cur[5][i] * W_SCALE, cur[6][i] * W_SCALE, cur[7][i] * W_SCALE);
            const int n = 4 * n4 + i; *(LAS u32x2*)(tl + n * 128 + ((kg ^ (2 * (n4 & 7))) * 8)) = w; }
        __syncthreads();
#pragma unroll
        for (int qq = 0; qq < 2; ++qq) { const int id = F.tid + NTHR * qq, n = id >> 3, pc = id & 7, kgl = (2 * pc) ^ (2 * ((n >> 2) & 7));
            const u32x4 w = *(LAS u32x4*)(tl + n * 128 + pc * 16);
            __builtin_nontemporal_store(w, (u32x4*)(q.dst + (size_t)(q.dr0 + n) * 2048 + q.k0 + 8 * kgl)); }
    } else {
#pragma unroll
        for (int i = 0; i < 4; ++i) { u32x4 w; w.x = cvt_pk_bf16(cur[0][i], cur[1][i]); w.y = cvt_pk_bf16(cur[2][i], cur[3][i]); w.z = cvt_pk_bf16(cur[4][i], cur[5][i]); w.w = cvt_pk_bf16(cur[6][i], cur[7][i]);
            const int n = 4 * n4 + i; *(LAS u32x4*)(tl + n * 256 + ((kg ^ (n4 & 15)) * 16)) = w; }
        __syncthreads();
#pragma unroll
        for (int qq = 0; qq < 4; ++qq) { const int id = F.tid + NTHR * qq, n = id >> 4, pc = id & 15, kgl = pc ^ ((n >> 2) & 15);
            const u32x4 w = *(LAS u32x4*)(tl + n * 256 + pc * 16);
            *(u32x4*)(q.dst + ((size_t)(q.dr0 + n) * 2048 + q.k0 + 8 * kgl) * 2) = w; }
    }
}
#define TR_LOAD(buf, q) do { _Pragma("unroll") for (int j_ = 0; j_ < 8; ++j_) buf[j_] = __builtin_nontemporal_load((const f32x4*)((q).src + (size_t)((q).k0 + 8 * kg + j_) * (q).N + (q).n0 + 4 * n4)); } while (0)
template <bool FP8>
__device__ __forceinline__ void conv_items(Frame& F, int it0, int it1, int idx = -1, int stride = 0) {
    const int n4 = F.tid & 31, kg = F.tid >> 5, G = stride > 0 ? stride : F.G;
    int nx = it0 + (idx >= 0 ? idx : F.bid); if (nx >= it1) return;
    TrParm qa = tr_parm(F, nx), qb = qa, qc = qa, qd = qa; f32x4 a[8], b[8], c[8], d[8];
    bool va = true, vb, vc, vd;
    TR_LOAD(a, qa); nx += G;
    vb = nx < it1; if (vb) { qb = tr_parm(F, nx); TR_LOAD(b, qb); } nx += G;
    vc = nx < it1; if (vc) { qc = tr_parm(F, nx); TR_LOAD(c, qc); } nx += G;
    vd = nx < it1; if (vd) { qd = tr_parm(F, nx); TR_LOAD(d, qd); } nx += G;
    for (;;) {
        tr_emit<FP8>(F, a, qa, F.lds, n4, kg);
        va = nx < it1; if (va) { qa = tr_parm(F, nx); TR_LOAD(a, qa); } nx += G;
        if (!vb) break;
        tr_emit<FP8>(F, b, qb, F.lds + 32768, n4, kg);
        vb = nx < it1; if (vb) { qb = tr_parm(F, nx); TR_LOAD(b, qb); } nx += G;
        if (!vc) break;
        tr_emit<FP8>(F, c, qc, F.lds, n4, kg);
        vc = nx < it1; if (vc) { qc = tr_parm(F, nx); TR_LOAD(c, qc); } nx += G;
        if (!vd) break;
        tr_emit<FP8>(F, d, qd, F.lds + 32768, n4, kg);
        vd = nx < it1; if (vd) { qd = tr_parm(F, nx); TR_LOAD(d, qd); } nx += G;
        if (!va) break;
    }
    __syncthreads();
}
template <bool W2>
__device__ __forceinline__ TrParm tr_parm_x(Frame& F, int it) {
    TrParm q;
    if constexpr (!W2) { it -= 1088; const int e = it >> 9, r = it & 511, nn = r & 31; q.src = F.w1 + (size_t)e * 2048 * 4096; q.N = 4096; q.dst = F.ws + WS_W1T + (size_t)e * 4096 * 2048;
        q.k0 = (r >> 5) * 128; q.n0 = nn * 128; q.dr0 = (nn & 15) * 256 + (nn >> 4) * 128; }
    else { it -= 1088 + 16384; const int e = it >> 8, r = it & 255, nn = r & 15; q.src = F.w2 + (size_t)e * 2048 * 2048; q.N = 2048; q.dst = F.ws + WS_W2T + (size_t)e * 2048 * 2048;
        q.k0 = (r >> 4) * 128; q.n0 = nn * 128; q.dr0 = q.n0; }
    return q;
}
#define TRA_LOAD(buf, q) do { _Pragma("unroll") for (int j_ = 0; j_ < 8; ++j_) { const f32x4* p_ = (const f32x4*)((q).src + (size_t)((q).k0 + 8 * kg + j_) * (q).N + (q).n0 + 4 * n4); \
        asm volatile("global_load_dwordx4 %0, %1, off nt" : "=v"(buf[j_]) : "v"(p_) : "memory"); } } while (0)
#define TRA_WAIT(N, buf) asm volatile("s_waitcnt vmcnt(" #N ")" : "+v"(buf[0]), "+v"(buf[1]), "+v"(buf[2]), "+v"(buf[3]), "+v"(buf[4]), "+v"(buf[5]), "+v"(buf[6]), "+v"(buf[7]) :: "memory")
template <bool W2>
__device__ __forceinline__ void conv_pipe(Frame& F, int it0, int it1, int idx = -1, int stride = 0) {
    const int n4 = F.tid & 31, kg = F.tid >> 5, G = stride > 0 ? stride : F.G;
    const int first = it0 + (idx >= 0 ? idx : F.bid); if (first >= it1) return;
    const int n = (it1 - first + G - 1) / G;
    if (n < 8) { conv_items<true>(F, it0, it1, idx, stride); return; }
    f32x4 a[8], b[8], c[8], d[8];
    TrParm qa = tr_parm_x<W2>(F, first), qb = tr_parm_x<W2>(F, first + G), qc = tr_parm_x<W2>(F, first + 2 * G), qd = tr_parm_x<W2>(F, first + 3 * G);
    TRA_LOAD(a, qa); TRA_LOAD(b, qb); TRA_LOAD(c, qc); TRA_LOAD(d, qd);
    int nx = first + 4 * G, left = n - 8;
    TRA_WAIT(24, a); tr_emit<true>(F, a, qa, F.lds, n4, kg);         qa = tr_parm_x<W2>(F, nx);         TRA_LOAD(a, qa);
    TRA_WAIT(26, b); tr_emit<true>(F, b, qb, F.lds + 32768, n4, kg); qb = tr_parm_x<W2>(F, nx + G);     TRA_LOAD(b, qb);
    TRA_WAIT(28, c); tr_emit<true>(F, c, qc, F.lds, n4, kg);         qc = tr_parm_x<W2>(F, nx + 2 * G); TRA_LOAD(c, qc);
    TRA_WAIT(30, d); tr_emit<true>(F, d, qd, F.lds + 32768, n4, kg); qd = tr_parm_x<W2>(F, nx + 3 * G); TRA_LOAD(d, qd);
    nx += 4 * G;
    while (left >= 4) {
        TRA_WAIT(30, a); tr_emit<true>(F, a, qa, F.lds, n4, kg);         qa = tr_parm_x<W2>(F, nx);         TRA_LOAD(a, qa);
        TRA_WAIT(30, b); tr_emit<true>(F, b, qb, F.lds + 32768, n4, kg); qb = tr_parm_x<W2>(F, nx + G);     TRA_LOAD(b, qb);
        TRA_WAIT(30, c); tr_emit<true>(F, c, qc, F.lds, n4, kg);         qc = tr_parm_x<W2>(F, nx + 2 * G); TRA_LOAD(c, qc);
        TRA_WAIT(30, d); tr_emit<true>(F, d, qd, F.lds + 32768, n4, kg); qd = tr_parm_x<W2>(F, nx + 3 * G); TRA_LOAD(d, qd);
        nx += 4 * G; left -= 4;
    }
    TRA_WAIT(30, a); tr_emit<true>(F, a, qa, F.lds, n4, kg);         if (left > 0) { qa = tr_parm_x<W2>(F, nx);         TRA_LOAD(a, qa); }
    TRA_WAIT(22, b); tr_emit<true>(F, b, qb, F.lds + 32768, n4, kg); if (left > 1) { qb = tr_parm_x<W2>(F, nx + G);     TRA_LOAD(b, qb); }
    TRA_WAIT(14, c); tr_emit<true>(F, c, qc, F.lds, n4, kg);         if (left > 2) { qc = tr_parm_x<W2>(F, nx + 2 * G); TRA_LOAD(c, qc); }
    TRA_WAIT(6, d);  tr_emit<true>(F, d, qd, F.lds + 32768, n4, kg);
    if (left > 0) { TRA_WAIT(6, a); tr_emit<true>(F, a, qa, F.lds, n4, kg); }
    if (left > 1) { TRA_WAIT(6, b); tr_emit<true>(F, b, qb, F.lds + 32768, n4, kg); }
    if (left > 2) { TRA_WAIT(6, c); tr_emit<true>(F, c, qc, F.lds, n4, kg); }
    __syncthreads();
}
constexpr int CVQ_W2T = 1536;
constexpr int CV0 = 1088;
constexpr int CVQ_P0 = 0, CVQ_P2 = 7168, CVQ_P2T = 3456, CVQ_P3 = 512, CVQ_P4 = 3584, CVQ_P5 = 512, CVQ_P6 = 1152;
static_assert(CVQ_P0 + CVQ_P2 + CVQ_P2T + CVQ_P3 + CVQ_P4 + CVQ_P5 + CVQ_P6 == 16384, "w1 conversion quotas");
constexpr int CV_P2 = CV0 + CVQ_P0, CV_P2T = CV_P2 + CVQ_P2, CV_P3 = CV_P2T + CVQ_P2T, CV_P4 = CV_P3 + CVQ_P3, CV_P5 = CV_P4 + CVQ_P4, CV_P6 = CV_P5 + CVQ_P5, CV_W2 = CV_P6 + CVQ_P6, CV_END = CV_W2 + 8192;
__device__ __forceinline__ void p0_router_w(Frame& F) {
    bf16_t* hi = (bf16_t*)(F.ws + WS_WRT); bf16_t* lo = hi + 32 * 2048;
    for (int i = F.bid * NTHR + F.tid; i < 2048 * 32; i += F.G * NTHR) { const int k = i >> 5, e = i & 31; const float w = F.w_router[i];
        const unsigned short h = f2bf(w); hi[e * 2048 + k] = h; lo[e * 2048 + k] = f2bf(w - bf2f(h)); }
}

__device__ __forceinline__ void p1_ln_mod(Frame& F) {
    const float* modp = (const float*)(F.ws + WS_MODP); float* mod = (float*)(F.ws + WS_MOD);
    for (int i = F.bid * NTHR + F.tid; i < 4 * 12288; i += F.G * NTHR) { float s = F.b_ada[i % 12288];
#pragma unroll
        for (int ks = 0; ks < 8; ++ks) s += modp[(size_t)ks * 49152 + i];
        mod[i] = s; }
    LAS float* sh = (LAS float*)F.lds; LAS float* sc = sh + 2048;
    bf16_t* H = (bf16_t*)(F.ws + WS_H);
    for (int rt = F.bid; rt < 256; rt += F.G) {
        const int b = rt >> 6;
        __syncthreads();
        for (int cidx = F.tid; cidx < 4096; cidx += NTHR) { const int col = b * 12288 + cidx; float s = F.b_ada[cidx];
#pragma unroll
            for (int ks = 0; ks < 8; ++ks) s += modp[(size_t)ks * 49152 + col];
            if (cidx < 2048) sh[cidx] = s; else sc[cidx - 2048] = 1.f + s; }
        __syncthreads();
        for (int r = 0; r < 4; ++r) { const int row = rt * 32 + F.wave * 4 + r;
            const f32x4* xr = (const f32x4*)(F.x + (size_t)row * DM) + F.lane;
            f32x4 v[8]; float s = 0.f;
#pragma unroll
            for (int j = 0; j < 8; ++j) { v[j] = __builtin_nontemporal_load(xr + 64 * j); s += (v[j][0] + v[j][1]) + (v[j][2] + v[j][3]); }
            const float mean = wave_sum(s) * (1.f / DM); float s2 = 0.f;
#pragma unroll
            for (int j = 0; j < 8; ++j) { v[j] = v[j] - mean; s2 += (v[j][0] * v[j][0] + v[j][1] * v[j][1]) + (v[j][2] * v[j][2] + v[j][3] * v[j][3]); }
            const float rstd = __builtin_amdgcn_rsqf(wave_sum(s2) * (1.f / DM) + EPS);
            u32x2* o8 = (u32x2*)(H + (size_t)row * DM) + F.lane;
#pragma unroll
            for (int j = 0; j < 8; ++j) { const f32x4 a = *(LAS f32x4*)(sc + 4 * F.lane + 256 * j), bsh = *(LAS f32x4*)(sh + 4 * F.lane + 256 * j);
                const f32x4 h = v[j] * rstd * a + bsh; u32x2 w; w.x = cvt_pk_bf16(h[0], h[1]); w.y = cvt_pk_bf16(h[2], h[3]); o8[64 * j] = w; }
        }
    }
    __syncthreads();
}

__device__ __forceinline__ void p3_kprep(Frame& F) {
    const bf16_t* PROJ = (const bf16_t*)(F.ws + WS_PROJ); bf16_t* KV = (bf16_t*)(F.ws + WS_KV);
    const int l = F.lane & 31, kvh = F.lane >> 5;
    const float kw0 = F.k_norm_w[l], kw1 = F.k_norm_w[l + 32], kw2 = F.k_norm_w[64 + l], kw3 = F.k_norm_w[96 + l];
    const float invf = __builtin_amdgcn_exp2f(-(float)l * 0.41524101186092029f);
    for (int m0 = (F.bid * NWAVES + F.wave) * 4; m0 < MTOK; m0 += F.G * NWAVES * 4) {
        unsigned short kx[4][4], vx[4][4];
#pragma unroll
        for (int q = 0; q < 4; ++q) { const bf16_t* src = PROJ + (size_t)(m0 + q) * PW + C_K + kvh * 128; const bf16_t* sv = PROJ + (size_t)(m0 + q) * PW + C_V + kvh * 128;
#pragma unroll
            for (int i = 0; i < 4; ++i) { kx[q][i] = src[l + 32 * i]; vx[q][i] = sv[l + 32 * i]; } }
#pragma unroll
        for (int q = 0; q < 4; ++q) { const int m = m0 + q;
            float x0 = bf2f(kx[q][0]), x1 = bf2f(kx[q][1]), x2 = bf2f(kx[q][2]), x3 = bf2f(kx[q][3]);
            float ss = x0 * x0 + x1 * x1 + x2 * x2 + x3 * x3;
#pragma unroll
            for (int o = 1; o < 32; o <<= 1) ss += __shfl_xor(ss, o);
            const float rn = __builtin_amdgcn_rsqf(ss * (1.f / 128.f) + EPS);
            x0 *= rn * kw0; x1 *= rn * kw1; x2 *= rn * kw2; x3 *= rn * kw3;
            const int t = m & 2047; const float prow = (float)(t / 64 - 16), pcol = (float)(t % 64 - 32);
            float rv = prow * invf * 0.15915494309189535f; rv -= rintf(rv);
            float sn = __builtin_amdgcn_sinf(rv), c = __builtin_amdgcn_cosf(rv);
            const float y0 = x0 * c - x1 * sn, y1 = x1 * c + x0 * sn;
            rv = pcol * invf * 0.15915494309189535f; rv -= rintf(rv);
            sn = __builtin_amdgcn_sinf(rv); c = __builtin_amdgcn_cosf(rv);
            const float y2 = x2 * c - x3 * sn, y3 = x3 * c + x2 * sn;
            bf16_t* dk = KV + (size_t)m * 512 + kvh * 128;
            dk[l] = f2bf(y0); dk[l + 32] = f2bf(y1); dk[64 + l] = f2bf(y2); dk[96 + l] = f2bf(y3);
            bf16_t* dv = KV + (size_t)m * 512 + 256 + kvh * 128;
            dv[l] = vx[q][0]; dv[l + 32] = vx[q][1]; dv[l + 64] = vx[q][2]; dv[l + 96] = vx[q][3]; }
    }
}

template <int DIR>
__device__ __forceinline__ void gate_scan(const LAS unsigned char* zraw  , float lb, LAS float* segbuf, int d, int seg, float (&bb)[16], float (&kk)[16], float& total) {
    float lf[16];
#pragma unroll
    for (int ii = 0; ii < 16; ++ii) { const float z = bf2f(*(const LAS unsigned short*)(zraw + (16 * seg + ii) * 272 + d * 2)); const float fg = lb + (1.f - lb) * fast_sigmoid(z); lf[ii] = flog(fg); kk[ii] = 1.f - fg; }
    float run = 0.f;
    if (DIR == 0) {
#pragma unroll
        for (int ii = 0; ii < 16; ++ii) { run += lf[ii]; bb[ii] = run; }
    } else {
#pragma unroll
        for (int ii = 15; ii >= 0; --ii) { run += lf[ii]; bb[ii] = run; }
    }
    segbuf[seg * 128 + d] = run;
    __syncthreads();
    const float s0 = segbuf[d], s1 = segbuf[128 + d], s2 = segbuf[256 + d], s3 = segbuf[384 + d];
    total = (s0 + s1) + (s2 + s3);
    float off;
    if (DIR == 0) off = (seg > 0 ? s0 : 0.f) + (seg > 1 ? s1 : 0.f) + (seg > 2 ? s2 : 0.f);
    else off = (seg < 3 ? s3 : 0.f) + (seg < 2 ? s2 : 0.f) + (seg < 1 ? s1 : 0.f);
#pragma unroll
    for (int ii = 0; ii < 16; ++ii) bb[ii] += off;
    __syncthreads();
}
__device__ __forceinline__ void pack16_store(LAS unsigned char* p, const float (&v)[16]) {
    u32x4 w0, w1;
    w0.x = cvt_pk_bf16(v[0], v[1]); w0.y = cvt_pk_bf16(v[2], v[3]); w0.z = cvt_pk_bf16(v[4], v[5]); w0.w = cvt_pk_bf16(v[6], v[7]);
    w1.x = cvt_pk_bf16(v[8], v[9]); w1.y = cvt_pk_bf16(v[10], v[11]); w1.z = cvt_pk_bf16(v[12], v[13]); w1.w = cvt_pk_bf16(v[14], v[15]);
    *(LAS u32x4*)p = w0; *(LAS u32x4*)(p + 16) = w1;
}
__device__ __forceinline__ float hgrn_lower_bound(const float* hgrn_lb, int dir, int col) { const float a0 = hgrn_lb[dir * 2048 + col], a1 = hgrn_lb[dir * 2048 + 1024 + col]; return 1.f / (1.f + __expf(a1 - a0)); }

#define HG_TILE_LD(r0, r1, base) do { r0 = *(const u32x4*)((base) + (size_t)(F.tid >> 4) * PW + (F.tid & 15) * 8); r1 = *(const u32x4*)((base) + (size_t)((F.tid >> 4) + 32) * PW + (F.tid & 15) * 8); } while (0)
#define HG_TILE_LDNT(r0, r1, base) do { r0 = __builtin_nontemporal_load((const u32x4*)((base) + (size_t)(F.tid >> 4) * PW + (F.tid & 15) * 8)); r1 = __builtin_nontemporal_load((const u32x4*)((base) + (size_t)((F.tid >> 4) + 32) * PW + (F.tid & 15) * 8)); } while (0)
#define HG_TILE_ST(raw, r0, r1) do { *(LAS u32x4*)((raw) + (F.tid >> 4) * 272 + (F.tid & 15) * 16) = r0; *(LAS u32x4*)((raw) + ((F.tid >> 4) + 32) * 272 + (F.tid & 15) * 16) = r1; } while (0)
__device__ __forceinline__ void p3_hgrn_u(Frame& F, int ui0, int ui1) {
    const bf16_t* PROJ = (const bf16_t*)(F.ws + WS_PROJ);
    bf16_t* UT = (bf16_t*)(F.ws + WS_UT); float* DEC = (float*)(F.ws + WS_DECAY);
    LAS unsigned char* KDT = F.lds; LAS unsigned char* VT = F.lds + 18432; LAS float* SEG = (LAS float*)(F.lds + 36864);
    LAS unsigned char* RZ0 = F.lds + 40960; LAS unsigned char* RZ1 = RZ0 + 17408; LAS unsigned char* RV = RZ1 + 17408;
    const int d = F.tid & 127, seg = F.tid >> 7;
    const int we = F.wave >> 1, wd = F.wave & 1, fr = F.lane & 15, fq = F.lane >> 4;
    for (int ui = ui0; ui < ui1; ++ui) { const int u = F.bid + ui * F.G; if (u >= 1024) break;
        const int bh = u >> 5, n = u & 31, b = bh >> 3, h = bh & 7; const size_t m0 = (size_t)b * SEQ + n * 64;
        { u32x4 a0, a1, b0, b1, c0, c1; const bf16_t* base = PROJ + m0 * PW + h * 128;
          HG_TILE_LD(a0, a1, base + C_FF); HG_TILE_LD(b0, b1, base + C_FB); HG_TILE_LD(c0, c1, base + C_IN);
          HG_TILE_ST(RZ0, a0, a1); HG_TILE_ST(RZ1, b0, b1); HG_TILE_ST(RV, c0, c1); }
        __syncthreads();
        { float vv[16];
#pragma unroll
          for (int ii = 0; ii < 16; ++ii) vv[ii] = bf2f(*(const LAS unsigned short*)(RV + (16 * seg + ii) * 272 + d * 2));
          pack16_store(VT + d * 144 + seg * 32, vv); }
#pragma unroll
        for (int dir = 0; dir < 2; ++dir) {
            float bb[16], kk[16], total; const float lb = hgrn_lower_bound(F.hgrn_lb, dir, h * 128 + d);
            if (dir == 0) gate_scan<0>(RZ0, lb, SEG, d, seg, bb, kk, total); else gate_scan<1>(RZ1, lb, SEG, d, seg, bb, kk, total);
            float kd[16];
#pragma unroll
            for (int ii = 0; ii < 16; ++ii) kd[ii] = kk[ii] * fexp(total - bb[ii]);
            pack16_store(KDT + d * 144 + seg * 32, kd);
            const int ud = u * 2 + dir;
            if (seg == 0) DEC[(size_t)ud * 128 + d] = fexp(total);
            __syncthreads();
            f32x4 acc[2][4];
#pragma unroll
            for (int te = 0; te < 2; ++te)
#pragma unroll
                for (int td = 0; td < 4; ++td) acc[te][td] = (f32x4){0.f, 0.f, 0.f, 0.f};
#pragma unroll
            for (int ks = 0; ks < 2; ++ks) {
                bf16x8 bv[2], av[4];
#pragma unroll
                for (int te = 0; te < 2; ++te) bv[te] = *(const LAS bf16x8*)(VT + (32 * we + 16 * te + fr) * 144 + (ks * 4 + fq) * 16);
#pragma unroll
                for (int td = 0; td < 4; ++td) av[td] = *(const LAS bf16x8*)(KDT + (64 * wd + 16 * td + fr) * 144 + (ks * 4 + fq) * 16);
#pragma unroll
                for (int te = 0; te < 2; ++te)
#pragma unroll
                    for (int td = 0; td < 4; ++td) acc[te][td] = __builtin_amdgcn_mfma_f32_16x16x32_bf16(av[td], bv[te], acc[te][td], 0, 0, 0);
            }
            bf16_t* ut = UT + (size_t)ud * 16384;
#pragma unroll
            for (int te = 0; te < 2; ++te)
#pragma unroll
                for (int td = 0; td < 4; ++td) { u32x2 w; w.x = cvt_pk_bf16_safe(acc[te][td][0], acc[te][td][1]); w.y = cvt_pk_bf16_safe(acc[te][td][2], acc[te][td][3]);
                    *(u32x2*)(ut + (size_t)(32 * we + 16 * te + fr) * 128 + 64 * wd + 16 * td + 4 * fq) = w; }
            __syncthreads();
        }
    }
}

__device__ __forceinline__ void p4_scan(Frame& F) {
    const bf16_t* UT = (const bf16_t*)(F.ws + WS_UT); const float* DEC = (const float*)(F.ws + WS_DECAY); bf16_t* SP = (bf16_t*)(F.ws + WS_SPREV);
    LAS float* DL = (LAS float*)F.lds;
    const int el = F.tid >> 5, d4 = F.tid & 31;
    for (int item = F.bid; item < 512; item += F.G) {
        const int sq = item >> 3, e = (item & 7) * 16 + el, bh = sq >> 1, dir = sq & 1;
        u32x2 uw[32];
#pragma unroll
        for (int n = 0; n < 32; ++n) { const size_t ud = (size_t)(bh * 32 + n) * 2 + dir; uw[n] = __builtin_nontemporal_load((const u32x2*)(UT + ud * 16384 + e * 128 + 4 * d4)); }
        __syncthreads();
#pragma unroll
        for (int q = 0; q < 2; ++q) { const int id = F.tid + NTHR * q, n = id >> 5, c4 = id & 31; const size_t ud = (size_t)(bh * 32 + n) * 2 + dir;
            *(LAS f32x4*)(DL + n * 128 + 4 * c4) = *(const f32x4*)(DEC + ud * 128 + 4 * c4); }
        __syncthreads();
        f32x4 st = {0.f, 0.f, 0.f, 0.f};
#pragma unroll
        for (int j = 0; j < 32; ++j) { const int n = dir == 0 ? j : 31 - j; const size_t ud = (size_t)(bh * 32 + n) * 2 + dir;
            u32x2 w; w.x = cvt_pk_bf16_safe(st[0], st[1]); w.y = cvt_pk_bf16_safe(st[2], st[3]);
            *(u32x2*)(SP + ud * 16384 + e * 128 + 4 * d4) = w;
            const u32x2 un = dir == 0 ? uw[j] : uw[31 - j];
            const f32x4 dd = *(const LAS f32x4*)(DL + n * 128 + 4 * d4);
            st = dd * st + (f32x4){bflo(un.x), bfhi(un.x), bflo(un.y), bfhi(un.y)}; }
    }
    __syncthreads();
}

__device__ __forceinline__ void p5_hgrn_out(Frame& F, int ui0, int ui1) {
    const bf16_t* PROJ = (const bf16_t*)(F.ws + WS_PROJ); const bf16_t* SPREV = (const bf16_t*)(F.ws + WS_SPREV); bf16_t* MIXED = (bf16_t*)(F.ws + WS_MIXED);
    LAS unsigned char* QD = F.lds; LAS unsigned char* KD = F.lds + 17408; LAS unsigned char* RZ0 = F.lds + 34816; LAS unsigned char* RZ1 = F.lds + 52224;
    LAS unsigned char* PP = F.lds + 69632; LAS unsigned char* VT = F.lds + 78848; LAS unsigned char* SPL = F.lds + 97280;
    LAS float* SEG = (LAS float*)(F.lds + 132096); LAS float* SSQ = (LAS float*)(F.lds + 134144);
    LAS unsigned char* RQ = QD; LAS unsigned char* RV = KD;
    const int d = F.tid & 127, seg = F.tid >> 7, fr = F.lane & 15, fq = F.lane >> 4;
    const int it = F.wave & 3, eh = F.wave >> 2;
    for (int ui = ui0; ui < ui1; ++ui) { const int u = F.bid + ui * F.G; if (u >= 1024) break;
        const int bh = u >> 5, n = u & 31, b = bh >> 3, h = bh & 7; const size_t m0 = (size_t)b * SEQ + n * 64;
        const int i = 16 * it + fr;
        u32x4 sp1[4]; u32x2 graw[4]; f32x4 nwv[4];
        { u32x4 a0, a1, b0, b1, c0, c1, d0, d1, sp0[4]; const bf16_t* base = PROJ + m0 * PW + h * 128;
          HG_TILE_LDNT(a0, a1, base + C_FF); HG_TILE_LDNT(b0, b1, base + C_FB); HG_TILE_LDNT(c0, c1, base + C_QR); HG_TILE_LDNT(d0, d1, base + C_IN);
          const bf16_t* spa = SPREV + (size_t)(u * 2) * 16384;
#pragma unroll
          for (int q = 0; q < 4; ++q) { const int id = F.tid + NTHR * q; sp0[q] = __builtin_nontemporal_load((const u32x4*)(spa + (id >> 4) * 128 + (id & 15) * 8)); }
#pragma unroll
          for (int q = 0; q < 4; ++q) { const int id = F.tid + NTHR * q; sp1[q] = __builtin_nontemporal_load((const u32x4*)(spa + 16384 + (id >> 4) * 128 + (id & 15) * 8)); }
#pragma unroll
          for (int te = 0; te < 4; ++te) { graw[te] = *(const u32x2*)(PROJ + (m0 + i) * PW + C_GO + h * 128 + 64 * eh + 16 * te + 4 * fq); nwv[te] = *(const f32x4*)(F.hgrn_norm_w + h * 128 + 64 * eh + 16 * te + 4 * fq); }
          HG_TILE_ST(RZ0, a0, a1); HG_TILE_ST(RZ1, b0, b1); HG_TILE_ST(RQ, c0, c1); HG_TILE_ST(RV, d0, d1);
#pragma unroll
          for (int q = 0; q < 4; ++q) { const int id = F.tid + NTHR * q; *(LAS u32x4*)(SPL + (id >> 4) * 272 + (id & 15) * 16) = sp0[q]; } }
        __syncthreads();
        float qs[16];
        { float vv[16];
#pragma unroll
          for (int ii = 0; ii < 16; ++ii) { vv[ii] = bf2f(*(const LAS unsigned short*)(RV + (16 * seg + ii) * 272 + d * 2)); const float q = bf2f(*(const LAS unsigned short*)(RQ + (16 * seg + ii) * 272 + d * 2)); qs[ii] = q * fast_sigmoid(q); }
          pack16_store(VT + d * 144 + seg * 32, vv); }
        f32x4 o[4];
#pragma unroll
        for (int te = 0; te < 4; ++te) o[te] = (f32x4){0.f, 0.f, 0.f, 0.f};
#pragma unroll
        for (int dir = 0; dir < 2; ++dir) {
            float bb[16], kk[16], total; const float lb = hgrn_lower_bound(F.hgrn_lb, dir, h * 128 + d);
            if (dir == 0) gate_scan<0>(RZ0, lb, SEG, d, seg, bb, kk, total); else gate_scan<1>(RZ1, lb, SEG, d, seg, bb, kk, total);
#pragma unroll
            for (int ii = 0; ii < 16; ++ii) { const int ir = 16 * seg + ii;
                *(LAS unsigned short*)(QD + ir * 272 + d * 2) = f2bf(qs[ii] * fexp(bb[ii]));
                *(LAS unsigned short*)(KD + ir * 272 + d * 2) = f2bf(kk[ii] * fexp(-bb[ii])); }
            if (dir == 1) {
#pragma unroll
                for (int q = 0; q < 4; ++q) { const int id = F.tid + NTHR * q; *(LAS u32x4*)(SPL + (id >> 4) * 272 + (id & 15) * 16) = sp1[q]; } }
            __syncthreads();
#pragma unroll
            for (int jj = 0; jj < 2; ++jj) { const int jt = 2 * eh + jj; f32x4 sacc = {0.f, 0.f, 0.f, 0.f};
#pragma unroll
                for (int ks = 0; ks < 4; ++ks) { const bf16x8 a = *(const LAS bf16x8*)(KD + (16 * jt + fr) * 272 + (ks * 4 + fq) * 16), bq = *(const LAS bf16x8*)(QD + (16 * it + fr) * 272 + (ks * 4 + fq) * 16);
                    sacc = __builtin_amdgcn_mfma_f32_16x16x32_bf16(a, bq, sacc, 0, 0, 0); }
                const int j0 = 16 * jt + 4 * fq; float pv[4];
#pragma unroll
                for (int r = 0; r < 4; ++r) { const int j = j0 + r; const bool keep = dir == 0 ? (j <= i) : (j >= i); pv[r] = keep ? sacc[r] : 0.f; }
                u32x2 w; w.x = cvt_pk_bf16(pv[0], pv[1]); w.y = cvt_pk_bf16(pv[2], pv[3]);
                *(LAS u32x2*)(PP + i * 144 + j0 * 2) = w; }
            __syncthreads();
#pragma unroll
            for (int ks = 0; ks < 2; ++ks) { const bf16x8 bp = *(const LAS bf16x8*)(PP + (16 * it + fr) * 144 + (ks * 4 + fq) * 16);
#pragma unroll
                for (int te = 0; te < 4; ++te) { const bf16x8 a = *(const LAS bf16x8*)(VT + (64 * eh + 16 * te + fr) * 144 + (ks * 4 + fq) * 16);
                    o[te] = __builtin_amdgcn_mfma_f32_16x16x32_bf16(a, bp, o[te], 0, 0, 0); } }
#pragma unroll
            for (int ks = 0; ks < 4; ++ks) { const bf16x8 bq = *(const LAS bf16x8*)(QD + (16 * it + fr) * 272 + (ks * 4 + fq) * 16);
#pragma unroll
                for (int te = 0; te < 4; ++te) { const bf16x8 a = *(const LAS bf16x8*)(SPL + (64 * eh + 16 * te + fr) * 272 + (ks * 4 + fq) * 16);
                    o[te] = __builtin_amdgcn_mfma_f32_16x16x32_bf16(a, bq, o[te], 0, 0, 0); } }
            __syncthreads();
        }
        float ss = 0.f;
#pragma unroll
        for (int te = 0; te < 4; ++te) ss += (o[te][0] * o[te][0] + o[te][1] * o[te][1]) + (o[te][2] * o[te][2] + o[te][3] * o[te][3]);
        ss += __shfl_xor(ss, 16); ss += __shfl_xor(ss, 32);
        if (fq == 0) SSQ[eh * 64 + i] = ss;
        __syncthreads();
        const float rs = __builtin_amdgcn_rsqf((SSQ[i] + SSQ[64 + i]) * (1.f / 128.f) + EPS);
#pragma unroll
        for (int te = 0; te < 4; ++te) { const int e = 64 * eh + 16 * te + 4 * fq; const f32x4 nw = nwv[te];
            const float g0 = bflo(graw[te].x), g1 = bfhi(graw[te].x), g2 = bflo(graw[te].y), g3 = bfhi(graw[te].y);
            u32x2 w; w.x = cvt_pk_bf16(o[te][0] * rs * nw[0] * g0 * fast_sigmoid(g0), o[te][1] * rs * nw[1] * g1 * fast_sigmoid(g1));
            w.y = cvt_pk_bf16(o[te][2] * rs * nw[2] * g2 * fast_sigmoid(g2), o[te][3] * rs * nw[3] * g3 * fast_sigmoid(g3));
            *(u32x2*)(MIXED + (m0 + i) * DM + 1024 + h * 128 + e) = w; }
        __syncthreads();
    }
}

__device__ __forceinline__ void p7_post_mixer(Frame& F) {
    const float* mod = (const float*)(F.ws + WS_MOD); const bf16_t* Y1 = (const bf16_t*)(F.ws + WS_Y1); bf16_t* X1 = (bf16_t*)(F.ws + WS_X1); unsigned char* H2 = F.ws + WS_H2;
    const bf16_t* WRH = (const bf16_t*)(F.ws + WS_WRT); const bf16_t* WRL = WRH + 32 * 2048;
    int* SLOT = (int*)(F.ws + WS_ROUTE + RT_SLOT); float* SGATE = (float*)(F.ws + WS_ROUTE + RT_SGATE); unsigned* ECNT = (unsigned*)(F.ws + WS_CTL + CTL_ECNT); unsigned char* XS = F.ws + WS_XS;
    LAS unsigned char* HTH = F.lds; LAS unsigned char* HTL = F.lds + 65792;
    LAS float* RED = (LAS float*)(F.lds + 131584); LAS float* LOG = (LAS float*)(F.lds + 147968); LAS int* LE = (LAS int*)(F.lds + 152064); LAS int* LR = LE + 128; LAS float* LG = (LAS float*)(LR + 128); LAS int* EB = (LAS int*)(LG + 128);
    const int fr = F.lane & 15, fq = F.lane >> 4;
    for (int rt = F.bid; rt < 256; rt += F.G) {
        const int b = rt >> 6; const float* mb = mod + (size_t)b * 12288;
        for (int pass = 0; pass < 2; ++pass) {
            for (int rr = 0; rr < 2; ++rr) { const int lr = 2 * F.wave + rr, row = rt * 32 + pass * 16 + lr;
                const f32x4* xr = (const f32x4*)(F.x + (size_t)row * DM) + F.lane; const u32x2* yr = (const u32x2*)(Y1 + (size_t)row * DM) + F.lane;
                f32x4 v[8]; float s = 0.f;
#pragma unroll
                for (int j = 0; j < 8; ++j) { const f32x4 g1 = *((const f32x4*)(mb + 4096) + F.lane + 64 * j); const u32x2 yw = yr[64 * j]; const f32x4 yv = {bflo(yw.x), bfhi(yw.x), bflo(yw.y), bfhi(yw.y)}; v[j] = __builtin_nontemporal_load(xr + 64 * j) * DN_ALPHA + g1 * yv; s += (v[j][0] + v[j][1]) + (v[j][2] + v[j][3]); }
                float mean = wave_sum(s) * (1.f / DM), s2 = 0.f;
#pragma unroll
                for (int j = 0; j < 8; ++j) { v[j] = v[j] - mean; s2 += (v[j][0] * v[j][0] + v[j][1] * v[j][1]) + (v[j][2] * v[j][2] + v[j][3] * v[j][3]); }
                float rstd = __builtin_amdgcn_rsqf(wave_sum(s2) * (1.f / DM) + EPS);
                s = 0.f;
                f32x4 pg[8], pb[8];
#pragma unroll
                for (int j = 0; j < 8; ++j) { pg[j] = *((const f32x4*)F.ln1_g + F.lane + 64 * j); pb[j] = *((const f32x4*)F.ln1_b + F.lane + 64 * j); }
#pragma unroll
                for (int j = 0; j < 8; ++j) { const f32x4 g = pg[j], bb = pb[j];
                    v[j] = v[j] * rstd * g + bb; { u32x2 xw; xw.x = cvt_pk_bf16(v[j][0], v[j][1]); xw.y = cvt_pk_bf16(v[j][2], v[j][3]); __builtin_nontemporal_store(xw, (u32x2*)(X1 + (size_t)row * DM) + F.lane + 64 * j); } s += (v[j][0] + v[j][1]) + (v[j][2] + v[j][3]); }
                mean = wave_sum(s) * (1.f / DM); s2 = 0.f;
#pragma unroll
                for (int j = 0; j < 8; ++j) { v[j] = v[j] - mean; s2 += (v[j][0] * v[j][0] + v[j][1] * v[j][1]) + (v[j][2] * v[j][2] + v[j][3] * v[j][3]); }
                rstd = __builtin_amdgcn_rsqf(wave_sum(s2) * (1.f / DM) + EPS);
#pragma unroll
                for (int j = 0; j < 8; ++j) { pg[j] = *((const f32x4*)(mb + 6144) + F.lane + 64 * j); pb[j] = *((const f32x4*)(mb + 8192) + F.lane + 64 * j); }
#pragma unroll
                for (int j = 0; j < 8; ++j) { const f32x4 sh = pg[j], sc = pb[j];
                    const f32x4 h = v[j] * rstd * (sc + 1.f) + sh;
                    u32x2 wh; wh.x = cvt_pk_bf16(h[0], h[1]); wh.y = cvt_pk_bf16(h[2], h[3]);
                    u32x2 wl; wl.x = cvt_pk_bf16(h[0] - bflo(wh.x), h[1] - bfhi(wh.x)); wl.y = cvt_pk_bf16(h[2] - bflo(wh.y), h[3] - bfhi(wh.y));
                    *((unsigned*)(H2 + (size_t)row * DM) + F.lane + 64 * j) = pk4_fp8(h[0], h[1], h[2], h[3]);
                    *(LAS u32x2*)(HTH + lr * 4112 + (4 * F.lane + 256 * j) * 2) = wh; *(LAS u32x2*)(HTL + lr * 4112 + (4 * F.lane + 256 * j) * 2) = wl; }
            }
            __syncthreads();
            { f32x4 acc[2] = {{0.f, 0.f, 0.f, 0.f}, {0.f, 0.f, 0.f, 0.f}};
#pragma unroll 2
              for (int ks = 0; ks < 8; ++ks) { const int k0 = 256 * F.wave + 32 * ks + 8 * fq;
                  const bf16x8 ah = *(const LAS bf16x8*)(HTH + fr * 4112 + k0 * 2), al = *(const LAS bf16x8*)(HTL + fr * 4112 + k0 * 2);
#pragma unroll
                  for (int et = 0; et < 2; ++et) { const bf16x8 bh = *(const bf16x8*)(WRH + (size_t)(et * 16 + fr) * 2048 + k0), bl = *(const bf16x8*)(WRL + (size_t)(et * 16 + fr) * 2048 + k0);
                      acc[et] = __builtin_amdgcn_mfma_f32_16x16x32_bf16(ah, bh, acc[et], 0, 0, 0);
                      acc[et] = __builtin_amdgcn_mfma_f32_16x16x32_bf16(al, bh, acc[et], 0, 0, 0);
                      acc[et] = __builtin_amdgcn_mfma_f32_16x16x32_bf16(ah, bl, acc[et], 0, 0, 0); } }
#pragma unroll
              for (int et = 0; et < 2; ++et)
#pragma unroll
                  for (int j = 0; j < 4; ++j) RED[(F.wave * 16 + 4 * fq + j) * 32 + et * 16 + fr] = acc[et][j]; }
            __syncthreads();
            { const int tok = F.tid >> 5, e = F.tid & 31; float s = F.b_router[e];
#pragma unroll
              for (int w = 0; w < 8; ++w) s += RED[(w * 16 + tok) * 32 + e];
              LOG[(pass * 16 + tok) * 32 + e] = s; }
            __syncthreads();
        }
        if (F.tid < 32) { const int t = rt * 32 + F.tid; unsigned taken = 0u; float tv[4]; int tix[4];
#pragma unroll
            for (int k = 0; k < 4; ++k) { float best = -3.0e38f; int bi = 0;
                for (int e = 0; e < 32; ++e) { const float v = LOG[F.tid * 32 + e]; if (!((taken >> e) & 1u) && v > best) { best = v; bi = e; } }
                taken |= 1u << bi; tv[k] = best; tix[k] = bi; }
            float ex[4], sum = 0.f;
#pragma unroll
            for (int k = 0; k < 4; ++k) { ex[k] = __expf(tv[k] - tv[0]); sum += ex[k]; }
            const float inv = 1.f / sum;
#pragma unroll
            for (int k = 0; k < 4; ++k) { LG[F.tid * 4 + k] = ex[k] * inv; LE[F.tid * 4 + k] = tix[k]; } }
        __syncthreads();
        if (F.tid < 32) { int cnt = 0; for (int a = 0; a < 128; ++a) if (LE[a] == F.tid) { LR[a] = cnt; ++cnt; }
            EB[F.tid] = cnt > 0 ? (int)__hip_atomic_fetch_add(ECNT + F.tid, (unsigned)cnt, __ATOMIC_RELAXED, __HIP_MEMORY_SCOPE_AGENT) : 0; }
        asm volatile("s_waitcnt vmcnt(0)" ::: "memory");
        __syncthreads();
        if (F.tid < 128) { const int e = LE[F.tid], slot = e * ECAP + EB[e] + LR[F.tid]; SLOT[rt * 128 + F.tid] = slot; SGATE[slot] = LG[F.tid]; LE[F.tid] = slot; }
        __syncthreads();
        { u32x4 rv[4][2];
#pragma unroll
          for (int i = 0; i < 4; ++i) { const u32x4* src = (const u32x4*)(H2 + (size_t)(rt * 32 + F.wave * 4 + i) * DM) + F.lane; rv[i][0] = __builtin_nontemporal_load(src); rv[i][1] = __builtin_nontemporal_load(src + 64); }
#pragma unroll
          for (int i = 0; i < 4; ++i)
#pragma unroll
              for (int k = 0; k < 4; ++k) { u32x4* dst = (u32x4*)(XS + (size_t)LE[(F.wave * 4 + i) * 4 + k] * DM) + F.lane; dst[0] = rv[i][0]; dst[64] = rv[i][1]; } }
        __syncthreads();
    }
}

__device__ __forceinline__ void route_tables(Frame& F) {
    const unsigned* ECNT = (const unsigned*)(F.ws + WS_CTL + CTL_ECNT); LAS int* tab = (LAS int*)(F.lds + LDS_TAB_OFF);
    __syncthreads();
    if (F.tid < 32) tab[F.tid] = (int)ECNT[F.tid];
    __syncthreads();
    if (F.tid == 0) { int t = 0;
        for (int g = 0; g < 8; ++g) {
            for (int j = 0; j < 4; ++j) { const int cnt = tab[4 * g + j], nt = (cnt + 255) >> 8, hf = (nt > 0 && cnt - (nt - 1) * 256 <= 128) ? 1 : 0; tab[64 + 8 * g + j] = t; t += nt - hf; }
            for (int j = 0; j < 4; ++j) { const int cnt = tab[4 * g + j], nt = (cnt + 255) >> 8, hf = (nt > 0 && cnt - (nt - 1) * 256 <= 128) ? 1 : 0; tab[64 + 8 * g + 4 + j] = t; t += hf; } }
        tab[128] = t; }
    __syncthreads();
}
__device__ __forceinline__ void p11_final(Frame& F) {
    const float* mod = (const float*)(F.ws + WS_MOD); const bf16_t* X1 = (const bf16_t*)(F.ws + WS_X1); const unsigned char* YB = F.ws + WS_YB; const int* SLOT = (const int*)(F.ws + WS_ROUTE + RT_SLOT);
    for (int row = F.bid * NWAVES + F.wave; row < MTOK; row += F.G * NWAVES) {
        const int b = row >> 11; const float* g2p = mod + (size_t)b * 12288 + 10240;
        const int s0 = SLOT[row * 4 + 0], s1 = SLOT[row * 4 + 1], s2i = SLOT[row * 4 + 2], s3 = SLOT[row * 4 + 3];
        const unsigned* y0 = (const unsigned*)(YB + (size_t)s0 * DM) + F.lane; const unsigned* y1 = (const unsigned*)(YB + (size_t)s1 * DM) + F.lane;
        const unsigned* y2 = (const unsigned*)(YB + (size_t)s2i * DM) + F.lane; const unsigned* y3 = (const unsigned*)(YB + (size_t)s3 * DM) + F.lane;
        const u32x2* xr = (const u32x2*)(X1 + (size_t)row * DM) + F.lane;
        f32x4 v[8]; float s = 0.f;
#pragma unroll
        for (int j = 0; j < 8; ++j) { const int a = (int)y0[64 * j], bq = (int)y1[64 * j], c = (int)y2[64 * j], dq = (int)y3[64 * j];
            const f32x2 a0 = __builtin_amdgcn_cvt_pk_f32_fp8(a, false), a1 = __builtin_amdgcn_cvt_pk_f32_fp8(a, true), b0 = __builtin_amdgcn_cvt_pk_f32_fp8(bq, false), b1 = __builtin_amdgcn_cvt_pk_f32_fp8(bq, true);
            const f32x2 c0 = __builtin_amdgcn_cvt_pk_f32_fp8(c, false), c1 = __builtin_amdgcn_cvt_pk_f32_fp8(c, true), d0 = __builtin_amdgcn_cvt_pk_f32_fp8(dq, false), d1 = __builtin_amdgcn_cvt_pk_f32_fp8(dq, true);
            f32x4 y; y[0] = ((a0.x + b0.x) + (c0.x + d0.x)) * (1.f / YB_SCALE); y[1] = ((a0.y + b0.y) + (c0.y + d0.y)) * (1.f / YB_SCALE);
            y[2] = ((a1.x + b1.x) + (c1.x + d1.x)) * (1.f / YB_SCALE); y[3] = ((a1.y + b1.y) + (c1.y + d1.y)) * (1.f / YB_SCALE);
            const f32x4 g2 = *((const f32x4*)g2p + F.lane + 64 * j);
            const u32x2 xw = xr[64 * j]; const f32x4 xv = {bflo(xw.x), bfhi(xw.x), bflo(xw.y), bfhi(xw.y)};
            v[j] = xv * DN_ALPHA + g2 * y; s += (v[j][0] + v[j][1]) + (v[j][2] + v[j][3]); }
        const float mean = wave_sum(s) * (1.f / DM); float s2 = 0.f;
#pragma unroll
        for (int j = 0; j < 8; ++j) { v[j] = v[j] - mean; s2 += (v[j][0] * v[j][0] + v[j][1] * v[j][1]) + (v[j][2] * v[j][2] + v[j][3] * v[j][3]); }
        const float rstd = __builtin_amdgcn_rsqf(wave_sum(s2) * (1.f / DM) + EPS);
        f32x4 pg[8], pb[8];
#pragma unroll
        for (int j = 0; j < 8; ++j) { pg[j] = *((const f32x4*)F.ln2_g + F.lane + 64 * j); pb[j] = *((const f32x4*)F.ln2_b + F.lane + 64 * j); }
#pragma unroll
        for (int j = 0; j < 8; ++j) __builtin_nontemporal_store(v[j] * rstd * pg[j] + pb[j], (f32x4*)(F.out + (size_t)row * DM) + F.lane + 64 * j);
    }
}

constexpr int NPHASE = 12;
struct Args { const float* in[21]; float* out; unsigned char* ws; int ph_lo, ph_hi; };
__global__ void __launch_bounds__(NTHR, 2) mega_fwd(Args args) {
    extern __shared__ __attribute__((aligned(16))) unsigned char lds_raw[];
    typedef const __attribute__((address_space(4))) Args* KArgP;
#define MKFRAME() Frame F; { int t_ = threadIdx.x; asm volatile("" : "+v"(t_)); KArgP ap = (KArgP)__builtin_amdgcn_kernarg_segment_ptr(); asm volatile("" : "+s"(ap)); \
    F.lds = (LAS unsigned char*)lds_raw; F.tid = t_; F.lane = t_ & 63; F.wave = __builtin_amdgcn_readfirstlane(t_ >> 6); F.G = gridDim.x; F.bid = blockIdx.x; \
    F.x = ap->in[0]; F.c = ap->in[1]; F.w_ada = ap->in[2]; F.b_ada = ap->in[3]; F.w_in = ap->in[4]; F.q_norm_w = ap->in[5]; F.k_norm_w = ap->in[6]; F.attn_norm_w = ap->in[7]; \
    F.hgrn_lb = ap->in[8]; F.hgrn_norm_w = ap->in[9]; F.w_out = ap->in[10]; F.ln1_g = ap->in[11]; F.ln1_b = ap->in[12]; F.w_router = ap->in[13]; F.b_router = ap->in[14]; \
    F.w1 = ap->in[15]; F.b1 = ap->in[16]; F.w2 = ap->in[17]; F.b2 = ap->in[18]; F.ln2_g = ap->in[19]; F.ln2_b = ap->in[20]; F.out = ap->out; F.ws = ap->ws; }
    for (int u = threadIdx.x; u < (LDS_BYTES - LDS_CTL_OFF) / 4; u += NTHR) ((LAS unsigned*)((LAS unsigned char*)lds_raw + LDS_CTL_OFF))[u] = 0u;
    __syncthreads();
#if MK_SPLIT
#define GRID_BAR() do { } while (0)
#else
    (void)xcd_barrier_post((unsigned*)(args.ws + WS_CTL) + 1024, (volatile LAS unsigned*)((LAS unsigned char*)lds_raw + LDS_CTL_OFF));
#define GRID_BAR() do { KArgP bp_ = (KArgP)__builtin_amdgcn_kernarg_segment_ptr(); asm volatile("" : "+s"(bp_)); XcdBarrier b_; b_.bar = (unsigned*)(bp_->ws + WS_CTL) + 1024; b_.x = xb_xcc_id(); b_.st = (volatile LAS unsigned*)((LAS unsigned char*)lds_raw + LDS_CTL_OFF); xcd_barrier(b_); } while (0)
#endif
#ifndef PH_MASK
#define PH_MASK 0xFFF
#endif
#define IN(k) ((((PH_MASK) >> (k)) & 1) && args.ph_lo <= (k) && (k) < args.ph_hi)
#define SEAM(k) do { if (IN(k) && IN((k) + 1 + ((k) == 7 ? 1 : 0))) GRID_BAR(); } while (0)
#define SG() (((int)blockIdx.x >> 3) & 3)
    if (IN(0)) { MKFRAME(); p0_adaln(F); p0_router_w(F); conv_items<false>(F, 0, 1088); conv_items<true>(F, CV0, CV_P2); } SEAM(0);
    if (IN(1)) { MKFRAME(); p1_ln_mod(F); } SEAM(1);
    if (IN(2)) { MKFRAME(); const int sg = SG(); pg8::PlainSched<4096> S; S.init(F.ws + WS_H, F.ws + WS_WIN_T, MTOK, PW, F.G, F.bid); pg8::EpiBf16Plain E{(bf16_t*)(F.ws + WS_PROJ), PW};
        S.window(0, sg); pg8::gemm_phase<pg8::EpiBf16Plain, pg8::PlainSched<4096>, false>(F.lds, S, E);
        conv_pipe<false>(F, CV_P2, CV_P2T);
        S.window(sg, 1 << 20); pg8::gemm_phase<pg8::EpiBf16Plain, pg8::PlainSched<4096>, false>(F.lds, S, E);
        { const int full = S.nwg / F.G, rem = S.nwg - full * F.G;
          if (rem > 0 && F.bid >= rem) conv_pipe<false>(F, CV_P2T, CV_P3, F.bid - rem, F.G - rem);
          else if (rem == 0) conv_pipe<false>(F, CV_P2T, CV_P3); } } SEAM(2);
    if (IN(3)) { MKFRAME(); const int sg = SG(); p3_kprep(F); p3_hgrn_u(F, 0, sg); conv_items<true>(F, CV_P3, CV_P4); p3_hgrn_u(F, sg, 1 << 20); } SEAM(3);
    if (IN(4)) { { MKFRAME(); if (SG() < 2) { conv_pipe<false>(F, CV_P4, CV_P5); p4_scan(F); } }
        { MKFRAME();
        const bf16_t* PROJ = (const bf16_t*)(F.ws + WS_PROJ); const bf16_t* KV = (const bf16_t*)(F.ws + WS_KV); bf16_t* MIXED = (bf16_t*)(F.ws + WS_MIXED);
        for (int u = F.bid; u < 256; u += F.G) { const int qb = u & 7, h = (u >> 3) & 7, b = u >> 6, kvh = h >> 2; const size_t m0 = (size_t)b * SEQ + qb * 256;
            att::attn_unit(PROJ + m0 * PW + C_Q + h * 128, KV + (size_t)b * SEQ * 512 + kvh * 128, KV + (size_t)b * SEQ * 512 + 256 + kvh * 128,
                           MIXED + m0 * DM + h * 128, F.q_norm_w, F.attn_norm_w + h * 128, qb * 256, SEQ, (char*)lds_raw); } }
        { MKFRAME(); if (SG() >= 2) { conv_pipe<false>(F, CV_P4, CV_P5); p4_scan(F); } }
    } SEAM(4);
    if (IN(5)) { MKFRAME(); const int sg = SG(); p5_hgrn_out(F, 0, sg); conv_items<true>(F, CV_P5, CV_P6); p5_hgrn_out(F, sg, 1 << 20); } SEAM(5);
    if (IN(6)) { MKFRAME(); const int sg = SG(); pg8::PlainSched<4096> S; S.init(F.ws + WS_MIXED, F.ws + WS_WOUT_T, MTOK, DM, F.G, F.bid); pg8::EpiBf16Plain E{(bf16_t*)(F.ws + WS_Y1), DM};
        if (sg < 2) conv_items<true>(F, CV_P6, CV_W2);
        pg8::gemm_phase<pg8::EpiBf16Plain, pg8::PlainSched<4096>, false>(F.lds, S, E);
        if (sg >= 2) conv_items<true>(F, CV_P6, CV_W2); } SEAM(6);
    if (IN(7)) { MKFRAME(); p7_post_mixer(F); } SEAM(7);
    if (IN(9)) { MKFRAME(); const int sg = SG(); route_tables(F); pg8::MoeSched<2048> S; S.init(F.ws + WS_XS, F.ws + WS_W1T, (const LAS int*)(F.lds + LDS_TAB_OFF) + 64, 16, F.G, F.bid);
        pg8::EpiSwiglu E{F.ws + WS_ACT, F.b1};
        const int rem9 = S.nwg % F.G, nshort = (rem9 > 0) ? F.G - rem9 : 0;
        const int w2t = (nshort * 12 < CVQ_W2T) ? nshort * 12 : CVQ_W2T;
        const int sg8 = ((int)blockIdx.x >> 3) & 7;
        S.window(0, sg8); pg8::gemm_phase<pg8::EpiSwiglu, pg8::MoeSched<2048>, true>(F.lds, S, E);
        conv_pipe<true>(F, CV_W2, CV_END - w2t);
        S.window(sg8, 1 << 20); pg8::gemm_phase<pg8::EpiSwiglu, pg8::MoeSched<2048>, true>(F.lds, S, E);
        if (w2t > 0 && F.bid >= rem9) conv_items<true>(F, CV_END - w2t, CV_END, F.bid - rem9, nshort); } SEAM(9);
    if (IN(10)) { MKFRAME(); route_tables(F); pg8::MoeSched<2048> S; S.init(F.ws + WS_ACT, F.ws + WS_W2T, (const LAS int*)(F.lds + LDS_TAB_OFF) + 64, 8, F.G, F.bid);
        pg8::EpiGate E{F.ws + WS_YB, F.b2, (const float*)(F.ws + WS_ROUTE + RT_SGATE)};
        pg8::gemm_phase<pg8::EpiGate, pg8::MoeSched<2048>, true>(F.lds, S, E); } SEAM(10);
    if (IN(11)) { MKFRAME(); p11_final(F); }
#undef IN
#undef SEAM
}

extern "C" void kernel_launch(void* const* d_in, const int* in_sizes, int n_in, void* d_out, int out_size, void* d_ws, size_t ws_size, hipStream_t stream) {
    static int grid = 0;
    if (grid == 0) {
        if (n_in != 21 || out_size != MTOK * DM || ws_size < WS_END) { fprintf(stderr, "kernel_launch: unexpected shapes (n_in %d out %d ws %zu, need ws >= %zu)\n", n_in, out_size, ws_size, (size_t)WS_END); grid = -1; return; }
        int dev = 0, cus = 0, per_cu = 0;
        if (hipGetDevice(&dev) != hipSuccess || hipDeviceGetAttribute(&cus, hipDeviceAttributeMultiprocessorCount, dev) != hipSuccess) { grid = -1; return; }
        if (hipFuncSetAttribute((const void*)mega_fwd, hipFuncAttributeMaxDynamicSharedMemorySize, LDS_BYTES) != hipSuccess) { fprintf(stderr, "kernel_launch: hipFuncSetAttribute failed\n"); grid = -1; return; }
        if (hipOccupancyMaxActiveBlocksPerMultiprocessor(&per_cu, (const void*)mega_fwd, NTHR, LDS_BYTES) != hipSuccess || per_cu < 1) { fprintf(stderr, "kernel_launch: occupancy query says %d\n", per_cu); (void)hipGetLastError(); }
        grid = cus;
    }
    if (grid < 0) return;
    (void)hipMemsetAsync((char*)d_ws + WS_CTL, 0, CTL_ZERO_BYTES, stream);
    Args a{};
    for (int i = 0; i < 21; ++i) a.in[i] = (const float*)d_in[i];
    a.out = (float*)d_out; a.ws = (unsigned char*)d_ws;
#if MK_SPLIT
#ifndef REP_MASK
#define REP_MASK 0
#endif
    for (int p = 0; p < NPHASE; ++p) { a.ph_lo = p; a.ph_hi = p + 1; hipLaunchKernelGGL(mega_fwd, dim3(grid), dim3(NTHR), LDS_BYTES, stream, a);
        if ((REP_MASK >> p) & 1) hipLaunchKernelGGL(mega_fwd, dim3(grid), dim3(NTHR), LDS_BYTES, stream, a); }
#else
    a.ph_lo = 0; a.ph_hi = NPHASE; hipLaunchKernelGGL(mega_fwd, dim3(grid), dim3(NTHR), LDS_BYTES, stream, a);
#endif
    const hipError_t le = hipPeekAtLastError();
    if (le != hipSuccess) fprintf(stderr, "kernel_launch: launch failed: %s\n", hipGetErrorName(le));
}
```

```cpp
#include <hip/hip_runtime.h>
#include <cstdio>
#include <cstdint>

#ifndef MK_SPLIT
#define MK_SPLIT 0
#endif

#define GAS __attribute__((address_space(1)))
#define LAS __attribute__((address_space(3)))
typedef unsigned short bf16_t;
typedef short bf16x8 __attribute__((ext_vector_type(8)));
typedef short s16x4 __attribute__((ext_vector_type(4)));
typedef float f32x2 __attribute__((ext_vector_type(2)));
typedef float f32x4 __attribute__((ext_vector_type(4)));
typedef float f32x16 __attribute__((ext_vector_type(16)));
typedef unsigned u32x2 __attribute__((ext_vector_type(2)));
typedef unsigned u32x4 __attribute__((ext_vector_type(4)));

constexpr int DM = 2048, NBATCH = 4, SEQ = 2048, MTOK = NBATCH * SEQ;
constexpr int PW = 6656;
constexpr int C_Q = 0, C_K = 1024, C_V = 1280, C_QR = 1536, C_FF = 2560, C_FB = 3584, C_IN = 4608, C_GO = 5632;
constexpr int NE = 32, TOPK = 4;
constexpr int ECAP = 8192, ECAP_TILES = ECAP / 256, MAXROWS = NE * ECAP;
constexpr float EPS = 1e-6f;
constexpr float DN_ALPHA = 1.189207115002721f;
constexpr int NWAVES = 8, NTHR = 512;

constexpr size_t MiB = 1u << 20;
constexpr size_t WS_CTL = 0, CTL_ZERO_BYTES = 64 * 1024;
constexpr size_t WS_MODP = 1 * MiB;
constexpr size_t WS_MOD = 3 * MiB;
constexpr size_t WS_ROUTE = 4 * MiB;
constexpr size_t WS_WRT = 6 * MiB;
constexpr size_t WS_WIN_T = 8 * MiB;
constexpr size_t WS_WOUT_T = 34 * MiB;
constexpr size_t WS_W1T = 64 * MiB;
constexpr size_t WS_W2T = 576 * MiB;
constexpr size_t WS_H = 832 * MiB;
constexpr size_t WS_H2 = 864 * MiB;
constexpr size_t WS_PROJ = 928 * MiB;
constexpr size_t WS_KV = 1032 * MiB;
constexpr size_t WS_UT = 1040 * MiB;
constexpr size_t WS_DECAY = 1168 * MiB;
constexpr size_t WS_SPREV = 1170 * MiB;
constexpr size_t WS_MIXED = 1234 * MiB;
constexpr size_t WS_Y1 = 1266 * MiB;
constexpr size_t WS_X1 = 1330 * MiB;
constexpr size_t WS_XS = 1394 * MiB;
constexpr size_t WS_ACT = 1906 * MiB;
constexpr size_t WS_YB = 2418 * MiB;
constexpr size_t WS_END = 3442 * MiB;
constexpr size_t CTL_ECNT = 32768;
constexpr size_t RT_TOKE = 0, RT_TOKG = 128 * 1024, RT_TOKR = 256 * 1024, RT_SLOT = 384 * 1024, RT_HIST = 512 * 1024, RT_SGATE = 576 * 1024;

constexpr int LDS_CTL_OFF = 156672, LDS_TAB_OFF = LDS_CTL_OFF + 256, LDS_BYTES = LDS_CTL_OFF + 2048;

__device__ __forceinline__ unsigned cvt_pk_bf16(float lo, float hi) { unsigned r; asm volatile("v_cvt_pk_bf16_f32 %0, %1, %2" : "=v"(r) : "v"(lo), "v"(hi)); return r; }
typedef __bf16 bf16x2_native __attribute__((ext_vector_type(2)));
__device__ __forceinline__ unsigned cvt_pk_bf16_safe(float lo, float hi) { const f32x2 v = {lo, hi}; const bf16x2_native r = __builtin_convertvector(v, bf16x2_native); return __builtin_bit_cast(unsigned, r); }
__device__ __forceinline__ float bf2f(unsigned short h) { return __uint_as_float((unsigned)h << 16); }
__device__ __forceinline__ float bflo(unsigned w) { return __uint_as_float(w << 16); }
__device__ __forceinline__ float bfhi(unsigned w) { return __uint_as_float(w & 0xffff0000u); }
__device__ __forceinline__ unsigned short f2bf(float f) { return (unsigned short)(cvt_pk_bf16(f, 0.f) & 0xffffu); }
__device__ __forceinline__ unsigned pk4_fp8(float a, float b, float c, float d) { int w = __builtin_amdgcn_cvt_pk_fp8_f32(a, b, 0, false); w = __builtin_amdgcn_cvt_pk_fp8_f32(c, d, w, true); return (unsigned)w; }
constexpr float W_SCALE = 64.f, ACT_SCALE = 4.f, YB_SCALE = 16.f;
__device__ __forceinline__ float wave_sum(float v) {
#pragma unroll
    for (int o = 1; o < 64; o <<= 1) v += __shfl_xor(v, o);
    return v;
}
__device__ __forceinline__ float fast_sigmoid(float x) { return __builtin_amdgcn_rcpf(1.f + __builtin_amdgcn_exp2f(-1.4426950408889634f * x)); }
__device__ __forceinline__ float fexp(float x) { return __builtin_amdgcn_exp2f(1.4426950408889634f * x); }
__device__ __forceinline__ float flog(float x) { return 0.6931471805599453f * __builtin_amdgcn_logf(x); }

#define XB_TMO      128
#define XB_XCNT(j)  (256  + 64 * (j))
#define XB_XSUB(j)  (1280 + 64 * (j))
#define XB_XGEN(j)  (2304 + 64 * (j))
#define XB_TOP      3328
#define XB_TOPGEN   3392
#define XCD_BAR_WORDS 3456
#define XB_SPIN_CAP (1u << 18)
__device__ __forceinline__ unsigned xb_ld(unsigned* p)              { return __hip_atomic_load(p, __ATOMIC_RELAXED, __HIP_MEMORY_SCOPE_AGENT); }
__device__ __forceinline__ unsigned xb_add(unsigned* p, unsigned v) { return __hip_atomic_fetch_add(p, v, __ATOMIC_RELAXED, __HIP_MEMORY_SCOPE_AGENT); }
__device__ __forceinline__ unsigned xb_xcc_id() { return (unsigned)__builtin_amdgcn_s_getreg((3 << 11) | 20) & 0xFu; }
#define XB_SPIN(cond, bar) do { unsigned _sp = 0; while (cond) { __builtin_amdgcn_s_sleep(1); \
    if ((++_sp & 255u) == 0u) { if (xb_ld(&(bar)[XB_TMO])) break; if (_sp > XB_SPIN_CAP) { atomicAdd(&(bar)[XB_TMO], 1u); break; } } } } while (0)
struct XcdBarrier { unsigned* bar; unsigned x; volatile LAS unsigned* st; };
__device__ __forceinline__ XcdBarrier xcd_barrier_post(unsigned* bar, volatile LAS unsigned* st) {
    XcdBarrier b; b.bar = bar; b.x = xb_xcc_id(); b.st = st;
    if (threadIdx.x == 0) (void)xb_add(&bar[XB_XCNT(b.x)], 1u);
    return b;
}
__device__ __forceinline__ void xcd_barrier_complete(unsigned* bar, unsigned x, unsigned& nloc, unsigned& nx) {
    const unsigned G = gridDim.x * gridDim.y * gridDim.z;
    unsigned sum, cnt, mine, sp = 0u;
    for (;;) {
        sum = 0u; cnt = 0u; mine = 0u;
#pragma unroll
        for (unsigned j = 0; j < 16; ++j) { const unsigned c = xb_ld(&bar[XB_XCNT(j)]); sum += c; cnt += (c > 0u) ? 1u : 0u; mine = (j == x) ? c : mine; }
        if (sum == G) break;
        __builtin_amdgcn_s_sleep(1);
        if ((++sp & 255u) == 0u) { if (xb_ld(&bar[XB_TMO])) break; if (sp > XB_SPIN_CAP) { atomicAdd(&bar[XB_TMO], 1u); break; } }
    }
    nloc = mine > 0u ? mine : 1u; nx = cnt > 0u ? cnt : 1u;
}
__device__ __forceinline__ void xcd_barrier(const XcdBarrier& b) {
    asm volatile("s_waitcnt vmcnt(0)" ::: "memory");
    __syncthreads();
    if (threadIdx.x == 0) {
        unsigned* bar = b.bar;
        __builtin_amdgcn_s_waitcnt(0);
        unsigned nloc = b.st[0], nx = b.st[1];
        if (nloc == 0u) { xcd_barrier_complete(bar, b.x, nloc, nx); b.st[0] = nloc; b.st[1] = nx; }
        const unsigned old = xb_add(&bar[XB_XSUB(b.x)], 1u);
        const unsigned gen = old / nloc;
        if (old + 1u == (gen + 1u) * nloc) {
            __builtin_amdgcn_fence(__ATOMIC_RELEASE, "agent");
            asm volatile("s_waitcnt vmcnt(0)" ::: "memory");
            const unsigned og = xb_add(&bar[XB_TOP], 1u);
            const unsigned tg = og / nx;
            if (og + 1u == (tg + 1u) * nx) xb_add(&bar[XB_TOPGEN], 1u);
            else XB_SPIN(xb_ld(&bar[XB_TOPGEN]) == tg, bar);
            __builtin_amdgcn_fence(__ATOMIC_ACQUIRE, "agent");
            xb_add(&bar[XB_XGEN(b.x)], 1u);
            asm volatile("s_waitcnt vmcnt(0)" ::: "memory");
        } else {
            XB_SPIN(xb_ld(&bar[XB_XGEN(b.x)]) == gen, bar);
            __builtin_amdgcn_fence(__ATOMIC_ACQUIRE, "agent");
            asm volatile("s_waitcnt vmcnt(0)" ::: "memory");
        }
    }
    __syncthreads();
}

namespace pg8 {
constexpr int BM = 256, BK = 64, HALF = 128, HTB = HALF * BK * 2, STAGE_BYTES = 8 * HTB, NXCD = 8, WGM = 8;
constexpr int GK = 2048;
__host__ __device__ __forceinline__ int lds_byte(int r, int c) { const int st = (r >> 4) * 2 + (c >> 5), rr = r & 15, cc = c & 31, ob = rr * 64 + cc * 2; return st * 1024 + (ob ^ (((ob >> 9) & 1) << 5)); }
__host__ __device__ __forceinline__ void stage_rc(int b, int& R, int& C) { const int st = b / 1024, sb = b % 1024, swz = sb ^ (((sb >> 9) & 1) << 5); R = (st >> 1) * 16 + swz / 64; C = (st & 1) * 32 + (swz % 64) / 2; }
__host__ __device__ __forceinline__ int perm32(int rho) { const int n = rho >> 4, i = rho & 15; return 8 * (i >> 2) + 4 * n + (i & 3); }

struct Unit { int pm, pn, e, half; };
template <int ROWB> struct TS { static constexpr size_t v = (size_t)BM * ROWB; };

__device__ __forceinline__ int xcd_remap(int wgid, int nwg) { const int q = nwg / NXCD, r = nwg % NXCD, xcd = wgid % NXCD, off = wgid / NXCD; return (xcd < r ? xcd * (q + 1) : r * (q + 1) + (xcd - r) * q) + off; }

template <int ROWB> struct PlainSched {
    const char* A; const char* B; int nM, nN, nwg, G, c, i0 = 0, i1 = 1 << 20;
    __device__ void window(int a, int b) { i0 = a; i1 = b; }
    __device__ void init(const void* A_, const void* B_, int M, int N, int G_, int c_) { A = (const char*)A_; B = (const char*)B_; nM = M / BM; nN = N / BM; nwg = nM * nN; G = G_; c = c_; }
    __device__ __forceinline__ bool next(int i, Unit& u) const {
        if (i + i0 >= i1) return false;
        const long L = (long)(i + i0) * G + c; if (L >= nwg) return false;
        const int wgid = xcd_remap((int)L, nwg);
        const int nig = WGM * nN, gid = wgid / nig, fm = gid * WGM, gsz = (nM - fm) < WGM ? (nM - fm) : WGM;
        u.pm = fm + ((wgid % nig) % gsz); u.pn = (wgid % nig) / gsz; u.e = 0; u.half = 0; return true;
    }
    __device__ __forceinline__ const char* aptr(const Unit& u) const { return A + (size_t)u.pm * TS<ROWB>::v; }
    __device__ __forceinline__ const char* bptr(const Unit& u) const { return B + (size_t)u.pn * TS<ROWB>::v; }
};
template <int ROWB> struct MoeSched {
    const char* A; const char* B; const LAS int* ps; int nN, nwg, G, c, i0 = 0, i1 = 1 << 20;
    __device__ void window(int a, int b) { i0 = a; i1 = b; }
    __device__ void init(const void* A_, const void* B_, const LAS int* ps_, int nN_, int G_, int c_) { A = (const char*)A_; B = (const char*)B_; ps = ps_; nN = nN_; nwg = ps_[64] * nN_; G = G_; c = c_; }
    __device__ __forceinline__ bool next(int i, Unit& u) const {
        if (i + i0 >= i1) return false;
        const long L = (long)(i + i0) * G + c; if (L >= nwg) return false;
        const int wgid = xcd_remap((int)L, nwg);
        int sidx = 0;
#pragma unroll 8
        for (int j = 1; j < 64; ++j) sidx += (wgid >= ps[j] * nN) ? 1 : 0;
        const int e = (sidx >> 3) * 4 + (sidx & 3), kind = (sidx >> 2) & 1, local = wgid - ps[sidx] * nN;
        int pn, r;
        if (kind == 0) { const int nt = ps[sidx + 1] - ps[sidx]; pn = local / nt; r = local % nt; }
        else { pn = local; r = ps[sidx - 3] - ps[sidx - 4]; }
        u.e = __builtin_amdgcn_readfirstlane(e); u.pn = __builtin_amdgcn_readfirstlane(pn); u.pm = __builtin_amdgcn_readfirstlane(e * ECAP_TILES + r); u.half = __builtin_amdgcn_readfirstlane(kind); return true;
    }
    __device__ __forceinline__ const char* aptr(const Unit& u) const { return A + (size_t)u.pm * TS<ROWB>::v; }
    __device__ __forceinline__ const char* bptr(const Unit& u) const { return B + ((size_t)u.e * nN + u.pn) * TS<ROWB>::v; }
};

struct EpiBf16Plain { static constexpr bool PERM = true; bf16_t* O; int ldc;
    __device__ __forceinline__ void operator()(const f32x4 (&acc)[2][2][4][2], const Unit& u, int wr, int wc, int fr, int fq) const {
        const int row0 = u.pm * BM + wr * 64 + fr, col0 = u.pn * BM + wc * 32 + 8 * fq;
#pragma unroll
        for (int ai = 0; ai < 2; ++ai)
#pragma unroll
            for (int m = 0; m < 4; ++m) { bf16_t* rowp = O + (size_t)(row0 + ai * HALF + m * 16) * ldc + col0;
#pragma unroll
                for (int bj = 0; bj < 2; ++bj) { const f32x4 v0 = acc[ai][bj][m][0], v1 = acc[ai][bj][m][1];
                    u32x4 w; w.x = cvt_pk_bf16(v0[0], v0[1]); w.y = cvt_pk_bf16(v0[2], v0[3]); w.z = cvt_pk_bf16(v1[0], v1[1]); w.w = cvt_pk_bf16(v1[2], v1[3]);
                    *(u32x4*)(rowp + bj * HALF) = w; } }
    }
};
struct EpiF32Plain { static constexpr bool PERM = false; float* C; int ldc;
    __device__ __forceinline__ void operator()(const f32x4 (&acc)[2][2][4][2], const Unit& u, int wr, int wc, int fr, int fq) const {
        const int row0 = u.pm * BM + wr * 64 + fr, col0 = u.pn * BM + wc * 32 + 4 * fq;
#pragma unroll
        for (int ai = 0; ai < 2; ++ai)
#pragma unroll
            for (int m = 0; m < 4; ++m) { float* rowp = C + (size_t)(row0 + ai * HALF + m * 16) * ldc + col0;
#pragma unroll
                for (int bj = 0; bj < 2; ++bj)
#pragma unroll
                    for (int n = 0; n < 2; ++n) *(f32x4*)(rowp + bj * HALF + n * 16) = acc[ai][bj][m][n]; }
    }
};
struct EpiSwiglu { static constexpr bool PERM = true; unsigned char* O; const float* b1;
    __device__ __forceinline__ void operator()(const f32x4 (&acc)[2][2][4][2], const Unit& u, int wr, int wc, int fr, int fq) const {
        const int row0 = u.pm * BM + wr * 64 + fr, col0 = u.pn * HALF + wc * 32 + 8 * fq;
        const float* bg = b1 + (size_t)u.e * 4096 + col0;
        f32x4 bgv[2], blv[2];
#pragma unroll
        for (int n = 0; n < 2; ++n) { bgv[n] = *(const f32x4*)(bg + 4 * n); blv[n] = *(const f32x4*)(bg + 2048 + 4 * n); }
#pragma unroll
        for (int ai = 0; ai < 2; ++ai) if (!(ai == 1 && u.half))
#pragma unroll
            for (int m = 0; m < 4; ++m) { unsigned char* rowp = O + (size_t)(row0 + ai * HALF + m * 16) * 2048 + col0;
                float r[8];
#pragma unroll
                for (int n = 0; n < 2; ++n) { const f32x4 g = acc[ai][0][m][n] * (1.f / W_SCALE) + bgv[n], l = acc[ai][1][m][n] * (1.f / W_SCALE) + blv[n];
#pragma unroll
                    for (int j = 0; j < 4; ++j) { const float gg = fminf(g[j], 7.0f), ll = fminf(fmaxf(l[j], -7.0f), 7.0f);
                        r[n * 4 + j] = ACT_SCALE * gg * fast_sigmoid(1.702f * gg) * (ll + 1.0f); } }
                u32x2 w; w.x = pk4_fp8(r[0], r[1], r[2], r[3]); w.y = pk4_fp8(r[4], r[5], r[6], r[7]);
                *(u32x2*)rowp = w; }
    }
};
struct EpiGate { static constexpr bool PERM = true; unsigned char* O; const float* b2; const float* sgate;
    __device__ __forceinline__ void operator()(const f32x4 (&acc)[2][2][4][2], const Unit& u, int wr, int wc, int fr, int fq) const {
        const int row0 = u.pm * BM + wr * 64 + fr, col0 = u.pn * BM + wc * 32 + 8 * fq;
        const float* bb = b2 + (size_t)u.e * 2048 + col0;
        f32x4 bv[2][2];
#pragma unroll
        for (int bj = 0; bj < 2; ++bj)
#pragma unroll
            for (int n = 0; n < 2; ++n) bv[bj][n] = *(const f32x4*)(bb + bj * HALF + 4 * n);
        float gts[2][4];
#pragma unroll
        for (int ai = 0; ai < 2; ++ai)
#pragma unroll
            for (int m = 0; m < 4; ++m) gts[ai][m] = sgate[row0 + ai * HALF + m * 16];
#pragma unroll
        for (int ai = 0; ai < 2; ++ai) if (!(ai == 1 && u.half))
#pragma unroll
            for (int m = 0; m < 4; ++m) { const int row = row0 + ai * HALF + m * 16; const float gt = gts[ai][m] * YB_SCALE; unsigned char* rowp = O + (size_t)row * 2048 + col0;
#pragma unroll
                for (int bj = 0; bj < 2; ++bj) { const f32x4 v0 = (acc[ai][bj][m][0] * (1.f / (W_SCALE * ACT_SCALE)) + bv[bj][0]) * gt, v1 = (acc[ai][bj][m][1] * (1.f / (W_SCALE * ACT_SCALE)) + bv[bj][1]) * gt;
                    u32x2 w; w.x = pk4_fp8(v0[0], v0[1], v0[2], v0[3]); w.y = pk4_fp8(v1[0], v1[1], v1[2], v1[3]);
                    *(u32x2*)(rowp + bj * HALF) = w; } }
    }
};

typedef int i32x4 __attribute__((ext_vector_type(4)));
typedef int i32x8 __attribute__((ext_vector_type(8)));
__device__ __forceinline__ bf16x8 lo8(i32x8 v) { const i32x4 a = __builtin_shufflevector(v, v, 0, 1, 2, 3); return __builtin_bit_cast(bf16x8, a); }
__device__ __forceinline__ bf16x8 hi8(i32x8 v) { const i32x4 a = __builtin_shufflevector(v, v, 4, 5, 6, 7); return __builtin_bit_cast(bf16x8, a); }
__device__ __forceinline__ i32x8 cat8(bf16x8 lo, bf16x8 hi) { const i32x4 a = __builtin_bit_cast(i32x4, lo), b = __builtin_bit_cast(i32x4, hi); return __builtin_shufflevector(a, b, 0, 1, 2, 3, 4, 5, 6, 7); }
template <class Epi, class Sched, bool FP8>
__device__ __forceinline__ void gemm_phase(LAS unsigned char* lds, const Sched& S, const Epi& E) {
    int tid_ = threadIdx.x; asm volatile("" : "+v"(tid_));
    const int tid = tid_, wid = __builtin_amdgcn_readfirstlane(tid >> 6), lane = tid & 63, wr = wid >> 2, wc = wid & 3, fr = lane & 15, fq = lane >> 4;
    constexpr int K = FP8 ? GK / 2 : GK, nt = K / BK;
    unsigned voffA[2], voffB[2];
#pragma unroll
    for (int i = 0; i < 2; ++i) { int R, C; stage_rc(tid * 16 + i * 8192, R, C); const int Rb = Epi::PERM ? ((R & ~31) + perm32(R & 31)) : R;
        voffA[i] = (unsigned)(R * K + C) * 2u; voffB[i] = (unsigned)(Rb * K + C) * 2u; }
    constexpr size_t kstep = (size_t)(BK * 2);
    constexpr size_t hstep = (size_t)HALF * K * 2;
    const unsigned ldsw = (unsigned)wid * 1024u;
    const int aoff = lds_byte(wr * 64 + fr, fq * 8), boff = lds_byte(wc * 32 + fr, fq * 8);
#define PG8_SA(b, h) (((b) * 2 + (h)) * HTB)
#define PG8_SB(b, h) ((4 + (b) * 2 + (h)) * HTB)
#define PG8_STAGE(bufoff, gbase, voff) do { _Pragma("unroll") for (int _i = 0; _i < 2; ++_i) \
        __builtin_amdgcn_global_load_lds((const unsigned*)((const char*)(gbase) + (voff)[_i]), (LAS unsigned*)(lds + (bufoff) + ldsw + _i * 8192), 16, 0, 0); } while (0)
#define PG8_LDA(dst, b, h) do { _Pragma("unroll") for (int m = 0; m < 4; ++m) dst[m] = cat8(*(const LAS bf16x8*)(lds + PG8_SA(b, h) + aoff + m * 2048), *(const LAS bf16x8*)(lds + PG8_SA(b, h) + aoff + m * 2048 + 1024)); } while (0)
#define PG8_LDB(dst, b, h) do { _Pragma("unroll") for (int n = 0; n < 2; ++n) dst[n] = cat8(*(const LAS bf16x8*)(lds + PG8_SB(b, h) + boff + n * 2048), *(const LAS bf16x8*)(lds + PG8_SB(b, h) + boff + n * 2048 + 1024)); } while (0)
#define PG8_MMA(ai, bj, At, Bt) do { __builtin_amdgcn_s_setprio(1); _Pragma("unroll") for (int m = 0; m < 4; ++m) _Pragma("unroll") for (int n = 0; n < 2; ++n) { \
        if constexpr (FP8) asm volatile("v_mfma_scale_f32_16x16x128_f8f6f4 %0, %1, %2, %0, %3, %3 op_sel_hi:[0,0,0]" : "+v"(acc[ai][bj][m][n]) : "v"(Bt[n]), "v"(At[m]), "v"(fp8_one));   \
        else { acc[ai][bj][m][n] = __builtin_amdgcn_mfma_f32_16x16x32_bf16(lo8(Bt[n]), lo8(At[m]), acc[ai][bj][m][n], 0, 0, 0); \
               acc[ai][bj][m][n] = __builtin_amdgcn_mfma_f32_16x16x32_bf16(hi8(Bt[n]), hi8(At[m]), acc[ai][bj][m][n], 0, 0, 0); } } \
        __builtin_amdgcn_s_setprio(0); } while (0)
#define PG8_WAIT_V(n) asm volatile("s_waitcnt vmcnt(" #n ")" ::: "memory")
#define PG8_WAIT_L(n) asm volatile("s_waitcnt lgkmcnt(" #n ")" ::: "memory")
#define PG8_BAR __builtin_amdgcn_s_barrier()
#define PG8_SCHED __builtin_amdgcn_sched_barrier(0)
#define PG8_USE_AT if constexpr (FP8) asm volatile("" :: "v"(At[0]), "v"(At[1]), "v"(At[2]), "v"(At[3]))
    Unit cur, nxt; int ui = 0;
    if (!S.next(0, cur)) return;
    f32x4 acc[2][2][4][2];
#pragma unroll
    for (int a = 0; a < 2; ++a)
#pragma unroll
        for (int b = 0; b < 2; ++b)
#pragma unroll
            for (int m = 0; m < 4; ++m)
#pragma unroll
                for (int n = 0; n < 2; ++n) acc[a][b][m][n] = (f32x4){0.f, 0.f, 0.f, 0.f};
    i32x8 At[4], B0[2], B1[2]; const int fp8_one = 0x7F7F7F7F; (void)fp8_one;
    const char* cA = S.aptr(cur); const char* cB = S.bptr(cur);
    PG8_STAGE(PG8_SB(0, 0), cB, voffB); PG8_STAGE(PG8_SB(0, 1), cB + hstep, voffB); PG8_STAGE(PG8_SA(0, 0), cA, voffA); PG8_STAGE(PG8_SA(0, 1), cA + hstep, voffA);
    if (wr == 1) PG8_BAR;
    PG8_WAIT_V(2); PG8_BAR;
    PG8_STAGE(PG8_SB(1, 0), cB + kstep, voffB); PG8_STAGE(PG8_SA(1, 0), cA + kstep, voffA); PG8_STAGE(PG8_SB(1, 1), cB + hstep + kstep, voffB);
    PG8_WAIT_V(6); PG8_BAR;
    for (;;) {
        const bool has_next = S.next(ui + 1, nxt);
        const char* nA = has_next ? S.aptr(nxt) : cA; const char* nB = has_next ? S.bptr(nxt) : cB;
        for (int t = 0; t < nt; t += 2) {
            const bool last = (t == nt - 2);
            const char* a1 = cA + (size_t)(t + 1) * kstep;
            const char* a2 = last ? nA : cA + (size_t)(t + 2) * kstep; const char* b2 = last ? nB : cB + (size_t)(t + 2) * kstep;
            const char* a3 = a2 + kstep; const char* b3 = b2 + kstep;
            PG8_LDB(B0, 0, 0); PG8_LDB(B1, 0, 1); PG8_SCHED; PG8_LDA(At, 0, 0); PG8_STAGE(PG8_SA(1, 1), a1 + hstep, voffA);
            PG8_WAIT_V(8); PG8_WAIT_L(0); PG8_BAR; PG8_MMA(0, 0, At, B0); PG8_MMA(0, 1, At, B1); PG8_BAR; PG8_SCHED;
            PG8_LDA(At, 0, 1); PG8_STAGE(PG8_SB(0, 0), b2, voffB); PG8_STAGE(PG8_SB(0, 1), b2 + hstep, voffB); PG8_STAGE(PG8_SA(0, 0), a2, voffA);
            PG8_WAIT_V(8); PG8_WAIT_L(0); PG8_BAR; PG8_USE_AT; if (!cur.half) { PG8_MMA(1, 0, At, B0); PG8_MMA(1, 1, At, B1); } PG8_BAR; PG8_SCHED;
            PG8_LDB(B0, 1, 0); PG8_LDB(B1, 1, 1); PG8_SCHED; PG8_LDA(At, 1, 0); PG8_STAGE(PG8_SA(0, 1), a2 + hstep, voffA);
            PG8_WAIT_V(8); PG8_WAIT_L(0); PG8_BAR; PG8_MMA(0, 0, At, B0); PG8_MMA(0, 1, At, B1); PG8_BAR; PG8_SCHED;
            PG8_LDA(At, 1, 1); PG8_STAGE(PG8_SB(1, 0), b3, voffB); PG8_STAGE(PG8_SB(1, 1), b3 + hstep, voffB); PG8_STAGE(PG8_SA(1, 0), a3, voffA);
            PG8_WAIT_V(8); PG8_WAIT_L(0); PG8_BAR; PG8_USE_AT; if (!cur.half) { PG8_MMA(1, 0, At, B0); PG8_MMA(1, 1, At, B1); } PG8_BAR; PG8_SCHED;
        }
        if (wr == 0) PG8_BAR;
        E(acc, cur, wr, wc, fr, fq);
        if (!has_next) break;
#pragma unroll
        for (int a = 0; a < 2; ++a)
#pragma unroll
            for (int b = 0; b < 2; ++b)
#pragma unroll
                for (int m = 0; m < 4; ++m)
#pragma unroll
                    for (int n = 0; n < 2; ++n) acc[a][b][m][n] = (f32x4){0.f, 0.f, 0.f, 0.f};
        cur = nxt; cA = nA; cB = nB; ++ui;
        if (wr == 1) PG8_BAR;
    }
    PG8_WAIT_V(0);
    PG8_BAR;
#undef PG8_SA
#undef PG8_SB
#undef PG8_STAGE
#undef PG8_LDA
#undef PG8_LDB
#undef PG8_MMA
#undef PG8_WAIT_V
#undef PG8_WAIT_L
#undef PG8_BAR
#undef PG8_SCHED
#undef PG8_USE_AT
}
}

namespace att {
constexpr int D = 128, NW = 8, QBLK = 32, KVBLK = 64;
constexpr float SCALE = 0.088388347648318440f;
constexpr float THR = 8.f;
constexpr int LDQ = PW, LDK = 512, LDO = 2048;
constexpr size_t SHM_V = KVBLK * D * 2, SHM_K = KVBLK * D * 2, SHM_ATTN = 2 * SHM_V + 2 * SHM_K + NW * 64 * 4;
#define KSWZ(row, colB) ((row) * 256 + ((colB) ^ (((row) & 7) << 4)))
#define SBAR() __builtin_amdgcn_sched_barrier(0)
__device__ __forceinline__ int crow(int r, int hi) { return (r & 3) + 8 * (r >> 2) + 4 * hi; }
__device__ __forceinline__ void partialSM(f32x16& p0, f32x16& p1, float& m_reg, float& mn, float& alpha) {
  constexpr float C = SCALE * 1.4426950408889634f;
  float pmax = p0[0]; for (int r = 1; r < 16; ++r) pmax = fmaxf(pmax, p0[r]); for (int r = 0; r < 16; ++r) pmax = fmaxf(pmax, p1[r]);
  { auto rr = __builtin_amdgcn_permlane32_swap(__float_as_uint(pmax), __float_as_uint(pmax), false, false);
    pmax = fmaxf(__uint_as_float(rr[0]), __uint_as_float(rr[1])); }
  if (__builtin_expect(__all(pmax - m_reg <= THR / SCALE), 1)) { mn = m_reg; alpha = 1.f; }
  else { mn = fmaxf(m_reg, pmax); alpha = __builtin_amdgcn_exp2f((m_reg - mn) * C); m_reg = mn; }
  float mnC = -mn * C;
  for (int r = 0; r < 16; ++r) p0[r] = fmaf(p0[r], C, mnC); for (int r = 0; r < 16; ++r) p1[r] = fmaf(p1[r], C, mnC);
  for (int r = 0; r < 16; ++r) p0[r] = __builtin_amdgcn_exp2f(p0[r]);
}
__device__ __forceinline__ void finishSM(f32x16& p0, f32x16& p1, float alpha, float& l_reg, bf16x8& pa0, bf16x8& pa1, bf16x8& pa2, bf16x8& pa3) {
  for (int r = 0; r < 16; ++r) p1[r] = __builtin_amdgcn_exp2f(p1[r]);
  float ps = 0; for (int r = 0; r < 16; ++r) ps += p0[r]; for (int r = 0; r < 16; ++r) ps += p1[r];
  { auto rr = __builtin_amdgcn_permlane32_swap(__float_as_uint(ps), __float_as_uint(ps), false, false);
    ps = __uint_as_float(rr[0]) + __uint_as_float(rr[1]); }
  l_reg = l_reg * alpha + ps;
#define PK4(P, BASE, OUT) do { unsigned a0 = cvt_pk_bf16(P[BASE + 0], P[BASE + 1]), a1 = cvt_pk_bf16(P[BASE + 2], P[BASE + 3]);   \
    unsigned b0 = cvt_pk_bf16(P[BASE + 4], P[BASE + 5]), b1 = cvt_pk_bf16(P[BASE + 6], P[BASE + 7]);                              \
    auto r0 = __builtin_amdgcn_permlane32_swap(a0, b0, false, false); auto r1 = __builtin_amdgcn_permlane32_swap(a1, b1, false, false); \
    u32x4 w = {r0[0], r1[0], r0[1], r1[1]}; OUT = *reinterpret_cast<bf16x8*>(&w); } while (0)
  PK4(p0, 0, pa0); PK4(p0, 8, pa1); PK4(p1, 0, pa2); PK4(p1, 8, pa3);
#undef PK4
}
__device__ __forceinline__ void qkt(f32x16& p0, f32x16& p1, const bf16_t* Ks, const bf16x8* qr, int r32, int hi) {
  p0 = f32x16{}; p1 = f32x16{};
  for (int d0 = 0; d0 < 8; ++d0) { int cb = (d0 * 16 + hi * 8) * 2;
    bf16x8 b0 = *reinterpret_cast<const bf16x8*>((const char*)Ks + KSWZ(r32, cb));
    bf16x8 b1 = *reinterpret_cast<const bf16x8*>((const char*)Ks + KSWZ(32 + r32, cb));
    p0 = __builtin_amdgcn_mfma_f32_32x32x16_bf16(b0, qr[d0], p0, 0, 0, 0);
    p1 = __builtin_amdgcn_mfma_f32_32x32x16_bf16(b1, qr[d0], p1, 0, 0, 0); }
}
__device__ __forceinline__ int v_st(int k, int c) { const int kk = (k & ~0xC) | ((k & 4) << 1) | ((k & 8) >> 1); return ((kk >> 3) * 4 + (c >> 5)) * 512 + ((kk & 7) * 32 + (c & 31)) * 2; }
__device__ __forceinline__ int v_rd_base(int lane) { return ((lane & 3) << 3) | (((lane >> 2) & 3) << 6) | (((lane >> 4) & 1) << 5) | (((lane >> 5) & 1) << 8); }
constexpr int v_rd_off(int d0, int ks, int half) { return d0 * 512 + ks * 4096 + half * 2048; }
template <int OFF> __device__ __forceinline__ s16x4 tr_read(int vb) {
  s16x4 r; asm volatile("ds_read_b64_tr_b16 %0, %1 offset:%2" : "=&v"(r) : "v"(vb), "i"(OFF) : "memory"); return r;
}
template <int D0> __device__ __forceinline__ void pv_one(f32x16& od, int vb, bf16x8 pa0, bf16x8 pa1, bf16x8 pa2, bf16x8 pa3) {
  const s16x4 l0 = tr_read<v_rd_off(D0, 0, 0)>(vb), h0 = tr_read<v_rd_off(D0, 0, 1)>(vb), l1 = tr_read<v_rd_off(D0, 1, 0)>(vb), h1 = tr_read<v_rd_off(D0, 1, 1)>(vb);
  const s16x4 l2 = tr_read<v_rd_off(D0, 2, 0)>(vb), h2 = tr_read<v_rd_off(D0, 2, 1)>(vb), l3 = tr_read<v_rd_off(D0, 3, 0)>(vb), h3 = tr_read<v_rd_off(D0, 3, 1)>(vb);
  asm volatile("s_waitcnt lgkmcnt(0)" ::: "memory"); SBAR();
#define PK(L, H) (bf16x8){L[0], L[1], L[2], L[3], H[0], H[1], H[2], H[3]}
  od = __builtin_amdgcn_mfma_f32_32x32x16_bf16(pa0, PK(l0, h0), od, 0, 0, 0);
  od = __builtin_amdgcn_mfma_f32_32x32x16_bf16(pa1, PK(l1, h1), od, 0, 0, 0);
  od = __builtin_amdgcn_mfma_f32_32x32x16_bf16(pa2, PK(l2, h2), od, 0, 0, 0);
  od = __builtin_amdgcn_mfma_f32_32x32x16_bf16(pa3, PK(l3, h3), od, 0, 0, 0);
#undef PK
}
__device__ __forceinline__ void pv_d0(f32x16* o, int vb, bf16x8 pa0, bf16x8 pa1, bf16x8 pa2, bf16x8 pa3) {
  pv_one<0>(o[0], vb, pa0, pa1, pa2, pa3); pv_one<1>(o[1], vb, pa0, pa1, pa2, pa3); pv_one<2>(o[2], vb, pa0, pa1, pa2, pa3); pv_one<3>(o[3], vb, pa0, pa1, pa2, pa3);
}
__device__ __forceinline__ void load_q(bf16x8* qr, const bf16_t* Qw, const float* qnw, int pos, int hi) {
  float qf[64]; float ssq = 0.f;
#pragma unroll
  for (int d0 = 0; d0 < 8; ++d0) { const u32x4 raw = *reinterpret_cast<const u32x4*>(Qw + d0 * 16);
#pragma unroll
    for (int i = 0; i < 4; ++i) { const float a = bflo(raw[i]), b = bfhi(raw[i]); qf[d0 * 8 + 2 * i] = a; qf[d0 * 8 + 2 * i + 1] = b; ssq += a * a + b * b; } }
  ssq += __shfl_xor(ssq, 32);
  const float rn = __builtin_amdgcn_rsqf(ssq * (1.f / 128.f) + EPS);
#pragma unroll
  for (int d0 = 0; d0 < 8; ++d0) { const f32x4 w0 = *reinterpret_cast<const f32x4*>(qnw + d0 * 16 + hi * 8), w1 = *reinterpret_cast<const f32x4*>(qnw + d0 * 16 + hi * 8 + 4);
#pragma unroll
    for (int i = 0; i < 4; ++i) { qf[d0 * 8 + i] *= rn * w0[i]; qf[d0 * 8 + 4 + i] *= rn * w1[i]; } }
  const float prow = (float)(pos / 64 - 16), pcol = (float)(pos % 64 - 32);
#pragma unroll
  for (int d0 = 0; d0 < 2; ++d0)
#pragma unroll
    for (int i = 0; i < 8; ++i) { const int j = d0 * 16 + hi * 8 + i;
      const float invf = __builtin_amdgcn_exp2f(-(float)j * 0.41524101186092029f);
      float rv = prow * invf * 0.15915494309189535f; rv -= rintf(rv);
      float s = __builtin_amdgcn_sinf(rv), c = __builtin_amdgcn_cosf(rv);
      float x1 = qf[d0 * 8 + i], x2 = qf[(d0 + 2) * 8 + i]; qf[d0 * 8 + i] = x1 * c - x2 * s; qf[(d0 + 2) * 8 + i] = x2 * c + x1 * s;
      rv = pcol * invf * 0.15915494309189535f; rv -= rintf(rv);
      s = __builtin_amdgcn_sinf(rv); c = __builtin_amdgcn_cosf(rv);
      x1 = qf[(d0 + 4) * 8 + i]; x2 = qf[(d0 + 6) * 8 + i]; qf[(d0 + 4) * 8 + i] = x1 * c - x2 * s; qf[(d0 + 6) * 8 + i] = x2 * c + x1 * s; }
#pragma unroll
  for (int d0 = 0; d0 < 8; ++d0) { u32x4 w = {cvt_pk_bf16(qf[d0 * 8 + 0], qf[d0 * 8 + 1]), cvt_pk_bf16(qf[d0 * 8 + 2], qf[d0 * 8 + 3]), cvt_pk_bf16(qf[d0 * 8 + 4], qf[d0 * 8 + 5]), cvt_pk_bf16(qf[d0 * 8 + 6], qf[d0 * 8 + 7])};
    qr[d0] = *reinterpret_cast<bf16x8*>(&w); }
}
__device__ __forceinline__ void attn_unit(const bf16_t* __restrict__ Qb, const bf16_t* __restrict__ Kh, const bf16_t* __restrict__ Vh,
                                          bf16_t* __restrict__ Ob, const float* qnw, const float* anw, int pos0, int seq, char* lds) {
  int tid_ = threadIdx.x; asm volatile("" : "+v"(tid_));
  asm volatile("" : "+s"(qnw), "+s"(anw));
  const int tid = tid_, wid = tid >> 6, lane = tid & 63, r32 = lane & 31, hi = lane >> 5;
  bf16_t* V_lds = (bf16_t*)lds; bf16_t* K_lds = (bf16_t*)(lds + 2 * SHM_V);
  float* ws = (float*)(lds + 2 * SHM_V + 2 * SHM_K) + wid * 64; float* li_l = ws; float* al_l = ws + 32;
  float m_reg = -1e30f, l_reg = 0; f32x16 o[4] = {}; bf16x8 qr[8];
  load_q(qr, Qb + (long)(wid * QBLK + r32) * LDQ + hi * 8, qnw, pos0 + wid * QBLK + r32, hi);
  const int sr = tid >> 4, sc = (tid & 15) * 8, vst0 = v_st(sr, sc), vst1 = v_st(32 + sr, sc);
  const int vb0 = (int)(uintptr_t)V_lds + v_rd_base(lane);
  struct { bf16x8 vs0, vs1, ks0, ks1; } sr_[2];
#define LD8(p) (*reinterpret_cast<const bf16x8*>(p))
#define SLOAD(i, k0) do { sr_[i].vs0 = LD8(&Vh[(long)((k0) + sr) * LDK + sc]); sr_[i].vs1 = LD8(&Vh[(long)((k0) + 32 + sr) * LDK + sc]); \
    sr_[i].ks0 = LD8(&Kh[(long)((k0) + sr) * LDK + sc]); sr_[i].ks1 = LD8(&Kh[(long)((k0) + 32 + sr) * LDK + sc]); } while (0)
#define SWRITE(b, i) do { *(bf16x8*)((char*)V_lds + (b) * SHM_V + vst0) = sr_[i].vs0;          \
    *(bf16x8*)((char*)V_lds + (b) * SHM_V + vst1) = sr_[i].vs1; int kc = sc * 2;               \
    *(bf16x8*)((char*)K_lds + (b) * SHM_K + KSWZ(sr, kc)) = sr_[i].ks0;                       \
    *(bf16x8*)((char*)K_lds + (b) * SHM_K + KSWZ(32 + sr, kc)) = sr_[i].ks1; } while (0)
#define SWAIT() asm volatile("s_waitcnt vmcnt(4)" ::: "memory")
#define RESC(a) do { if (__any((a) < 1.f)) { if (hi == 0) al_l[r32] = (a); asm volatile("s_waitcnt lgkmcnt(0)" ::: "memory"); \
    for (int d = 0; d < 4; ++d) for (int r = 0; r < 16; ++r) o[d][r] *= al_l[crow(r, hi)]; } } while (0)
  f32x16 pA0, pA1, pB0, pB1; float mnA, mnB, alA, alB; bf16x8 pa0, pa1, pa2, pa3; const int NT = seq / KVBLK;
  constexpr int SE = 0, SO = 1;
  SLOAD(SE, 0); asm volatile("s_waitcnt vmcnt(0)" ::: "memory"); SWRITE(0, SE); __syncthreads();
  qkt(pA0, pA1, K_lds, qr, r32, hi); partialSM(pA0, pA1, m_reg, mnA, alA);
  SLOAD(SO, KVBLK); if (2 < NT) SLOAD(SE, 2 * KVBLK);
  SWAIT(); SWRITE(1, SO); __syncthreads();
  for (int j = 1; j + 1 < NT; j += 2) {
    SBAR(); qkt(pB0, pB1, (bf16_t*)((char*)K_lds + SHM_K), qr, r32, hi);
    finishSM(pA0, pA1, alA, l_reg, pa0, pa1, pa2, pa3); SBAR();
    SLOAD(SO, (j + 2) * KVBLK); SBAR();
    pv_d0(o, vb0, pa0, pa1, pa2, pa3); partialSM(pB0, pB1, m_reg, mnB, alB);
    __syncthreads(); SWAIT(); SWRITE(0, SE);
    RESC(alB); __syncthreads();
    SBAR(); qkt(pA0, pA1, K_lds, qr, r32, hi);
    finishSM(pB0, pB1, alB, l_reg, pa0, pa1, pa2, pa3); SBAR();
    if (j + 3 < NT) SLOAD(SE, (j + 3) * KVBLK); SBAR();
    pv_d0(o, vb0 + (int)SHM_V, pa0, pa1, pa2, pa3); partialSM(pA0, pA1, m_reg, mnA, alA);
    __syncthreads(); SWAIT(); SWRITE(1, SO);
    RESC(alA); __syncthreads();
  }
  SBAR(); qkt(pB0, pB1, (bf16_t*)((char*)K_lds + SHM_K), qr, r32, hi);
  finishSM(pA0, pA1, alA, l_reg, pa0, pa1, pa2, pa3); SBAR();
  pv_d0(o, vb0, pa0, pa1, pa2, pa3); partialSM(pB0, pB1, m_reg, mnB, alB);
  __syncthreads(); RESC(alB);
  finishSM(pB0, pB1, alB, l_reg, pa0, pa1, pa2, pa3); SBAR();
  pv_d0(o, vb0 + (int)SHM_V, pa0, pa1, pa2, pa3);
  if (hi == 0) li_l[r32] = l_reg; asm volatile("s_waitcnt lgkmcnt(0)" ::: "memory");
  bf16_t* Ow = Ob + (long)(wid * QBLK) * LDO;
  char* ost = lds + 69632 + wid * 8704;
  float aw[4];
#pragma unroll
  for (int d0 = 0; d0 < 4; ++d0) aw[d0] = anw[d0 * 32 + r32];
#pragma unroll
  for (int r = 0; r < 16; ++r) { const int orow = crow(r, hi); const float rli = __builtin_amdgcn_rcpf(li_l[orow]);
    float ss = 0.f;
#pragma unroll
    for (int d0 = 0; d0 < 4; ++d0) { const float v = o[d0][r] * rli; o[d0][r] = v; ss += v * v; }
#pragma unroll
    for (int x = 1; x < 32; x <<= 1) ss += __shfl_xor(ss, x);
    const float rs = __builtin_amdgcn_rsqf(ss * (1.f / 128.f) + EPS);
#pragma unroll
    for (int d0 = 0; d0 < 4; ++d0) *(unsigned short*)(ost + orow * 272 + (d0 * 32 + r32) * 2) = f2bf(o[d0][r] * rs * aw[d0]); }
  asm volatile("s_waitcnt lgkmcnt(0)" ::: "memory");
#pragma unroll
  for (int q = 0; q < 8; ++q) { const int id = q * 64 + lane, row = id >> 4, ch = id & 15;
    const u32x4 w = *(const u32x4*)(ost + row * 272 + ch * 16);
    *(u32x4*)(Ow + (long)row * LDO + ch * 8) = w; }
  __syncthreads();
#undef LD8
#undef SLOAD
#undef SWRITE
#undef SWAIT
#undef RESC
}
}

struct Frame {
    LAS unsigned char* lds; int tid, lane, wave, G, bid;
    const float *x, *c, *w_ada, *b_ada, *w_in, *q_norm_w, *k_norm_w, *attn_norm_w, *hgrn_lb, *hgrn_norm_w, *w_out, *ln1_g, *ln1_b, *w_router, *b_router, *w1, *b1, *w2, *b2, *ln2_g, *ln2_b;
    float* out; unsigned char* ws;
};

__device__ __forceinline__ void p0_adaln(Frame& F) {
    LAS float* sc = (LAS float*)F.lds;
    LAS float* red = sc + 1024;
    float* modp = (float*)(F.ws + WS_MODP);
    for (int it = F.bid; it < 768; it += F.G) {
        const int cc = it % 96, ks = it / 96, c0 = cc * 128, k0 = ks * 256;
        __syncthreads();
        for (int i = F.tid; i < 1024; i += NTHR) { const int b = i >> 8, k = i & 255; const float v = F.c[b * 2048 + k0 + k]; sc[i] = v / (1.f + __expf(-v)); }
        __syncthreads();
        const int col4 = F.tid & 31, kr = F.tid >> 5;
        f32x4 a0 = {0, 0, 0, 0}, a1 = a0, a2 = a0, a3 = a0;
#pragma unroll 8
        for (int i = 0; i < 16; ++i) { const int k = kr + 16 * i; const f32x4 w = __builtin_nontemporal_load((const f32x4*)(F.w_ada + (size_t)(k0 + k) * 12288 + c0 + 4 * col4));
            a0 += w * sc[k]; a1 += w * sc[256 + k]; a2 += w * sc[512 + k]; a3 += w * sc[768 + k]; }
        *(LAS f32x4*)(red + (kr * 4 + 0) * 128 + 4 * col4) = a0; *(LAS f32x4*)(red + (kr * 4 + 1) * 128 + 4 * col4) = a1;
        *(LAS f32x4*)(red + (kr * 4 + 2) * 128 + 4 * col4) = a2; *(LAS f32x4*)(red + (kr * 4 + 3) * 128 + 4 * col4) = a3;
        __syncthreads();
        { const int b = F.tid >> 7, col = F.tid & 127; float s = 0.f;
#pragma unroll
          for (int r = 0; r < 16; ++r) s += red[(r * 4 + b) * 128 + col];
          modp[(size_t)(ks * 4 + b) * 12288 + c0 + col] = s; }
    }
    __syncthreads();
}
struct TrItem { const float* src; bf16_t* dst; int N; };
__device__ __forceinline__ TrItem tr_decode(Frame& F, int it, int& k0, int& n0, int& drow0) {
    TrItem t; int kt, ntile;
    if (it < 832) { t.src = F.w_in; t.N = PW; t.dst = (bf16_t*)(F.ws + WS_WIN_T); ntile = 52; kt = it / ntile; n0 = (it % ntile) * 128; drow0 = n0; }
    else if (it < 1088) { it -= 832; t.src = F.w_out; t.N = 2048; t.dst = (bf16_t*)(F.ws + WS_WOUT_T); ntile = 16; kt = it / ntile; n0 = (it % ntile) * 128; drow0 = n0; }
    else if (it < 1088 + 16384) { it -= 1088; const int e = it >> 9; it &= 511; t.src = F.w1 + (size_t)e * 2048 * 4096; t.N = 4096; t.dst = (bf16_t*)(F.ws + WS_W1T + (size_t)e * 4096 * 2048);
        kt = it >> 5; n0 = (it & 31) * 128; drow0 = n0 < 2048 ? (n0 >> 7) * 256 : ((n0 - 2048) >> 7) * 256 + 128; }
    else { it -= 1088 + 16384; const int e = it >> 8; it &= 255; t.src = F.w2 + (size_t)e * 2048 * 2048; t.N = 2048; t.dst = (bf16_t*)(F.ws + WS_W2T + (size_t)e * 2048 * 2048);
        kt = it >> 4; n0 = (it & 15) * 128; drow0 = n0; }
    k0 = kt * 128; return t;
}
struct TrParm { const float* src; unsigned char* dst; int N, k0, n0, dr0; };
__device__ __forceinline__ TrParm tr_parm(Frame& F, int it) { TrParm q; int k0, n0, dr0; const TrItem t = tr_decode(F, it, k0, n0, dr0); q.src = t.src; q.dst = (unsigned char*)t.dst; q.N = t.N; q.k0 = k0; q.n0 = n0; q.dr0 = dr0; return q; }
template <bool FP8>
__device__ __forceinline__ void tr_emit(Frame& F, const f32x4 (&cur)[8], const TrParm& q, LAS unsigned char* tl, int n4, int kg) {
    if constexpr (FP8) {
#pragma unroll
        for (int i = 0; i < 4; ++i) { u32x2 w; w.x = pk4_fp8(cur[0][i] * W_SCALE, cur[1][i] * W_SCALE, cur[2][i] * W_SCALE, cur[3][i] * W_SCALE); w.y = pk4_fp8(cur[4][i] * W_SCALE, cur[5][i] * W_SCALE, cur[6][i] * W_SCALE, cur[7][i] * W_SCALE);
            const int n = 4 * n4 + i; *(LAS u32x2*)(tl + n * 128 + ((kg ^ (2 * (n4 & 7))) * 8)) = w; }
        __syncthreads();
#pragma unroll
        for (int qq = 0; qq < 2; ++qq) { const int id = F.tid + NTHR * qq, n = id >> 3, pc = id & 7, kgl = (2 * pc) ^ (2 * ((n >> 2) & 7));
            const u32x4 w = *(LAS u32x4*)(tl + n * 128 + pc * 16);
            __builtin_nontemporal_store(w, (u32x4*)(q.dst + (size_t)(q.dr0 + n) * 2048 + q.k0 + 8 * kgl)); }
    } else {
#pragma unroll
        for (int i = 0; i < 4; ++i) { u32x4 w; w.x = cvt_pk_bf16(cur[0][i], cur[1][i]); w.y = cvt_pk_bf16(cur[2][i], cur[3][i]); w.z = cvt_pk_bf16(cur[4][i], cur[5][i]); w.w = cvt_pk_bf16(cur[6][i], cur[7][i]);
            const int n = 4 * n4 + i; *(LAS u32x4*)(tl + n * 256 + ((kg ^ (n4 & 15)) * 16)) = w; }
        __syncthreads();
#pragma unroll
        for (int qq = 0; qq < 4; ++qq) { const int id = F.tid + NTHR * qq, n = id >> 4, pc = id & 15, kgl = pc ^ ((n >> 2) & 15);
            const u32x4 w = *(LAS u32x4*)(tl + n * 256 + pc * 16);
            *(u32x4*)(q.dst + ((size_t)(q.dr0 + n) * 2048 + q.k0 + 8 * kgl) * 2) = w; }
    }
}
#define TR_LOAD(buf, q) do { _Pragma("unroll") for (int j_ = 0; j_ < 8; ++j_) buf[j_] = __builtin_nontemporal_load((const f32x4*)((q).src + (size_t)((q).k0 + 8 * kg + j_) * (q).N + (q).n0 + 4 * n4)); } while (0)
template <bool FP8>
__device__ __forceinline__ void conv_items(Frame& F, int it0, int it1, int idx = -1, int stride = 0) {
    const int n4 = F.tid & 31, kg = F.tid >> 5, G = stride > 0 ? stride : F.G;
    int nx = it0 + (idx >= 0 ? idx : F.bid); if (nx >= it1) return;
    TrParm qa = tr_parm(F, nx), qb = qa, qc = qa, qd = qa; f32x4 a[8], b[8], c[8], d[8];
    bool va = true, vb, vc, vd;
    TR_LOAD(a, qa); nx += G;
    vb = nx < it1; if (vb) { qb = tr_parm(F, nx); TR_LOAD(b, qb); } nx += G;
    vc = nx < it1; if (vc) { qc = tr_parm(F, nx); TR_LOAD(c, qc); } nx += G;
    vd = nx < it1; if (vd) { qd = tr_parm(F, nx); TR_LOAD(d, qd); } nx += G;
    for (;;) {
        tr_emit<FP8>(F, a, qa, F.lds, n4, kg);
        va = nx < it1; if (va) { qa = tr_parm(F, nx); TR_LOAD(a, qa); } nx += G;
        if (!vb) break;
        tr_emit<FP8>(F, b, qb, F.lds + 32768, n4, kg);
        vb = nx < it1; if (vb) { qb = tr_parm(F, nx); TR_LOAD(b, qb); } nx += G;
        if (!vc) break;
        tr_emit<FP8>(F, c, qc, F.lds, n4, kg);
        vc = nx < it1; if (vc) { qc = tr_parm(F, nx); TR_LOAD(c, qc); } nx += G;
        if (!vd) break;
        tr_emit<FP8>(F, d, qd, F.lds + 32768, n4, kg);
        vd = nx < it1; if (vd) { qd = tr_parm(F, nx); TR_LOAD(d, qd); } nx += G;
        if (!va) break;
    }
    __syncthreads();
}
struct TrX { const char* sl; unsigned char* sd; };
template <bool W2>
__device__ __forceinline__ TrX tr_parm_x(Frame& F, int it) {
    TrX q;
    if constexpr (!W2) { it -= 1088; const int e = it >> 9, r = it & 511, nn = r & 31, k0 = (r >> 5) * 128, dr0 = (nn & 15) * 256 + (nn >> 4) * 128;
        q.sl = (const char*)(F.w1 + (size_t)e * 2048 * 4096 + (size_t)k0 * 4096 + nn * 128); q.sd = F.ws + WS_W1T + (size_t)e * 4096 * 2048 + (size_t)dr0 * 2048 + k0; }
    else { it -= 1088 + 16384; const int e = it >> 8, r = it & 255, nn = r & 15, k0 = (r >> 4) * 128;
        q.sl = (const char*)(F.w2 + (size_t)e * 2048 * 2048 + (size_t)k0 * 2048 + nn * 128); q.sd = F.ws + WS_W2T + (size_t)e * 2048 * 2048 + (size_t)nn * 128 * 2048 + k0; }
    return q;
}
__device__ __forceinline__ unsigned pk4_fp8u(f32x2 lo, f32x2 hi) { int w; asm("" : "=v"(w)); w = __builtin_amdgcn_cvt_pk_fp8_f32(lo[0], lo[1], w, false); w = __builtin_amdgcn_cvt_pk_fp8_f32(hi[0], hi[1], w, true); return (unsigned)w; }
template <bool W2>
__device__ __forceinline__ void tra_load(f32x4 (&buf)[8], const TrX& q, unsigned voffL) {
    constexpr size_t RB = (W2 ? 2048 : 4096) * 4;
#pragma unroll
    for (int j = 0; j < 8; ++j) { const char* sb = q.sl + j * RB; asm volatile("global_load_dwordx4 %0, %1, %2 nt" : "=v"(buf[j]) : "v"(voffL), "s"(sb) : "memory"); }
}
#define TRA_WAIT(N, buf) asm volatile("s_waitcnt vmcnt(" #N ")" : "+v"(buf[0]), "+v"(buf[1]), "+v"(buf[2]), "+v"(buf[3]), "+v"(buf[4]), "+v"(buf[5]), "+v"(buf[6]), "+v"(buf[7]) :: "memory")
__device__ __forceinline__ void tra_emit(const f32x4 (&cur)[8], const TrX& q, LAS unsigned char* tl, unsigned ldsw, unsigned ldsr, unsigned voffS0, unsigned voffS1) {
    f32x4 sc[8];
#pragma unroll
    for (int j = 0; j < 8; ++j) sc[j] = cur[j] * W_SCALE;
#pragma unroll
    for (int i = 0; i < 4; ++i) { u32x2 w; w.x = pk4_fp8u((f32x2){sc[0][i], sc[1][i]}, (f32x2){sc[2][i], sc[3][i]}); w.y = pk4_fp8u((f32x2){sc[4][i], sc[5][i]}, (f32x2){sc[6][i], sc[7][i]});
        *(LAS u32x2*)(tl + ldsw + i * 128) = w; }
    __syncthreads();
    const u32x4 w0 = *(LAS u32x4*)(tl + ldsr), w1 = *(LAS u32x4*)(tl + ldsr + 8192);
    asm volatile("global_store_dwordx4 %0, %1, %2 nt" :: "v"(voffS0), "v"(w0), "s"(q.sd) : "memory");
    asm volatile("global_store_dwordx4 %0, %1, %2 nt" :: "v"(voffS1), "v"(w1), "s"(q.sd) : "memory");
}
template <bool W2>
__device__ __forceinline__ void conv_pipe(Frame& F, int it0, int it1, int idx = -1, int stride = 0) {
    const int n4 = F.tid & 31, kg = F.tid >> 5, G = stride > 0 ? stride : F.G;
    const int first = it0 + (idx >= 0 ? idx : F.bid); if (first >= it1) return;
    const int n = (it1 - first + G - 1) / G;
    if (n < 8) { conv_items<true>(F, it0, it1, idx, stride); return; }
    const unsigned voffL = (unsigned)((8 * kg) * (W2 ? 2048 : 4096) + 4 * n4) * 4u;
    const unsigned ldsw = (unsigned)(4 * n4 * 128 + ((kg ^ (2 * (n4 & 7))) * 8)), ldsr = (unsigned)F.tid * 16u;
    unsigned voffS0, voffS1; { const int nr = F.tid >> 3, pc = F.tid & 7; voffS0 = (unsigned)(nr * 2048 + 8 * ((2 * pc) ^ (2 * ((nr >> 2) & 7)))); const int nr1 = nr + 64; voffS1 = (unsigned)(nr1 * 2048 + 8 * ((2 * pc) ^ (2 * ((nr1 >> 2) & 7)))); }
    LAS unsigned char* const t0 = F.lds; LAS unsigned char* const t1 = F.lds + 32768;
    f32x4 a[8], b[8], c[8], d[8];
    TrX qa = tr_parm_x<W2>(F, first), qb = tr_parm_x<W2>(F, first + G), qc = tr_parm_x<W2>(F, first + 2 * G), qd = tr_parm_x<W2>(F, first + 3 * G);
    tra_load<W2>(a, qa, voffL); tra_load<W2>(b, qb, voffL); tra_load<W2>(c, qc, voffL); tra_load<W2>(d, qd, voffL);
    int nx = first + 4 * G, left = n - 8;
#define TRA_STEP(N, buf, q, tl, nxt) do { TRA_WAIT(N, buf); tra_emit(buf, q, tl, ldsw, ldsr, voffS0, voffS1); q = tr_parm_x<W2>(F, nxt); tra_load<W2>(buf, q, voffL); } while (0)
    TRA_STEP(24, a, qa, t0, nx); TRA_STEP(26, b, qb, t1, nx + G); TRA_STEP(28, c, qc, t0, nx + 2 * G); TRA_STEP(30, d, qd, t1, nx + 3 * G);
    nx += 4 * G;
    while (left >= 4) {
        TRA_STEP(30, a, qa, t0, nx); TRA_STEP(30, b, qb, t1, nx + G); TRA_STEP(30, c, qc, t0, nx + 2 * G); TRA_STEP(30, d, qd, t1, nx + 3 * G);
        nx += 4 * G; left -= 4;
    }
    TRA_WAIT(30, a); tra_emit(a, qa, t0, ldsw, ldsr, voffS0, voffS1); if (left > 0) { qa = tr_parm_x<W2>(F, nx);         tra_load<W2>(a, qa, voffL); }
    TRA_WAIT(22, b); tra_emit(b, qb, t1, ldsw, ldsr, voffS0, voffS1); if (left > 1) { qb = tr_parm_x<W2>(F, nx + G);     tra_load<W2>(b, qb, voffL); }
    TRA_WAIT(14, c); tra_emit(c, qc, t0, ldsw, ldsr, voffS0, voffS1); if (left > 2) { qc = tr_parm_x<W2>(F, nx + 2 * G); tra_load<W2>(c, qc, voffL); }
    TRA_WAIT(6, d);  tra_emit(d, qd, t1, ldsw, ldsr, voffS0, voffS1);
    if (left > 0) { TRA_WAIT(6, a); tra_emit(a, qa, t0, ldsw, ldsr, voffS0, voffS1); }
    if (left > 1) { TRA_WAIT(6, b); tra_emit(b, qb, t1, ldsw, ldsr, voffS0, voffS1); }
    if (left > 2) { TRA_WAIT(6, c); tra_emit(c, qc, t0, ldsw, ldsr, voffS0, voffS1); }
#undef TRA_STEP
    __syncthreads();
}
constexpr int CVQ_W2T = 1536;
constexpr int CV0 = 1088;
constexpr int CVQ_P0 = 0, CVQ_P2 = 7168, CVQ_P2T = 3456, CVQ_P3 = 512, CVQ_P4 = 3584, CVQ_P5 = 512, CVQ_P6 = 1152;
static_assert(CVQ_P0 + CVQ_P2 + CVQ_P2T + CVQ_P3 + CVQ_P4 + CVQ_P5 + CVQ_P6 == 16384, "w1 conversion quotas");
constexpr int CV_P2 = CV0 + CVQ_P0, CV_P2T = CV_P2 + CVQ_P2, CV_P3 = CV_P2T + CVQ_P2T, CV_P4 = CV_P3 + CVQ_P3, CV_P5 = CV_P4 + CVQ_P4, CV_P6 = CV_P5 + CVQ_P5, CV_W2 = CV_P6 + CVQ_P6, CV_END = CV_W2 + 8192;
__device__ __forceinline__ void p0_router_w(Frame& F) {
    bf16_t* hi = (bf16_t*)(F.ws + WS_WRT); bf16_t* lo = hi + 32 * 2048;
    for (int i = F.bid * NTHR + F.tid; i < 2048 * 32; i += F.G * NTHR) { const int k = i >> 5, e = i & 31; const float w = F.w_router[i];
        const unsigned short h = f2bf(w); hi[e * 2048 + k] = h; lo[e * 2048 + k] = f2bf(w - bf2f(h)); }
}

__device__ __forceinline__ void p1_ln_mod(Frame& F) {
    const float* modp = (const float*)(F.ws + WS_MODP); float* mod = (float*)(F.ws + WS_MOD);
    for (int i = F.bid * NTHR + F.tid; i < 4 * 12288; i += F.G * NTHR) { float s = F.b_ada[i % 12288];
#pragma unroll
        for (int ks = 0; ks < 8; ++ks) s += modp[(size_t)ks * 49152 + i];
        mod[i] = s; }
    LAS float* sh = (LAS float*)F.lds; LAS float* sc = sh + 2048;
    bf16_t* H = (bf16_t*)(F.ws + WS_H);
    for (int rt = F.bid; rt < 256; rt += F.G) {
        const int b = rt >> 6;
        __syncthreads();
        for (int cidx = F.tid; cidx < 4096; cidx += NTHR) { const int col = b * 12288 + cidx; float s = F.b_ada[cidx];
#pragma unroll
            for (int ks = 0; ks < 8; ++ks) s += modp[(size_t)ks * 49152 + col];
            if (cidx < 2048) sh[cidx] = s; else sc[cidx - 2048] = 1.f + s; }
        __syncthreads();
        for (int r = 0; r < 4; ++r) { const int row = rt * 32 + F.wave * 4 + r;
            const f32x4* xr = (const f32x4*)(F.x + (size_t)row * DM) + F.lane;
            f32x4 v[8]; float s = 0.f;
#pragma unroll
            for (int j = 0; j < 8; ++j) { v[j] = __builtin_nontemporal_load(xr + 64 * j); s += (v[j][0] + v[j][1]) + (v[j][2] + v[j][3]); }
            const float mean = wave_sum(s) * (1.f / DM); float s2 = 0.f;
#pragma unroll
            for (int j = 0; j < 8; ++j) { v[j] = v[j] - mean; s2 += (v[j][0] * v[j][0] + v[j][1] * v[j][1]) + (v[j][2] * v[j][2] + v[j][3] * v[j][3]); }
            const float rstd = __builtin_amdgcn_rsqf(wave_sum(s2) * (1.f / DM) + EPS);
            u32x2* o8 = (u32x2*)(H + (size_t)row * DM) + F.lane;
#pragma unroll
            for (int j = 0; j < 8; ++j) { const f32x4 a = *(LAS f32x4*)(sc + 4 * F.lane + 256 * j), bsh = *(LAS f32x4*)(sh + 4 * F.lane + 256 * j);
                const f32x4 h = v[j] * rstd * a + bsh; u32x2 w; w.x = cvt_pk_bf16(h[0], h[1]); w.y = cvt_pk_bf16(h[2], h[3]); o8[64 * j] = w; }
        }
    }
    __syncthreads();
}

__device__ __forceinline__ void p3_kprep(Frame& F) {
    const bf16_t* PROJ = (const bf16_t*)(F.ws + WS_PROJ); bf16_t* KV = (bf16_t*)(F.ws + WS_KV);
    const int l = F.lane & 31, kvh = F.lane >> 5;
    const float kw0 = F.k_norm_w[l], kw1 = F.k_norm_w[l + 32], kw2 = F.k_norm_w[64 + l], kw3 = F.k_norm_w[96 + l];
    const float invf = __builtin_amdgcn_exp2f(-(float)l * 0.41524101186092029f);
    for (int m0 = (F.bid * NWAVES + F.wave) * 4; m0 < MTOK; m0 += F.G * NWAVES * 4) {
        unsigned short kx[4][4], vx[4][4];
#pragma unroll
        for (int q = 0; q < 4; ++q) { const bf16_t* src = PROJ + (size_t)(m0 + q) * PW + C_K + kvh * 128; const bf16_t* sv = PROJ + (size_t)(m0 + q) * PW + C_V + kvh * 128;
#pragma unroll
            for (int i = 0; i < 4; ++i) { kx[q][i] = src[l + 32 * i]; vx[q][i] = sv[l + 32 * i]; } }
#pragma unroll
        for (int q = 0; q < 4; ++q) { const int m = m0 + q;
            float x0 = bf2f(kx[q][0]), x1 = bf2f(kx[q][1]), x2 = bf2f(kx[q][2]), x3 = bf2f(kx[q][3]);
            float ss = x0 * x0 + x1 * x1 + x2 * x2 + x3 * x3;
#pragma unroll
            for (int o = 1; o < 32; o <<= 1) ss += __shfl_xor(ss, o);
            const float rn = __builtin_amdgcn_rsqf(ss * (1.f / 128.f) + EPS);
            x0 *= rn * kw0; x1 *= rn * kw1; x2 *= rn * kw2; x3 *= rn * kw3;
            const int t = m & 2047; const float prow = (float)(t / 64 - 16), pcol = (float)(t % 64 - 32);
            float rv = prow * invf * 0.15915494309189535f; rv -= rintf(rv);
            float sn = __builtin_amdgcn_sinf(rv), c = __builtin_amdgcn_cosf(rv);
            const float y0 = x0 * c - x1 * sn, y1 = x1 * c + x0 * sn;
            rv = pcol * invf * 0.15915494309189535f; rv -= rintf(rv);
            sn = __builtin_amdgcn_sinf(rv); c = __builtin_amdgcn_cosf(rv);
            const float y2 = x2 * c - x3 * sn, y3 = x3 * c + x2 * sn;
            bf16_t* dk = KV + (size_t)m * 512 + kvh * 128;
            dk[l] = f2bf(y0); dk[l + 32] = f2bf(y1); dk[64 + l] = f2bf(y2); dk[96 + l] = f2bf(y3);
            bf16_t* dv = KV + (size_t)m * 512 + 256 + kvh * 128;
            dv[l] = vx[q][0]; dv[l + 32] = vx[q][1]; dv[l + 64] = vx[q][2]; dv[l + 96] = vx[q][3]; }
    }
}

template <int DIR>
__device__ __forceinline__ void gate_scan(const LAS unsigned char* zraw  , float lb, LAS float* segbuf, int d, int seg, float (&bb)[16], float (&kk)[16], float& total) {
    float lf[16];
#pragma unroll
    for (int ii = 0; ii < 16; ++ii) { const float z = bf2f(*(const LAS unsigned short*)(zraw + (16 * seg + ii) * 272 + d * 2)); const float fg = lb + (1.f - lb) * fast_sigmoid(z); lf[ii] = flog(fg); kk[ii] = 1.f - fg; }
    float run = 0.f;
    if (DIR == 0) {
#pragma unroll
        for (int ii = 0; ii < 16; ++ii) { run += lf[ii]; bb[ii] = run; }
    } else {
#pragma unroll
        for (int ii = 15; ii >= 0; --ii) { run += lf[ii]; bb[ii] = run; }
    }
    segbuf[seg * 128 + d] = run;
    __syncthreads();
    const float s0 = segbuf[d], s1 = segbuf[128 + d], s2 = segbuf[256 + d], s3 = segbuf[384 + d];
    total = (s0 + s1) + (s2 + s3);
    float off;
    if (DIR == 0) off = (seg > 0 ? s0 : 0.f) + (seg > 1 ? s1 : 0.f) + (seg > 2 ? s2 : 0.f);
    else off = (seg < 3 ? s3 : 0.f) + (seg < 2 ? s2 : 0.f) + (seg < 1 ? s1 : 0.f);
#pragma unroll
    for (int ii = 0; ii < 16; ++ii) bb[ii] += off;
    __syncthreads();
}
__device__ __forceinline__ void pack16_store(LAS unsigned char* p, const float (&v)[16]) {
    u32x4 w0, w1;
    w0.x = cvt_pk_bf16(v[0], v[1]); w0.y = cvt_pk_bf16(v[2], v[3]); w0.z = cvt_pk_bf16(v[4], v[5]); w0.w = cvt_pk_bf16(v[6], v[7]);
    w1.x = cvt_pk_bf16(v[8], v[9]); w1.y = cvt_pk_bf16(v[10], v[11]); w1.z = cvt_pk_bf16(v[12], v[13]); w1.w = cvt_pk_bf16(v[14], v[15]);
    *(LAS u32x4*)p = w0; *(LAS u32x4*)(p + 16) = w1;
}
__device__ __forceinline__ float hgrn_lower_bound(const float* hgrn_lb, int dir, int col) { const float a0 = hgrn_lb[dir * 2048 + col], a1 = hgrn_lb[dir * 2048 + 1024 + col]; return 1.f / (1.f + __expf(a1 - a0)); }

#define HG_TILE_LD(r0, r1, base) do { r0 = *(const u32x4*)((base) + (size_t)(F.tid >> 4) * PW + (F.tid & 15) * 8); r1 = *(const u32x4*)((base) + (size_t)((F.tid >> 4) + 32) * PW + (F.tid & 15) * 8); } while (0)
#define HG_TILE_LDNT(r0, r1, base) do { r0 = __builtin_nontemporal_load((const u32x4*)((base) + (size_t)(F.tid >> 4) * PW + (F.tid & 15) * 8)); r1 = __builtin_nontemporal_load((const u32x4*)((base) + (size_t)((F.tid >> 4) + 32) * PW + (F.tid & 15) * 8)); } while (0)
#define HG_TILE_ST(raw, r0, r1) do { *(LAS u32x4*)((raw) + (F.tid >> 4) * 272 + (F.tid & 15) * 16) = r0; *(LAS u32x4*)((raw) + ((F.tid >> 4) + 32) * 272 + (F.tid & 15) * 16) = r1; } while (0)
__device__ __forceinline__ void p3_hgrn_u(Frame& F, int ui0, int ui1) {
    const bf16_t* PROJ = (const bf16_t*)(F.ws + WS_PROJ);
    bf16_t* UT = (bf16_t*)(F.ws + WS_UT); float* DEC = (float*)(F.ws + WS_DECAY);
    LAS unsigned char* KDT = F.lds; LAS unsigned char* VT = F.lds + 18432; LAS float* SEG = (LAS float*)(F.lds + 36864);
    LAS unsigned char* RZ0 = F.lds + 40960; LAS unsigned char* RZ1 = RZ0 + 17408; LAS unsigned char* RV = RZ1 + 17408;
    const int d = F.tid & 127, seg = F.tid >> 7;
    const int we = F.wave >> 1, wd = F.wave & 1, fr = F.lane & 15, fq = F.lane >> 4;
    for (int ui = ui0; ui < ui1; ++ui) { const int u = F.bid + ui * F.G; if (u >= 1024) break;
        const int bh = u >> 5, n = u & 31, b = bh >> 3, h = bh & 7; const size_t m0 = (size_t)b * SEQ + n * 64;
        { u32x4 a0, a1, b0, b1, c0, c1; const bf16_t* base = PROJ + m0 * PW + h * 128;
          HG_TILE_LD(a0, a1, base + C_FF); HG_TILE_LD(b0, b1, base + C_FB); HG_TILE_LD(c0, c1, base + C_IN);
          HG_TILE_ST(RZ0, a0, a1); HG_TILE_ST(RZ1, b0, b1); HG_TILE_ST(RV, c0, c1); }
        __syncthreads();
        { float vv[16];
#pragma unroll
          for (int ii = 0; ii < 16; ++ii) vv[ii] = bf2f(*(const LAS unsigned short*)(RV + (16 * seg + ii) * 272 + d * 2));
          pack16_store(VT + d * 144 + seg * 32, vv); }
#pragma unroll
        for (int dir = 0; dir < 2; ++dir) {
            float bb[16], kk[16], total; const float lb = hgrn_lower_bound(F.hgrn_lb, dir, h * 128 + d);
            if (dir == 0) gate_scan<0>(RZ0, lb, SEG, d, seg, bb, kk, total); else gate_scan<1>(RZ1, lb, SEG, d, seg, bb, kk, total);
            float kd[16];
#pragma unroll
            for (int ii = 0; ii < 16; ++ii) kd[ii] = kk[ii] * fexp(total - bb[ii]);
            pack16_store(KDT + d * 144 + seg * 32, kd);
            const int ud = u * 2 + dir;
            if (seg == 0) DEC[(size_t)ud * 128 + d] = fexp(total);
            __syncthreads();
            f32x4 acc[2][4];
#pragma unroll
            for (int te = 0; te < 2; ++te)
#pragma unroll
                for (int td = 0; td < 4; ++td) acc[te][td] = (f32x4){0.f, 0.f, 0.f, 0.f};
#pragma unroll
            for (int ks = 0; ks < 2; ++ks) {
                bf16x8 bv[2], av[4];
#pragma unroll
                for (int te = 0; te < 2; ++te) bv[te] = *(const LAS bf16x8*)(VT + (32 * we + 16 * te + fr) * 144 + (ks * 4 + fq) * 16);
#pragma unroll
                for (int td = 0; td < 4; ++td) av[td] = *(const LAS bf16x8*)(KDT + (64 * wd + 16 * td + fr) * 144 + (ks * 4 + fq) * 16);
#pragma unroll
                for (int te = 0; te < 2; ++te)
#pragma unroll
                    for (int td = 0; td < 4; ++td) acc[te][td] = __builtin_amdgcn_mfma_f32_16x16x32_bf16(av[td], bv[te], acc[te][td], 0, 0, 0);
            }
            bf16_t* ut = UT + (size_t)ud * 16384;
#pragma unroll
            for (int te = 0; te < 2; ++te)
#pragma unroll
                for (int td = 0; td < 4; ++td) { u32x2 w; w.x = cvt_pk_bf16_safe(acc[te][td][0], acc[te][td][1]); w.y = cvt_pk_bf16_safe(acc[te][td][2], acc[te][td][3]);
                    *(u32x2*)(ut + (size_t)(32 * we + 16 * te + fr) * 128 + 64 * wd + 16 * td + 4 * fq) = w; }
            __syncthreads();
        }
    }
}

__device__ __forceinline__ void p4_scan(Frame& F) {
    const bf16_t* UT = (const bf16_t*)(F.ws + WS_UT); const float* DEC = (const float*)(F.ws + WS_DECAY); bf16_t* SP = (bf16_t*)(F.ws + WS_SPREV);
    LAS float* DL = (LAS float*)F.lds;
    const int el = F.tid >> 5, d4 = F.tid & 31;
    for (int item = F.bid; item < 512; item += F.G) {
        const int sq = item >> 3, e = (item & 7) * 16 + el, bh = sq >> 1, dir = sq & 1;
        u32x2 uw[32];
#pragma unroll
        for (int n = 0; n < 32; ++n) { const size_t ud = (size_t)(bh * 32 + n) * 2 + dir; uw[n] = __builtin_nontemporal_load((const u32x2*)(UT + ud * 16384 + e * 128 + 4 * d4)); }
        __syncthreads();
#pragma unroll
        for (int q = 0; q < 2; ++q) { const int id = F.tid + NTHR * q, n = id >> 5, c4 = id & 31; const size_t ud = (size_t)(bh * 32 + n) * 2 + dir;
            *(LAS f32x4*)(DL + n * 128 + 4 * c4) = *(const f32x4*)(DEC + ud * 128 + 4 * c4); }
        __syncthreads();
        f32x4 st = {0.f, 0.f, 0.f, 0.f};
#pragma unroll
        for (int j = 0; j < 32; ++j) { const int n = dir == 0 ? j : 31 - j; const size_t ud = (size_t)(bh * 32 + n) * 2 + dir;
            u32x2 w; w.x = cvt_pk_bf16_safe(st[0], st[1]); w.y = cvt_pk_bf16_safe(st[2], st[3]);
            *(u32x2*)(SP + ud * 16384 + e * 128 + 4 * d4) = w;
            const u32x2 un = dir == 0 ? uw[j] : uw[31 - j];
            const f32x4 dd = *(const LAS f32x4*)(DL + n * 128 + 4 * d4);
            st = dd * st + (f32x4){bflo(un.x), bfhi(un.x), bflo(un.y), bfhi(un.y)}; }
    }
    __syncthreads();
}

__device__ __forceinline__ void p5_hgrn_out(Frame& F, int ui0, int ui1) {
    const bf16_t* PROJ = (const bf16_t*)(F.ws + WS_PROJ); const bf16_t* SPREV = (const bf16_t*)(F.ws + WS_SPREV); bf16_t* MIXED = (bf16_t*)(F.ws + WS_MIXED);
    LAS unsigned char* QD = F.lds; LAS unsigned char* KD = F.lds + 17408; LAS unsigned char* RZ0 = F.lds + 34816; LAS unsigned char* RZ1 = F.lds + 52224;
    LAS unsigned char* PP = F.lds + 69632; LAS unsigned char* VT = F.lds + 78848; LAS unsigned char* SPL = F.lds + 97280;
    LAS float* SEG = (LAS float*)(F.lds + 132096); LAS float* SSQ = (LAS float*)(F.lds + 134144);
    LAS unsigned char* RQ = QD; LAS unsigned char* RV = KD;
    const int d = F.tid & 127, seg = F.tid >> 7, fr = F.lane & 15, fq = F.lane >> 4;
    const int it = F.wave & 3, eh = F.wave >> 2;
    for (int ui = ui0; ui < ui1; ++ui) { const int u = F.bid + ui * F.G; if (u >= 1024) break;
        const int bh = u >> 5, n = u & 31, b = bh >> 3, h = bh & 7; const size_t m0 = (size_t)b * SEQ + n * 64;
        const int i = 16 * it + fr;
        u32x4 sp1[4]; u32x2 graw[4]; f32x4 nwv[4];
        { u32x4 a0, a1, b0, b1, c0, c1, d0, d1, sp0[4]; const bf16_t* base = PROJ + m0 * PW + h * 128;
          HG_TILE_LDNT(a0, a1, base + C_FF); HG_TILE_LDNT(b0, b1, base + C_FB); HG_TILE_LDNT(c0, c1, base + C_QR); HG_TILE_LDNT(d0, d1, base + C_IN);
          const bf16_t* spa = SPREV + (size_t)(u * 2) * 16384;
#pragma unroll
          for (int q = 0; q < 4; ++q) { const int id = F.tid + NTHR * q; sp0[q] = __builtin_nontemporal_load((const u32x4*)(spa + (id >> 4) * 128 + (id & 15) * 8)); }
#pragma unroll
          for (int q = 0; q < 4; ++q) { const int id = F.tid + NTHR * q; sp1[q] = __builtin_nontemporal_load((const u32x4*)(spa + 16384 + (id >> 4) * 128 + (id & 15) * 8)); }
#pragma unroll
          for (int te = 0; te < 4; ++te) { graw[te] = *(const u32x2*)(PROJ + (m0 + i) * PW + C_GO + h * 128 + 64 * eh + 16 * te + 4 * fq); nwv[te] = *(const f32x4*)(F.hgrn_norm_w + h * 128 + 64 * eh + 16 * te + 4 * fq); }
          HG_TILE_ST(RZ0, a0, a1); HG_TILE_ST(RZ1, b0, b1); HG_TILE_ST(RQ, c0, c1); HG_TILE_ST(RV, d0, d1);
#pragma unroll
          for (int q = 0; q < 4; ++q) { const int id = F.tid + NTHR * q; *(LAS u32x4*)(SPL + (id >> 4) * 272 + (id & 15) * 16) = sp0[q]; } }
        __syncthreads();
        float qs[16];
        { float vv[16];
#pragma unroll
          for (int ii = 0; ii < 16; ++ii) { vv[ii] = bf2f(*(const LAS unsigned short*)(RV + (16 * seg + ii) * 272 + d * 2)); const float q = bf2f(*(const LAS unsigned short*)(RQ + (16 * seg + ii) * 272 + d * 2)); qs[ii] = q * fast_sigmoid(q); }
          pack16_store(VT + d * 144 + seg * 32, vv); }
        f32x4 o[4];
#pragma unroll
        for (int te = 0; te < 4; ++te) o[te] = (f32x4){0.f, 0.f, 0.f, 0.f};
#pragma unroll
        for (int dir = 0; dir < 2; ++dir) {
            float bb[16], kk[16], total; const float lb = hgrn_lower_bound(F.hgrn_lb, dir, h * 128 + d);
            if (dir == 0) gate_scan<0>(RZ0, lb, SEG, d, seg, bb, kk, total); else gate_scan<1>(RZ1, lb, SEG, d, seg, bb, kk, total);
#pragma unroll
            for (int ii = 0; ii < 16; ++ii) { const int ir = 16 * seg + ii;
                *(LAS unsigned short*)(QD + ir * 272 + d * 2) = f2bf(qs[ii] * fexp(bb[ii]));
                *(LAS unsigned short*)(KD + ir * 272 + d * 2) = f2bf(kk[ii] * fexp(-bb[ii])); }
            if (dir == 1) {
#pragma unroll
                for (int q = 0; q < 4; ++q) { const int id = F.tid + NTHR * q; *(LAS u32x4*)(SPL + (id >> 4) * 272 + (id & 15) * 16) = sp1[q]; } }
            __syncthreads();
#pragma unroll
            for (int jj = 0; jj < 2; ++jj) { const int jt = 2 * eh + jj; f32x4 sacc = {0.f, 0.f, 0.f, 0.f};
#pragma unroll
                for (int ks = 0; ks < 4; ++ks) { const bf16x8 a = *(const LAS bf16x8*)(KD + (16 * jt + fr) * 272 + (ks * 4 + fq) * 16), bq = *(const LAS bf16x8*)(QD + (16 * it + fr) * 272 + (ks * 4 + fq) * 16);
                    sacc = __builtin_amdgcn_mfma_f32_16x16x32_bf16(a, bq, sacc, 0, 0, 0); }
                const int j0 = 16 * jt + 4 * fq; float pv[4];
#pragma unroll
                for (int r = 0; r < 4; ++r) { const int j = j0 + r; const bool keep = dir == 0 ? (j <= i) : (j >= i); pv[r] = keep ? sacc[r] : 0.f; }
                u32x2 w; w.x = cvt_pk_bf16(pv[0], pv[1]); w.y = cvt_pk_bf16(pv[2], pv[3]);
                *(LAS u32x2*)(PP + i * 144 + j0 * 2) = w; }
            __syncthreads();
#pragma unroll
            for (int ks = 0; ks < 2; ++ks) { const bf16x8 bp = *(const LAS bf16x8*)(PP + (16 * it + fr) * 144 + (ks * 4 + fq) * 16);
#pragma unroll
                for (int te = 0; te < 4; ++te) { const bf16x8 a = *(const LAS bf16x8*)(VT + (64 * eh + 16 * te + fr) * 144 + (ks * 4 + fq) * 16);
                    o[te] = __builtin_amdgcn_mfma_f32_16x16x32_bf16(a, bp, o[te], 0, 0, 0); } }
#pragma unroll
            for (int ks = 0; ks < 4; ++ks) { const bf16x8 bq = *(const LAS bf16x8*)(QD + (16 * it + fr) * 272 + (ks * 4 + fq) * 16);
#pragma unroll
                for (int te = 0; te < 4; ++te) { const bf16x8 a = *(const LAS bf16x8*)(SPL + (64 * eh + 16 * te + fr) * 272 + (ks * 4 + fq) * 16);
                    o[te] = __builtin_amdgcn_mfma_f32_16x16x32_bf16(a, bq, o[te], 0, 0, 0); } }
            __syncthreads();
        }
        float ss = 0.f;
#pragma unroll
        for (int te = 0; te < 4; ++te) ss += (o[te][0] * o[te][0] + o[te][1] * o[te][1]) + (o[te][2] * o[te][2] + o[te][3] * o[te][3]);
        ss += __shfl_xor(ss, 16); ss += __shfl_xor(ss, 32);
        if (fq == 0) SSQ[eh * 64 + i] = ss;
        __syncthreads();
        const float rs = __builtin_amdgcn_rsqf((SSQ[i] + SSQ[64 + i]) * (1.f / 128.f) + EPS);
#pragma unroll
        for (int te = 0; te < 4; ++te) { const int e = 64 * eh + 16 * te + 4 * fq; const f32x4 nw = nwv[te];
            const float g0 = bflo(graw[te].x), g1 = bfhi(graw[te].x), g2 = bflo(graw[te].y), g3 = bfhi(graw[te].y);
            u32x2 w; w.x = cvt_pk_bf16(o[te][0] * rs * nw[0] * g0 * fast_sigmoid(g0), o[te][1] * rs * nw[1] * g1 * fast_sigmoid(g1));
            w.y = cvt_pk_bf16(o[te][2] * rs * nw[2] * g2 * fast_sigmoid(g2), o[te][3] * rs * nw[3] * g3 * fast_sigmoid(g3));
            *(u32x2*)(MIXED + (m0 + i) * DM + 1024 + h * 128 + e) = w; }
        __syncthreads();
    }
}

__device__ __forceinline__ void p7_post_mixer(Frame& F) {
    const float* mod = (const float*)(F.ws + WS_MOD); const bf16_t* Y1 = (const bf16_t*)(F.ws + WS_Y1); bf16_t* X1 = (bf16_t*)(F.ws + WS_X1); unsigned char* H2 = F.ws + WS_H2;
    const bf16_t* WRH = (const bf16_t*)(F.ws + WS_WRT); const bf16_t* WRL = WRH + 32 * 2048;
    int* SLOT = (int*)(F.ws + WS_ROUTE + RT_SLOT); float* SGATE = (float*)(F.ws + WS_ROUTE + RT_SGATE); unsigned* ECNT = (unsigned*)(F.ws + WS_CTL + CTL_ECNT); unsigned char* XS = F.ws + WS_XS;
    LAS unsigned char* HTH = F.lds; LAS unsigned char* HTL = F.lds + 65792;
    LAS float* RED = (LAS float*)(F.lds + 131584); LAS float* LOG = (LAS float*)(F.lds + 147968); LAS int* LE = (LAS int*)(F.lds + 152064); LAS int* LR = LE + 128; LAS float* LG = (LAS float*)(LR + 128); LAS int* EB = (LAS int*)(LG + 128);
    const int fr = F.lane & 15, fq = F.lane >> 4;
    for (int rt = F.bid; rt < 256; rt += F.G) {
        const int b = rt >> 6; const float* mb = mod + (size_t)b * 12288;
        for (int pass = 0; pass < 2; ++pass) {
            for (int rr = 0; rr < 2; ++rr) { const int lr = 2 * F.wave + rr, row = rt * 32 + pass * 16 + lr;
                const f32x4* xr = (const f32x4*)(F.x + (size_t)row * DM) + F.lane; const u32x2* yr = (const u32x2*)(Y1 + (size_t)row * DM) + F.lane;
                f32x4 v[8]; float s = 0.f;
#pragma unroll
                for (int j = 0; j < 8; ++j) { const f32x4 g1 = *((const f32x4*)(mb + 4096) + F.lane + 64 * j); const u32x2 yw = yr[64 * j]; const f32x4 yv = {bflo(yw.x), bfhi(yw.x), bflo(yw.y), bfhi(yw.y)}; v[j] = __builtin_nontemporal_load(xr + 64 * j) * DN_ALPHA + g1 * yv; s += (v[j][0] + v[j][1]) + (v[j][2] + v[j][3]); }
                float mean = wave_sum(s) * (1.f / DM), s2 = 0.f;
#pragma unroll
                for (int j = 0; j < 8; ++j) { v[j] = v[j] - mean; s2 += (v[j][0] * v[j][0] + v[j][1] * v[j][1]) + (v[j][2] * v[j][2] + v[j][3] * v[j][3]); }
                float rstd = __builtin_amdgcn_rsqf(wave_sum(s2) * (1.f / DM) + EPS);
                s = 0.f;
                f32x4 pg[8], pb[8];
#pragma unroll
                for (int j = 0; j < 8; ++j) { pg[j] = *((const f32x4*)F.ln1_g + F.lane + 64 * j); pb[j] = *((const f32x4*)F.ln1_b + F.lane + 64 * j); }
#pragma unroll
                for (int j = 0; j < 8; ++j) { const f32x4 g = pg[j], bb = pb[j];
                    v[j] = v[j] * rstd * g + bb; { u32x2 xw; xw.x = cvt_pk_bf16(v[j][0], v[j][1]); xw.y = cvt_pk_bf16(v[j][2], v[j][3]); __builtin_nontemporal_store(xw, (u32x2*)(X1 + (size_t)row * DM) + F.lane + 64 * j); } s += (v[j][0] + v[j][1]) + (v[j][2] + v[j][3]); }
                mean = wave_sum(s) * (1.f / DM); s2 = 0.f;
#pragma unroll
                for (int j = 0; j < 8; ++j) { v[j] = v[j] - mean; s2 += (v[j][0] * v[j][0] + v[j][1] * v[j][1]) + (v[j][2] * v[j][2] + v[j][3] * v[j][3]); }
                rstd = __builtin_amdgcn_rsqf(wave_sum(s2) * (1.f / DM) + EPS);
#pragma unroll
                for (int j = 0; j < 8; ++j) { pg[j] = *((const f32x4*)(mb + 6144) + F.lane + 64 * j); pb[j] = *((const f32x4*)(mb + 8192) + F.lane + 64 * j); }
#pragma unroll
                for (int j = 0; j < 8; ++j) { const f32x4 sh = pg[j], sc = pb[j];
                    const f32x4 h = v[j] * rstd * (sc + 1.f) + sh;
                    u32x2 wh; wh.x = cvt_pk_bf16(h[0], h[1]); wh.y = cvt_pk_bf16(h[2], h[3]);
                    u32x2 wl; wl.x = cvt_pk_bf16(h[0] - bflo(wh.x), h[1] - bfhi(wh.x)); wl.y = cvt_pk_bf16(h[2] - bflo(wh.y), h[3] - bfhi(wh.y));
                    *((unsigned*)(H2 + (size_t)row * DM) + F.lane + 64 * j) = pk4_fp8(h[0], h[1], h[2], h[3]);
                    *(LAS u32x2*)(HTH + lr * 4112 + (4 * F.lane + 256 * j) * 2) = wh; *(LAS u32x2*)(HTL + lr * 4112 + (4 * F.lane + 256 * j) * 2) = wl; }
            }
            __syncthreads();
            { f32x4 acc[2] = {{0.f, 0.f, 0.f, 0.f}, {0.f, 0.f, 0.f, 0.f}};
#pragma unroll 2
              for (int ks = 0; ks < 8; ++ks) { const int k0 = 256 * F.wave + 32 * ks + 8 * fq;
                  const bf16x8 ah = *(const LAS bf16x8*)(HTH + fr * 4112 + k0 * 2), al = *(const LAS bf16x8*)(HTL + fr * 4112 + k0 * 2);
#pragma unroll
                  for (int et = 0; et < 2; ++et) { const bf16x8 bh = *(const bf16x8*)(WRH + (size_t)(et * 16 + fr) * 2048 + k0), bl = *(const bf16x8*)(WRL + (size_t)(et * 16 + fr) * 2048 + k0);
                      acc[et] = __builtin_amdgcn_mfma_f32_16x16x32_bf16(ah, bh, acc[et], 0, 0, 0);
                      acc[et] = __builtin_amdgcn_mfma_f32_16x16x32_bf16(al, bh, acc[et], 0, 0, 0);
                      acc[et] = __builtin_amdgcn_mfma_f32_16x16x32_bf16(ah, bl, acc[et], 0, 0, 0); } }
#pragma unroll
              for (int et = 0; et < 2; ++et)
#pragma unroll
                  for (int j = 0; j < 4; ++j) RED[(F.wave * 16 + 4 * fq + j) * 32 + et * 16 + fr] = acc[et][j]; }
            __syncthreads();
            { const int tok = F.tid >> 5, e = F.tid & 31; float s = F.b_router[e];
#pragma unroll
              for (int w = 0; w < 8; ++w) s += RED[(w * 16 + tok) * 32 + e];
              LOG[(pass * 16 + tok) * 32 + e] = s; }
            __syncthreads();
        }
        if (F.tid < 32) { const int t = rt * 32 + F.tid; unsigned taken = 0u; float tv[4]; int tix[4];
#pragma unroll
            for (int k = 0; k < 4; ++k) { float best = -3.0e38f; int bi = 0;
                for (int e = 0; e < 32; ++e) { const float v = LOG[F.tid * 32 + e]; if (!((taken >> e) & 1u) && v > best) { best = v; bi = e; } }
                taken |= 1u << bi; tv[k] = best; tix[k] = bi; }
            float ex[4], sum = 0.f;
#pragma unroll
            for (int k = 0; k < 4; ++k) { ex[k] = __expf(tv[k] - tv[0]); sum += ex[k]; }
            const float inv = 1.f / sum;
#pragma unroll
            for (int k = 0; k < 4; ++k) { LG[F.tid * 4 + k] = ex[k] * inv; LE[F.tid * 4 + k] = tix[k]; } }
        __syncthreads();
        if (F.tid < 32) { int cnt = 0; for (int a = 0; a < 128; ++a) if (LE[a] == F.tid) { LR[a] = cnt; ++cnt; }
            EB[F.tid] = cnt > 0 ? (int)__hip_atomic_fetch_add(ECNT + F.tid, (unsigned)cnt, __ATOMIC_RELAXED, __HIP_MEMORY_SCOPE_AGENT) : 0; }
        asm volatile("s_waitcnt vmcnt(0)" ::: "memory");
        __syncthreads();
        if (F.tid < 128) { const int e = LE[F.tid], slot = e * ECAP + EB[e] + LR[F.tid]; SLOT[rt * 128 + F.tid] = slot; SGATE[slot] = LG[F.tid]; LE[F.tid] = slot; }
        __syncthreads();
        { u32x4 rv[4][2];
#pragma unroll
          for (int i = 0; i < 4; ++i) { const u32x4* src = (const u32x4*)(H2 + (size_t)(rt * 32 + F.wave * 4 + i) * DM) + F.lane; rv[i][0] = __builtin_nontemporal_load(src); rv[i][1] = __builtin_nontemporal_load(src + 64); }
#pragma unroll
          for (int i = 0; i < 4; ++i)
#pragma unroll
              for (int k = 0; k < 4; ++k) { u32x4* dst = (u32x4*)(XS + (size_t)LE[(F.wave * 4 + i) * 4 + k] * DM) + F.lane; dst[0] = rv[i][0]; dst[64] = rv[i][1]; } }
        __syncthreads();
    }
}

__device__ __forceinline__ void route_tables(Frame& F) {
    const unsigned* ECNT = (const unsigned*)(F.ws + WS_CTL + CTL_ECNT); LAS int* tab = (LAS int*)(F.lds + LDS_TAB_OFF);
    __syncthreads();
    if (F.tid < 32) tab[F.tid] = (int)ECNT[F.tid];
    __syncthreads();
    if (F.tid == 0) { int t = 0;
        for (int g = 0; g < 8; ++g) {
            for (int j = 0; j < 4; ++j) { const int cnt = tab[4 * g + j], nt = (cnt + 255) >> 8, hf = (nt > 0 && cnt - (nt - 1) * 256 <= 128) ? 1 : 0; tab[64 + 8 * g + j] = t; t += nt - hf; }
            for (int j = 0; j < 4; ++j) { const int cnt = tab[4 * g + j], nt = (cnt + 255) >> 8, hf = (nt > 0 && cnt - (nt - 1) * 256 <= 128) ? 1 : 0; tab[64 + 8 * g + 4 + j] = t; t += hf; } }
        tab[128] = t; }
    __syncthreads();
}
__device__ __forceinline__ void p11_final(Frame& F) {
    const float* mod = (const float*)(F.ws + WS_MOD); const bf16_t* X1 = (const bf16_t*)(F.ws + WS_X1); const unsigned char* YB = F.ws + WS_YB; const int* SLOT = (const int*)(F.ws + WS_ROUTE + RT_SLOT);
    for (int row = F.bid * NWAVES + F.wave; row < MTOK; row += F.G * NWAVES) {
        const int b = row >> 11; const float* g2p = mod + (size_t)b * 12288 + 10240;
        const int s0 = SLOT[row * 4 + 0], s1 = SLOT[row * 4 + 1], s2i = SLOT[row * 4 + 2], s3 = SLOT[row * 4 + 3];
        const unsigned* y0 = (const unsigned*)(YB + (size_t)s0 * DM) + F.lane; const unsigned* y1 = (const unsigned*)(YB + (size_t)s1 * DM) + F.lane;
        const unsigned* y2 = (const unsigned*)(YB + (size_t)s2i * DM) + F.lane; const unsigned* y3 = (const unsigned*)(YB + (size_t)s3 * DM) + F.lane;
        const u32x2* xr = (const u32x2*)(X1 + (size_t)row * DM) + F.lane;
        f32x4 v[8]; float s = 0.f;
#pragma unroll
        for (int j = 0; j < 8; ++j) { const int a = (int)y0[64 * j], bq = (int)y1[64 * j], c = (int)y2[64 * j], dq = (int)y3[64 * j];
            const f32x2 a0 = __builtin_amdgcn_cvt_pk_f32_fp8(a, false), a1 = __builtin_amdgcn_cvt_pk_f32_fp8(a, true), b0 = __builtin_amdgcn_cvt_pk_f32_fp8(bq, false), b1 = __builtin_amdgcn_cvt_pk_f32_fp8(bq, true);
            const f32x2 c0 = __builtin_amdgcn_cvt_pk_f32_fp8(c, false), c1 = __builtin_amdgcn_cvt_pk_f32_fp8(c, true), d0 = __builtin_amdgcn_cvt_pk_f32_fp8(dq, false), d1 = __builtin_amdgcn_cvt_pk_f32_fp8(dq, true);
            f32x4 y; y[0] = ((a0.x + b0.x) + (c0.x + d0.x)) * (1.f / YB_SCALE); y[1] = ((a0.y + b0.y) + (c0.y + d0.y)) * (1.f / YB_SCALE);
            y[2] = ((a1.x + b1.x) + (c1.x + d1.x)) * (1.f / YB_SCALE); y[3] = ((a1.y + b1.y) + (c1.y + d1.y)) * (1.f / YB_SCALE);
            const f32x4 g2 = *((const f32x4*)g2p + F.lane + 64 * j);
            const u32x2 xw = xr[64 * j]; const f32x4 xv = {bflo(xw.x), bfhi(xw.x), bflo(xw.y), bfhi(xw.y)};
            v[j] = xv * DN_ALPHA + g2 * y; s += (v[j][0] + v[j][1]) + (v[j][2] + v[j][3]); }
        const float mean = wave_sum(s) * (1.f / DM); float s2 = 0.f;
#pragma unroll
        for (int j = 0; j < 8; ++j) { v[j] = v[j] - mean; s2 += (v[j][0] * v[j][0] + v[j][1] * v[j][1]) + (v[j][2] * v[j][2] + v[j][3] * v[j][3]); }
        const float rstd = __builtin_amdgcn_rsqf(wave_sum(s2) * (1.f / DM) + EPS);
        f32x4 pg[8], pb[8];
#pragma unroll
        for (int j = 0; j < 8; ++j) { pg[j] = *((const f32x4*)F.ln2_g + F.lane + 64 * j); pb[j] = *((const f32x4*)F.ln2_b + F.lane + 64 * j); }
#pragma unroll
        for (int j = 0; j < 8; ++j) __builtin_nontemporal_store(v[j] * rstd * pg[j] + pb[j], (f32x4*)(F.out + (size_t)row * DM) + F.lane + 64 * j);
    }
}

constexpr int NPHASE = 12;
struct Args { const float* in[21]; float* out; unsigned char* ws; int ph_lo, ph_hi; };
__global__ void __launch_bounds__(NTHR, 2) mega_fwd(Args args) {
    extern __shared__ __attribute__((aligned(16))) unsigned char lds_raw[];
    typedef const __attribute__((address_space(4))) Args* KArgP;
#define MKFRAME() Frame F; { int t_ = threadIdx.x; asm volatile("" : "+v"(t_)); KArgP ap = (KArgP)__builtin_amdgcn_kernarg_segment_ptr(); asm volatile("" : "+s"(ap)); \
    F.lds = (LAS unsigned char*)lds_raw; F.tid = t_; F.lane = t_ & 63; F.wave = __builtin_amdgcn_readfirstlane(t_ >> 6); F.G = gridDim.x; F.bid = blockIdx.x; \
    F.x = ap->in[0]; F.c = ap->in[1]; F.w_ada = ap->in[2]; F.b_ada = ap->in[3]; F.w_in = ap->in[4]; F.q_norm_w = ap->in[5]; F.k_norm_w = ap->in[6]; F.attn_norm_w = ap->in[7]; \
    F.hgrn_lb = ap->in[8]; F.hgrn_norm_w = ap->in[9]; F.w_out = ap->in[10]; F.ln1_g = ap->in[11]; F.ln1_b = ap->in[12]; F.w_router = ap->in[13]; F.b_router = ap->in[14]; \
    F.w1 = ap->in[15]; F.b1 = ap->in[16]; F.w2 = ap->in[17]; F.b2 = ap->in[18]; F.ln2_g = ap->in[19]; F.ln2_b = ap->in[20]; F.out = ap->out; F.ws = ap->ws; }
    for (int u = threadIdx.x; u < (LDS_BYTES - LDS_CTL_OFF) / 4; u += NTHR) ((LAS unsigned*)((LAS unsigned char*)lds_raw + LDS_CTL_OFF))[u] = 0u;
    __syncthreads();
#if MK_SPLIT
#define GRID_BAR() do { } while (0)
#else
    (void)xcd_barrier_post((unsigned*)(args.ws + WS_CTL) + 1024, (volatile LAS unsigned*)((LAS unsigned char*)lds_raw + LDS_CTL_OFF));
#define GRID_BAR() do { KArgP bp_ = (KArgP)__builtin_amdgcn_kernarg_segment_ptr(); asm volatile("" : "+s"(bp_)); XcdBarrier b_; b_.bar = (unsigned*)(bp_->ws + WS_CTL) + 1024; b_.x = xb_xcc_id(); b_.st = (volatile LAS unsigned*)((LAS unsigned char*)lds_raw + LDS_CTL_OFF); xcd_barrier(b_); } while (0)
#endif
#ifndef PH_MASK
#define PH_MASK 0xFFF
#endif
#define IN(k) ((((PH_MASK) >> (k)) & 1) && args.ph_lo <= (k) && (k) < args.ph_hi)
#define SEAM(k) do { if (IN(k) && IN((k) + 1 + ((k) == 7 ? 1 : 0))) GRID_BAR(); } while (0)
#define SG() (((int)blockIdx.x >> 3) & 3)
    if (IN(0)) { MKFRAME(); p0_adaln(F); p0_router_w(F); conv_items<false>(F, 0, 1088); conv_items<true>(F, CV0, CV_P2); } SEAM(0);
    if (IN(1)) { MKFRAME(); p1_ln_mod(F); } SEAM(1);
    if (IN(2)) { MKFRAME(); const int sg = SG(); pg8::PlainSched<4096> S; S.init(F.ws + WS_H, F.ws + WS_WIN_T, MTOK, PW, F.G, F.bid); pg8::EpiBf16Plain E{(bf16_t*)(F.ws + WS_PROJ), PW};
        S.window(0, sg); pg8::gemm_phase<pg8::EpiBf16Plain, pg8::PlainSched<4096>, false>(F.lds, S, E);
        conv_pipe<false>(F, CV_P2, CV_P2T);
        S.window(sg, 1 << 20); pg8::gemm_phase<pg8::EpiBf16Plain, pg8::PlainSched<4096>, false>(F.lds, S, E);
        { const int full = S.nwg / F.G, rem = S.nwg - full * F.G;
          if (rem > 0 && F.bid >= rem) conv_pipe<false>(F, CV_P2T, CV_P3, F.bid - rem, F.G - rem);
          else if (rem == 0) conv_pipe<false>(F, CV_P2T, CV_P3); } } SEAM(2);
    if (IN(3)) { MKFRAME(); const int sg = SG(); p3_kprep(F); p3_hgrn_u(F, 0, sg); conv_items<true>(F, CV_P3, CV_P4); p3_hgrn_u(F, sg, 1 << 20); } SEAM(3);
    if (IN(4)) { { MKFRAME(); if (SG() < 2) { conv_pipe<false>(F, CV_P4, CV_P5); p4_scan(F); } }
        { MKFRAME();
        const bf16_t* PROJ = (const bf16_t*)(F.ws + WS_PROJ); const bf16_t* KV = (const bf16_t*)(F.ws + WS_KV); bf16_t* MIXED = (bf16_t*)(F.ws + WS_MIXED);
        for (int u = F.bid; u < 256; u += F.G) { const int qb = u & 7, h = (u >> 3) & 7, b = u >> 6, kvh = h >> 2; const size_t m0 = (size_t)b * SEQ + qb * 256;
            att::attn_unit(PROJ + m0 * PW + C_Q + h * 128, KV + (size_t)b * SEQ * 512 + kvh * 128, KV + (size_t)b * SEQ * 512 + 256 + kvh * 128,
                           MIXED + m0 * DM + h * 128, F.q_norm_w, F.attn_norm_w + h * 128, qb * 256, SEQ, (char*)lds_raw); } }
        { MKFRAME(); if (SG() >= 2) { conv_pipe<false>(F, CV_P4, CV_P5); p4_scan(F); } }
    } SEAM(4);
    if (IN(5)) { MKFRAME(); const int sg = SG(); p5_hgrn_out(F, 0, sg); conv_items<true>(F, CV_P5, CV_P6); p5_hgrn_out(F, sg, 1 << 20); } SEAM(5);
    if (IN(6)) { MKFRAME(); const int sg = SG(); pg8::PlainSched<4096> S; S.init(F.ws + WS_MIXED, F.ws + WS_WOUT_T, MTOK, DM, F.G, F.bid); pg8::EpiBf16Plain E{(bf16_t*)(F.ws + WS_Y1), DM};
        if (sg < 2) conv_items<true>(F, CV_P6, CV_W2);
        pg8::gemm_phase<pg8::EpiBf16Plain, pg8::PlainSched<4096>, false>(F.lds, S, E);
        if (sg >= 2) conv_items<true>(F, CV_P6, CV_W2); } SEAM(6);
    if (IN(7)) { MKFRAME(); p7_post_mixer(F); } SEAM(7);
    if (IN(9)) { MKFRAME(); const int sg = SG(); route_tables(F); pg8::MoeSched<2048> S; S.init(F.ws + WS_XS, F.ws + WS_W1T, (const LAS int*)(F.lds + LDS_TAB_OFF) + 64, 16, F.G, F.bid);
        pg8::EpiSwiglu E{F.ws + WS_ACT, F.b1};
        const int rem9 = S.nwg % F.G, nshort = (rem9 > 0) ? F.G - rem9 : 0;
        const int w2t = (nshort * 12 < CVQ_W2T) ? nshort * 12 : CVQ_W2T;
        const int sg8 = ((int)blockIdx.x >> 3) & 7;
        S.window(0, sg8); pg8::gemm_phase<pg8::EpiSwiglu, pg8::MoeSched<2048>, true>(F.lds, S, E);
        conv_pipe<true>(F, CV_W2, CV_END - w2t);
        S.window(sg8, 1 << 20); pg8::gemm_phase<pg8::EpiSwiglu, pg8::MoeSched<2048>, true>(F.lds, S, E);
        if (w2t > 0 && F.bid >= rem9) conv_items<true>(F, CV_END - w2t, CV_END, F.bid - rem9, nshort); } SEAM(9);
    if (IN(10)) { MKFRAME(); route_tables(F); pg8::MoeSched<2048> S; S.init(F.ws + WS_ACT, F.ws + WS_W2T, (const LAS int*)(F.lds + LDS_TAB_OFF) + 64, 8, F.G, F.bid);
        pg8::EpiGate E{F.ws + WS_YB, F.b2, (const float*)(F.ws + WS_ROUTE + RT_SGATE)};
        pg8::gemm_phase<pg8::EpiGate, pg8::MoeSched<2048>, true>(F.lds, S, E); } SEAM(10);
    if (IN(11)) { MKFRAME(); p11_final(F); }
#undef IN
#undef SEAM
}

extern "C" void kernel_launch(void* const* d_in, const int* in_sizes, int n_in, void* d_out, int out_size, void* d_ws, size_t ws_size, hipStream_t stream) {
    static int grid = 0;
    if (grid == 0) {
        if (n_in != 21 || out_size != MTOK * DM || ws_size < WS_END) { fprintf(stderr, "kernel_launch: unexpected shapes (n_in %d out %d ws %zu, need ws >= %zu)\n", n_in, out_size, ws_size, (size_t)WS_END); grid = -1; return; }
        int dev = 0, cus = 0, per_cu = 0;
        if (hipGetDevice(&dev) != hipSuccess || hipDeviceGetAttribute(&cus, hipDeviceAttributeMultiprocessorCount, dev) != hipSuccess) { grid = -1; return; }
        if (hipFuncSetAttribute((const void*)mega_fwd, hipFuncAttributeMaxDynamicSharedMemorySize, LDS_BYTES) != hipSuccess) { fprintf(stderr, "kernel_launch: hipFuncSetAttribute failed\n"); grid = -1; return; }
        if (hipOccupancyMaxActiveBlocksPerMultiprocessor(&per_cu, (const void*)mega_fwd, NTHR, LDS_BYTES) != hipSuccess || per_cu < 1) { fprintf(stderr, "kernel_launch: occupancy query says %d\n", per_cu); (void)hipGetLastError(); }
        grid = cus;
    }
    if (grid < 0) return;
    (void)hipMemsetAsync((char*)d_ws + WS_CTL, 0, CTL_ZERO_BYTES, stream);
    Args a{};
    for (int i = 0; i < 21; ++i) a.in[i] = (const float*)d_in[i];
    a.out = (float*)d_out; a.ws = (unsigned char*)d_ws;
#if MK_SPLIT
#ifndef REP_MASK
#define REP_MASK 0
#endif
    for (int p = 0; p < NPHASE; ++p) { a.ph_lo = p; a.ph_hi = p + 1; hipLaunchKernelGGL(mega_fwd, dim3(grid), dim3(NTHR), LDS_BYTES, stream, a);
        if ((REP_MASK >> p) & 1) hipLaunchKernelGGL(mega_fwd, dim3(grid), dim3(NTHR), LDS_BYTES, stream, a); }
#else
    a.ph_lo = 0; a.ph_hi = NPHASE; hipLaunchKernelGGL(mega_fwd, dim3(grid), dim3(NTHR), LDS_BYTES, stream, a);
#endif
    const hipError_t le = hipPeekAtLastError();
    if (le != hipSuccess) fprintf(stderr, "kernel_launch: launch failed: %s\n", hipGetErrorName(le));
}
```

```cpp
#include <hip/hip_runtime.h>
#include <cstdio>
#include <cstdint>

#ifndef MK_SPLIT
#define MK_SPLIT 0
#endif

#define GAS __attribute__((address_space(1)))
#define LAS __attribute__((address_space(3)))
typedef unsigned short bf16_t;
typedef short bf16x8 __attribute__((ext_vector_type(8)));
typedef short s16x4 __attribute__((ext_vector_type(4)));
typedef float f32x2 __attribute__((ext_vector_type(2)));
typedef float f32x4 __attribute__((ext_vector_type(4)));
typedef float f32x16 __attribute__((ext_vector_type(16)));
typedef unsigned u32x2 __attribute__((ext_vector_type(2)));
typedef unsigned u32x4 __attribute__((ext_vector_type(4)));

constexpr int DM = 2048, NBATCH = 4, SEQ = 2048, MTOK = NBATCH * SEQ;
constexpr int PW = 6656;
constexpr int C_Q = 0, C_K = 1024, C_V = 1280, C_QR = 1536, C_FF = 2560, C_FB = 3584, C_IN = 4608, C_GO = 5632;
constexpr int NE = 32, TOPK = 4;
constexpr int ECAP = 8192, ECAP_TILES = ECAP / 256, MAXROWS = NE * ECAP;
constexpr float EPS = 1e-6f;
constexpr float DN_ALPHA = 1.189207115002721f;
constexpr int NWAVES = 8, NTHR = 512;

constexpr size_t MiB = 1u << 20;
constexpr size_t WS_CTL = 0, CTL_ZERO_BYTES = 64 * 1024;
constexpr size_t WS_MODP = 1 * MiB;
constexpr size_t WS_MOD = 3 * MiB;
constexpr size_t WS_ROUTE = 4 * MiB;
constexpr size_t WS_WRT = 6 * MiB;
constexpr size_t WS_WIN_T = 8 * MiB;
constexpr size_t WS_WOUT_T = 34 * MiB;
constexpr size_t WS_W1T = 64 * MiB;
constexpr size_t WS_W2T = 576 * MiB;
constexpr size_t WS_H = 832 * MiB;
constexpr size_t WS_H2 = 864 * MiB;
constexpr size_t WS_PROJ = 928 * MiB;
constexpr size_t WS_KV = 1032 * MiB;
constexpr size_t WS_UT = 1040 * MiB;
constexpr size_t WS_DECAY = 1168 * MiB;
constexpr size_t WS_SPREV = 1170 * MiB;
constexpr size_t WS_MIXED = 1234 * MiB;
constexpr size_t WS_Y1 = 1266 * MiB;
constexpr size_t WS_X1 = 1330 * MiB;
constexpr size_t WS_XS = 1394 * MiB;
constexpr size_t WS_ACT = 1906 * MiB;
constexpr size_t WS_YB = 2418 * MiB;
constexpr size_t WS_END = 3442 * MiB;
constexpr size_t CTL_ECNT = 32768;
constexpr size_t RT_TOKE = 0, RT_TOKG = 128 * 1024, RT_TOKR = 256 * 1024, RT_SLOT = 384 * 1024, RT_HIST = 512 * 1024, RT_SGATE = 576 * 1024;

constexpr int LDS_CTL_OFF = 156672, LDS_TAB_OFF = LDS_CTL_OFF + 256, LDS_BYTES = LDS_CTL_OFF + 2048;

__device__ __forceinline__ unsigned cvt_pk_bf16(float lo, float hi) { unsigned r; asm volatile("v_cvt_pk_bf16_f32 %0, %1, %2" : "=v"(r) : "v"(lo), "v"(hi)); return r; }
typedef __bf16 bf16x2_native __attribute__((ext_vector_type(2)));
__device__ __forceinline__ unsigned cvt_pk_bf16_safe(float lo, float hi) { const f32x2 v = {lo, hi}; const bf16x2_native r = __builtin_convertvector(v, bf16x2_native); return __builtin_bit_cast(unsigned, r); }
__device__ __forceinline__ float bf2f(unsigned short h) { return __uint_as_float((unsigned)h << 16); }
__device__ __forceinline__ float bflo(unsigned w) { return __uint_as_float(w << 16); }
__device__ __forceinline__ float bfhi(unsigned w) { return __uint_as_float(w & 0xffff0000u); }
__device__ __forceinline__ unsigned short f2bf(float f) { return (unsigned short)(cvt_pk_bf16(f, 0.f) & 0xffffu); }
__device__ __forceinline__ unsigned pk4_fp8(float a, float b, float c, float d) { int w = __builtin_amdgcn_cvt_pk_fp8_f32(a, b, 0, false); w = __builtin_amdgcn_cvt_pk_fp8_f32(c, d, w, true); return (unsigned)w; }
constexpr float W_SCALE = 64.f, ACT_SCALE = 4.f, YB_SCALE = 16.f;
__device__ __forceinline__ float wave_sum(float v) {
#pragma unroll
    for (int o = 1; o < 64; o <<= 1) v += __shfl_xor(v, o);
    return v;
}
__device__ __forceinline__ float fast_sigmoid(float x) { return __builtin_amdgcn_rcpf(1.f + __builtin_amdgcn_exp2f(-1.4426950408889634f * x)); }
__device__ __forceinline__ float fexp(float x) { return __builtin_amdgcn_exp2f(1.4426950408889634f * x); }
__device__ __forceinline__ float flog(float x) { return 0.6931471805599453f * __builtin_amdgcn_logf(x); }

#define XB_TMO      128
#define XB_XCNT(j)  (256  + 64 * (j))
#define XB_XSUB(j)  (1280 + 64 * (j))
#define XB_XGEN(j)  (2304 + 64 * (j))
#define XB_TOP      3328
#define XB_TOPGEN   3392
#define XCD_BAR_WORDS 3456
#define XB_SPIN_CAP (1u << 18)
__device__ __forceinline__ unsigned xb_ld(unsigned* p)              { return __hip_atomic_load(p, __ATOMIC_RELAXED, __HIP_MEMORY_SCOPE_AGENT); }
__device__ __forceinline__ unsigned xb_add(unsigned* p, unsigned v) { return __hip_atomic_fetch_add(p, v, __ATOMIC_RELAXED, __HIP_MEMORY_SCOPE_AGENT); }
__device__ __forceinline__ unsigned xb_xcc_id() { return (unsigned)__builtin_amdgcn_s_getreg((3 << 11) | 20) & 0xFu; }
#define XB_SPIN(cond, bar) do { unsigned _sp = 0; while (cond) { __builtin_amdgcn_s_sleep(1); \
    if ((++_sp & 255u) == 0u) { if (xb_ld(&(bar)[XB_TMO])) break; if (_sp > XB_SPIN_CAP) { atomicAdd(&(bar)[XB_TMO], 1u); break; } } } } while (0)
struct XcdBarrier { unsigned* bar; unsigned x; volatile LAS unsigned* st; };
__device__ __forceinline__ XcdBarrier xcd_barrier_post(unsigned* bar, volatile LAS unsigned* st) {
    XcdBarrier b; b.bar = bar; b.x = xb_xcc_id(); b.st = st;
    if (threadIdx.x == 0) (void)xb_add(&bar[XB_XCNT(b.x)], 1u);
    return b;
}
__device__ __forceinline__ void xcd_barrier_complete(unsigned* bar, unsigned x, unsigned& nloc, unsigned& nx) {
    const unsigned G = gridDim.x * gridDim.y * gridDim.z;
    unsigned sum, cnt, mine, sp = 0u;
    for (;;) {
        sum = 0u; cnt = 0u; mine = 0u;
#pragma unroll
        for (unsigned j = 0; j < 16; ++j) { const unsigned c = xb_ld(&bar[XB_XCNT(j)]); sum += c; cnt += (c > 0u) ? 1u : 0u; mine = (j == x) ? c : mine; }
        if (sum == G) break;
        __builtin_amdgcn_s_sleep(1);
        if ((++sp & 255u) == 0u) { if (xb_ld(&bar[XB_TMO])) break; if (sp > XB_SPIN_CAP) { atomicAdd(&bar[XB_TMO], 1u); break; } }
    }
    nloc = mine > 0u ? mine : 1u; nx = cnt > 0u ? cnt : 1u;
}
__device__ __forceinline__ void xcd_barrier(const XcdBarrier& b) {
    asm volatile("s_waitcnt vmcnt(0)" ::: "memory");
    __syncthreads();
    if (threadIdx.x == 0) {
        unsigned* bar = b.bar;
        __builtin_amdgcn_s_waitcnt(0);
        unsigned nloc = b.st[0], nx = b.st[1];
        if (nloc == 0u) { xcd_barrier_complete(bar, b.x, nloc, nx); b.st[0] = nloc; b.st[1] = nx; }
        const unsigned old = xb_add(&bar[XB_XSUB(b.x)], 1u);
        const unsigned gen = old / nloc;
        if (old + 1u == (gen + 1u) * nloc) {
            __builtin_amdgcn_fence(__ATOMIC_RELEASE, "agent");
            asm volatile("s_waitcnt vmcnt(0)" ::: "memory");
            const unsigned og = xb_add(&bar[XB_TOP], 1u);
            const unsigned tg = og / nx;
            if (og + 1u == (tg + 1u) * nx) xb_add(&bar[XB_TOPGEN], 1u);
            else XB_SPIN(xb_ld(&bar[XB_TOPGEN]) == tg, bar);
            __builtin_amdgcn_fence(__ATOMIC_ACQUIRE, "agent");
            xb_add(&bar[XB_XGEN(b.x)], 1u);
            asm volatile("s_waitcnt vmcnt(0)" ::: "memory");
        } else {
            XB_SPIN(xb_ld(&bar[XB_XGEN(b.x)]) == gen, bar);
            __builtin_amdgcn_fence(__ATOMIC_ACQUIRE, "agent");
            asm volatile("s_waitcnt vmcnt(0)" ::: "memory");
        }
    }
    __syncthreads();
}

namespace pg8 {
constexpr int BM = 256, BK = 64, HALF = 128, HTB = HALF * BK * 2, STAGE_BYTES = 8 * HTB, NXCD = 8, WGM = 8;
constexpr int GK = 2048;
__host__ __device__ __forceinline__ int lds_byte(int r, int c) { const int st = (r >> 4) * 2 + (c >> 5), rr = r & 15, cc = c & 31, ob = rr * 64 + cc * 2; return st * 1024 + (ob ^ (((ob >> 9) & 1) << 5)); }
__host__ __device__ __forceinline__ void stage_rc(int b, int& R, int& C) { const int st = b / 1024, sb = b % 1024, swz = sb ^ (((sb >> 9) & 1) << 5); R = (st >> 1) * 16 + swz / 64; C = (st & 1) * 32 + (swz % 64) / 2; }
__host__ __device__ __forceinline__ int perm32(int rho) { const int n = rho >> 4, i = rho & 15; return 8 * (i >> 2) + 4 * n + (i & 3); }

struct Unit { int pm, pn, e, half; };
template <int ROWB> struct TS { static constexpr size_t v = (size_t)BM * ROWB; };

__device__ __forceinline__ int xcd_remap(int wgid, int nwg) { const int q = nwg / NXCD, r = nwg % NXCD, xcd = wgid % NXCD, off = wgid / NXCD; return (xcd < r ? xcd * (q + 1) : r * (q + 1) + (xcd - r) * q) + off; }

template <int ROWB> struct PlainSched {
    const char* A; const char* B; int nM, nN, nwg, G, c, i0 = 0, i1 = 1 << 20;
    __device__ void window(int a, int b) { i0 = a; i1 = b; }
    __device__ void init(const void* A_, const void* B_, int M, int N, int G_, int c_) { A = (const char*)A_; B = (const char*)B_; nM = M / BM; nN = N / BM; nwg = nM * nN; G = G_; c = c_; }
    __device__ __forceinline__ bool next(int i, Unit& u) const {
        if (i + i0 >= i1) return false;
        const long L = (long)(i + i0) * G + c; if (L >= nwg) return false;
        const int wgid = xcd_remap((int)L, nwg);
        const int nig = WGM * nN, gid = wgid / nig, fm = gid * WGM, gsz = (nM - fm) < WGM ? (nM - fm) : WGM;
        u.pm = fm + ((wgid % nig) % gsz); u.pn = (wgid % nig) / gsz; u.e = 0; u.half = 0; return true;
    }
    __device__ __forceinline__ const char* aptr(const Unit& u) const { return A + (size_t)u.pm * TS<ROWB>::v; }
    __device__ __forceinline__ const char* bptr(const Unit& u) const { return B + (size_t)u.pn * TS<ROWB>::v; }
};
template <int ROWB> struct MoeSched {
    const char* A; const char* B; const LAS int* ps; int nN, nwg, G, c, i0 = 0, i1 = 1 << 20;
    __device__ void window(int a, int b) { i0 = a; i1 = b; }
    __device__ void init(const void* A_, const void* B_, const LAS int* ps_, int nN_, int G_, int c_) { A = (const char*)A_; B = (const char*)B_; ps = ps_; nN = nN_; nwg = ps_[64] * nN_; G = G_; c = c_; }
    __device__ __forceinline__ bool next(int i, Unit& u) const {
        if (i + i0 >= i1) return false;
        const long L = (long)(i + i0) * G + c; if (L >= nwg) return false;
        const int wgid = xcd_remap((int)L, nwg);
        int sidx = 0;
#pragma unroll 8
        for (int j = 1; j < 64; ++j) sidx += (wgid >= ps[j] * nN) ? 1 : 0;
        const int e = (sidx >> 3) * 4 + (sidx & 3), kind = (sidx >> 2) & 1, local = wgid - ps[sidx] * nN;
        int pn, r;
        if (kind == 0) { const int nt = ps[sidx + 1] - ps[sidx]; pn = local / nt; r = local % nt; }
        else { pn = local; r = ps[sidx - 3] - ps[sidx - 4]; }
        u.e = __builtin_amdgcn_readfirstlane(e); u.pn = __builtin_amdgcn_readfirstlane(pn); u.pm = __builtin_amdgcn_readfirstlane(e * ECAP_TILES + r); u.half = __builtin_amdgcn_readfirstlane(kind); return true;
    }
    __device__ __forceinline__ const char* aptr(const Unit& u) const { return A + (size_t)u.pm * TS<ROWB>::v; }
    __device__ __forceinline__ const char* bptr(const Unit& u) const { return B + ((size_t)u.e * nN + u.pn) * TS<ROWB>::v; }
};

struct EpiBf16Plain { static constexpr bool PERM = true; bf16_t* O; int ldc;
    __device__ __forceinline__ void operator()(const f32x4 (&acc)[2][2][4][2], const Unit& u, int wr, int wc, int fr, int fq) const {
        const int row0 = u.pm * BM + wr * 64 + fr, col0 = u.pn * BM + wc * 32 + 8 * fq;
#pragma unroll
        for (int ai = 0; ai < 2; ++ai)
#pragma unroll
            for (int m = 0; m < 4; ++m) { bf16_t* rowp = O + (size_t)(row0 + ai * HALF + m * 16) * ldc + col0;
#pragma unroll
                for (int bj = 0; bj < 2; ++bj) { const f32x4 v0 = acc[ai][bj][m][0], v1 = acc[ai][bj][m][1];
                    u32x4 w; w.x = cvt_pk_bf16(v0[0], v0[1]); w.y = cvt_pk_bf16(v0[2], v0[3]); w.z = cvt_pk_bf16(v1[0], v1[1]); w.w = cvt_pk_bf16(v1[2], v1[3]);
                    *(u32x4*)(rowp + bj * HALF) = w; } }
    }
};
struct EpiF32Plain { static constexpr bool PERM = false; float* C; int ldc;
    __device__ __forceinline__ void operator()(const f32x4 (&acc)[2][2][4][2], const Unit& u, int wr, int wc, int fr, int fq) const {
        const int row0 = u.pm * BM + wr * 64 + fr, col0 = u.pn * BM + wc * 32 + 4 * fq;
#pragma unroll
        for (int ai = 0; ai < 2; ++ai)
#pragma unroll
            for (int m = 0; m < 4; ++m) { float* rowp = C + (size_t)(row0 + ai * HALF + m * 16) * ldc + col0;
#pragma unroll
                for (int bj = 0; bj < 2; ++bj)
#pragma unroll
                    for (int n = 0; n < 2; ++n) *(f32x4*)(rowp + bj * HALF + n * 16) = acc[ai][bj][m][n]; }
    }
};
struct EpiSwiglu { static constexpr bool PERM = true; unsigned char* O; const float* b1;
    __device__ __forceinline__ void operator()(const f32x4 (&acc)[2][2][4][2], const Unit& u, int wr, int wc, int fr, int fq) const {
        const int row0 = u.pm * BM + wr * 64 + fr, col0 = u.pn * HALF + wc * 32 + 8 * fq;
        const float* bg = b1 + (size_t)u.e * 4096 + col0;
        f32x4 bg4[2], bl1[2];
#pragma unroll
        for (int n = 0; n < 2; ++n) { bg4[n] = *(const f32x4*)(bg + 4 * n) * ACT_SCALE; bl1[n] = *(const f32x4*)(bg + 2048 + 4 * n) + 1.0f; }
        constexpr float CARG = -1.702f * 1.4426950408889634f / ACT_SCALE;
#pragma unroll
        for (int ai = 0; ai < 2; ++ai) if (!(ai == 1 && u.half))
#pragma unroll
            for (int m = 0; m < 4; ++m) { unsigned char* rowp = O + (size_t)(row0 + ai * HALF + m * 16) * 2048 + col0;
                f32x4 r[2];
#pragma unroll
                for (int n = 0; n < 2; ++n) { f32x4 g4 = acc[ai][0][m][n] * (ACT_SCALE / W_SCALE) + bg4[n], lp = acc[ai][1][m][n] * (1.f / W_SCALE) + bl1[n];
                    g4 = __builtin_elementwise_min(g4, (f32x4){7.0f * ACT_SCALE, 7.0f * ACT_SCALE, 7.0f * ACT_SCALE, 7.0f * ACT_SCALE});
                    lp = __builtin_elementwise_min(__builtin_elementwise_max(lp, (f32x4){-6.0f, -6.0f, -6.0f, -6.0f}), (f32x4){8.0f, 8.0f, 8.0f, 8.0f});
                    const f32x4 ar = g4 * CARG; f32x4 den;
#pragma unroll
                    for (int j = 0; j < 4; ++j) den[j] = __builtin_amdgcn_exp2f(ar[j]);
                    den = den + 1.0f;
#pragma unroll
                    for (int j = 0; j < 4; ++j) den[j] = __builtin_amdgcn_rcpf(den[j]);
                    r[n] = (g4 * lp) * den; }
                u32x2 w; w.x = pk4_fp8(r[0][0], r[0][1], r[0][2], r[0][3]); w.y = pk4_fp8(r[1][0], r[1][1], r[1][2], r[1][3]);
                *(u32x2*)rowp = w; }
    }
};
struct EpiGate { static constexpr bool PERM = true; unsigned char* O; const float* b2; const float* sgate;
    __device__ __forceinline__ void operator()(const f32x4 (&acc)[2][2][4][2], const Unit& u, int wr, int wc, int fr, int fq) const {
        const int row0 = u.pm * BM + wr * 64 + fr, col0 = u.pn * BM + wc * 32 + 8 * fq;
        const float* bb = b2 + (size_t)u.e * 2048 + col0;
        f32x4 bv[2][2];
#pragma unroll
        for (int bj = 0; bj < 2; ++bj)
#pragma unroll
            for (int n = 0; n < 2; ++n) bv[bj][n] = *(const f32x4*)(bb + bj * HALF + 4 * n);
        float gts[2][4];
#pragma unroll
        for (int ai = 0; ai < 2; ++ai)
#pragma unroll
            for (int m = 0; m < 4; ++m) gts[ai][m] = sgate[row0 + ai * HALF + m * 16];
#pragma unroll
        for (int ai = 0; ai < 2; ++ai) if (!(ai == 1 && u.half))
#pragma unroll
            for (int m = 0; m < 4; ++m) { const int row = row0 + ai * HALF + m * 16; const float gt = gts[ai][m] * YB_SCALE; unsigned char* rowp = O + (size_t)row * 2048 + col0;
#pragma unroll
                for (int bj = 0; bj < 2; ++bj) { const f32x4 v0 = (acc[ai][bj][m][0] * (1.f / (W_SCALE * ACT_SCALE)) + bv[bj][0]) * gt, v1 = (acc[ai][bj][m][1] * (1.f / (W_SCALE * ACT_SCALE)) + bv[bj][1]) * gt;
                    u32x2 w; w.x = pk4_fp8(v0[0], v0[1], v0[2], v0[3]); w.y = pk4_fp8(v1[0], v1[1], v1[2], v1[3]);
                    *(u32x2*)(rowp + bj * HALF) = w; } }
    }
};

typedef int i32x4 __attribute__((ext_vector_type(4)));
typedef int i32x8 __attribute__((ext_vector_type(8)));
__device__ __forceinline__ bf16x8 lo8(i32x8 v) { const i32x4 a = __builtin_shufflevector(v, v, 0, 1, 2, 3); return __builtin_bit_cast(bf16x8, a); }
__device__ __forceinline__ bf16x8 hi8(i32x8 v) { const i32x4 a = __builtin_shufflevector(v, v, 4, 5, 6, 7); return __builtin_bit_cast(bf16x8, a); }
__device__ __forceinline__ i32x8 cat8(bf16x8 lo, bf16x8 hi) { const i32x4 a = __builtin_bit_cast(i32x4, lo), b = __builtin_bit_cast(i32x4, hi); return __builtin_shufflevector(a, b, 0, 1, 2, 3, 4, 5, 6, 7); }
template <class Epi, class Sched, bool FP8>
__device__ __forceinline__ void gemm_phase(LAS unsigned char* lds, const Sched& S, const Epi& E) {
    int tid_ = threadIdx.x; asm volatile("" : "+v"(tid_));
    const int tid = tid_, wid = __builtin_amdgcn_readfirstlane(tid >> 6), lane = tid & 63, wr = wid >> 2, wc = wid & 3, fr = lane & 15, fq = lane >> 4;
    constexpr int K = FP8 ? GK / 2 : GK, nt = K / BK;
    unsigned voffA[2], voffB[2];
#pragma unroll
    for (int i = 0; i < 2; ++i) { int R, C; stage_rc(tid * 16 + i * 8192, R, C); const int Rb = Epi::PERM ? ((R & ~31) + perm32(R & 31)) : R;
        voffA[i] = (unsigned)(R * K + C) * 2u; voffB[i] = (unsigned)(Rb * K + C) * 2u; }
    constexpr size_t kstep = (size_t)(BK * 2);
    constexpr size_t hstep = (size_t)HALF * K * 2;
    const unsigned ldsw = (unsigned)wid * 1024u;
    const int aoff = lds_byte(wr * 64 + fr, fq * 8), boff = lds_byte(wc * 32 + fr, fq * 8);
#define PG8_SA(b, h) (((b) * 2 + (h)) * HTB)
#define PG8_SB(b, h) ((4 + (b) * 2 + (h)) * HTB)
#define PG8_STAGE(bufoff, gbase, voff) do { _Pragma("unroll") for (int _i = 0; _i < 2; ++_i) \
        __builtin_amdgcn_global_load_lds((const unsigned*)((const char*)(gbase) + (voff)[_i]), (LAS unsigned*)(lds + (bufoff) + ldsw + _i * 8192), 16, 0, 0); } while (0)
#define PG8_LDA(dst, b, h) do { _Pragma("unroll") for (int m = 0; m < 4; ++m) dst[m] = cat8(*(const LAS bf16x8*)(lds + PG8_SA(b, h) + aoff + m * 2048), *(const LAS bf16x8*)(lds + PG8_SA(b, h) + aoff + m * 2048 + 1024)); } while (0)
#define PG8_LDB(dst, b, h) do { _Pragma("unroll") for (int n = 0; n < 2; ++n) dst[n] = cat8(*(const LAS bf16x8*)(lds + PG8_SB(b, h) + boff + n * 2048), *(const LAS bf16x8*)(lds + PG8_SB(b, h) + boff + n * 2048 + 1024)); } while (0)
#define PG8_MMA(ai, bj, At, Bt) do { __builtin_amdgcn_s_setprio(1); _Pragma("unroll") for (int m = 0; m < 4; ++m) _Pragma("unroll") for (int n = 0; n < 2; ++n) { \
        if constexpr (FP8) asm volatile("v_mfma_scale_f32_16x16x128_f8f6f4 %0, %1, %2, %0, %3, %3 op_sel_hi:[0,0,0]" : "+v"(acc[ai][bj][m][n]) : "v"(Bt[n]), "v"(At[m]), "v"(fp8_one));   \
        else { acc[ai][bj][m][n] = __builtin_amdgcn_mfma_f32_16x16x32_bf16(lo8(Bt[n]), lo8(At[m]), acc[ai][bj][m][n], 0, 0, 0); \
               acc[ai][bj][m][n] = __builtin_amdgcn_mfma_f32_16x16x32_bf16(hi8(Bt[n]), hi8(At[m]), acc[ai][bj][m][n], 0, 0, 0); } } \
        __builtin_amdgcn_s_setprio(0); } while (0)
#define PG8_WAIT_V(n) asm volatile("s_waitcnt vmcnt(" #n ")" ::: "memory")
#define PG8_WAIT_L(n) asm volatile("s_waitcnt lgkmcnt(" #n ")" ::: "memory")
#define PG8_BAR __builtin_amdgcn_s_barrier()
#define PG8_SCHED __builtin_amdgcn_sched_barrier(0)
#define PG8_USE_AT if constexpr (FP8) asm volatile("" :: "v"(At[0]), "v"(At[1]), "v"(At[2]), "v"(At[3]))
    Unit cur, nxt; int ui = 0;
    if (!S.next(0, cur)) return;
    f32x4 acc[2][2][4][2];
#pragma unroll
    for (int a = 0; a < 2; ++a)
#pragma unroll
        for (int b = 0; b < 2; ++b)
#pragma unroll
            for (int m = 0; m < 4; ++m)
#pragma unroll
                for (int n = 0; n < 2; ++n) acc[a][b][m][n] = (f32x4){0.f, 0.f, 0.f, 0.f};
    i32x8 At[4], B0[2], B1[2]; const int fp8_one = 0x7F7F7F7F; (void)fp8_one;
    const char* cA = S.aptr(cur); const char* cB = S.bptr(cur);
    PG8_STAGE(PG8_SB(0, 0), cB, voffB); PG8_STAGE(PG8_SB(0, 1), cB + hstep, voffB); PG8_STAGE(PG8_SA(0, 0), cA, voffA); PG8_STAGE(PG8_SA(0, 1), cA + hstep, voffA);
    if (wr == 1) PG8_BAR;
    PG8_WAIT_V(2); PG8_BAR;
    PG8_STAGE(PG8_SB(1, 0), cB + kstep, voffB); PG8_STAGE(PG8_SA(1, 0), cA + kstep, voffA); PG8_STAGE(PG8_SB(1, 1), cB + hstep + kstep, voffB);
    PG8_WAIT_V(6); PG8_BAR;
    for (;;) {
        const bool has_next = S.next(ui + 1, nxt);
        const char* nA = has_next ? S.aptr(nxt) : cA; const char* nB = has_next ? S.bptr(nxt) : cB;
        for (int t = 0; t < nt; t += 2) {
            const bool last = (t == nt - 2);
            const char* a1 = cA + (size_t)(t + 1) * kstep;
            const char* a2 = last ? nA : cA + (size_t)(t + 2) * kstep; const char* b2 = last ? nB : cB + (size_t)(t + 2) * kstep;
            const char* a3 = a2 + kstep; const char* b3 = b2 + kstep;
            PG8_LDB(B0, 0, 0); PG8_LDB(B1, 0, 1); PG8_SCHED; PG8_LDA(At, 0, 0); PG8_STAGE(PG8_SA(1, 1), a1 + hstep, voffA);
            PG8_WAIT_V(8); PG8_WAIT_L(0); PG8_BAR; PG8_MMA(0, 0, At, B0); PG8_MMA(0, 1, At, B1); PG8_BAR; PG8_SCHED;
            PG8_LDA(At, 0, 1); PG8_STAGE(PG8_SB(0, 0), b2, voffB); PG8_STAGE(PG8_SB(0, 1), b2 + hstep, voffB); PG8_STAGE(PG8_SA(0, 0), a2, voffA);
            PG8_WAIT_V(8); PG8_WAIT_L(0); PG8_BAR; PG8_USE_AT; if (!cur.half) { PG8_MMA(1, 0, At, B0); PG8_MMA(1, 1, At, B1); } PG8_BAR; PG8_SCHED;
            PG8_LDB(B0, 1, 0); PG8_LDB(B1, 1, 1); PG8_SCHED; PG8_LDA(At, 1, 0); PG8_STAGE(PG8_SA(0, 1), a2 + hstep, voffA);
            PG8_WAIT_V(8); PG8_WAIT_L(0); PG8_BAR; PG8_MMA(0, 0, At, B0); PG8_MMA(0, 1, At, B1); PG8_BAR; PG8_SCHED;
            PG8_LDA(At, 1, 1); PG8_STAGE(PG8_SB(1, 0), b3, voffB); PG8_STAGE(PG8_SB(1, 1), b3 + hstep, voffB); PG8_STAGE(PG8_SA(1, 0), a3, voffA);
            PG8_WAIT_V(8); PG8_WAIT_L(0); PG8_BAR; PG8_USE_AT; if (!cur.half) { PG8_MMA(1, 0, At, B0); PG8_MMA(1, 1, At, B1); } PG8_BAR; PG8_SCHED;
        }
        if (wr == 0) PG8_BAR;
        E(acc, cur, wr, wc, fr, fq);
        if (!has_next) break;
#pragma unroll
        for (int a = 0; a < 2; ++a)
#pragma unroll
            for (int b = 0; b < 2; ++b)
#pragma unroll
                for (int m = 0; m < 4; ++m)
#pragma unroll
                    for (int n = 0; n < 2; ++n) acc[a][b][m][n] = (f32x4){0.f, 0.f, 0.f, 0.f};
        cur = nxt; cA = nA; cB = nB; ++ui;
        if (wr == 1) PG8_BAR;
    }
    PG8_WAIT_V(0);
    PG8_BAR;
#undef PG8_SA
#undef PG8_SB
#undef PG8_STAGE
#undef PG8_LDA
#undef PG8_LDB
#undef PG8_MMA
#undef PG8_WAIT_V
#undef PG8_WAIT_L
#undef PG8_BAR
#undef PG8_SCHED
#undef PG8_USE_AT
}
}

namespace att {
constexpr int D = 128, NW = 8, QBLK = 32, KVBLK = 64;
constexpr float SCALE = 0.088388347648318440f;
constexpr float THR = 8.f;
constexpr int LDQ = PW, LDK = 512, LDO = 2048;
constexpr size_t SHM_V = KVBLK * D * 2, SHM_K = KVBLK * D * 2, SHM_ATTN = 2 * SHM_V + 2 * SHM_K + NW * 64 * 4;
#define KSWZ(row, colB) ((row) * 256 + ((colB) ^ (((row) & 7) << 4)))
#define SBAR() __builtin_amdgcn_sched_barrier(0)
__device__ __forceinline__ int crow(int r, int hi) { return (r & 3) + 8 * (r >> 2) + 4 * hi; }
__device__ __forceinline__ void partialSM(f32x16& p0, f32x16& p1, float& m_reg, float& mn, float& alpha) {
  constexpr float C = SCALE * 1.4426950408889634f;
  float pmax = p0[0]; for (int r = 1; r < 16; ++r) pmax = fmaxf(pmax, p0[r]); for (int r = 0; r < 16; ++r) pmax = fmaxf(pmax, p1[r]);
  { auto rr = __builtin_amdgcn_permlane32_swap(__float_as_uint(pmax), __float_as_uint(pmax), false, false);
    pmax = fmaxf(__uint_as_float(rr[0]), __uint_as_float(rr[1])); }
  if (__builtin_expect(__all(pmax - m_reg <= THR / SCALE), 1)) { mn = m_reg; alpha = 1.f; }
  else { mn = fmaxf(m_reg, pmax); alpha = __builtin_amdgcn_exp2f((m_reg - mn) * C); m_reg = mn; }
  float mnC = -mn * C;
  for (int r = 0; r < 16; ++r) p0[r] = fmaf(p0[r], C, mnC); for (int r = 0; r < 16; ++r) p1[r] = fmaf(p1[r], C, mnC);
  for (int r = 0; r < 16; ++r) p0[r] = __builtin_amdgcn_exp2f(p0[r]);
}
__device__ __forceinline__ void finishSM(f32x16& p0, f32x16& p1, float alpha, float& l_reg, bf16x8& pa0, bf16x8& pa1, bf16x8& pa2, bf16x8& pa3) {
  for (int r = 0; r < 16; ++r) p1[r] = __builtin_amdgcn_exp2f(p1[r]);
  float ps = 0; for (int r = 0; r < 16; ++r) ps += p0[r]; for (int r = 0; r < 16; ++r) ps += p1[r];
  { auto rr = __builtin_amdgcn_permlane32_swap(__float_as_uint(ps), __float_as_uint(ps), false, false);
    ps = __uint_as_float(rr[0]) + __uint_as_float(rr[1]); }
  l_reg = l_reg * alpha + ps;
#define PK4(P, BASE, OUT) do { unsigned a0 = cvt_pk_bf16(P[BASE + 0], P[BASE + 1]), a1 = cvt_pk_bf16(P[BASE + 2], P[BASE + 3]);   \
    unsigned b0 = cvt_pk_bf16(P[BASE + 4], P[BASE + 5]), b1 = cvt_pk_bf16(P[BASE + 6], P[BASE + 7]);                              \
    auto r0 = __builtin_amdgcn_permlane32_swap(a0, b0, false, false); auto r1 = __builtin_amdgcn_permlane32_swap(a1, b1, false, false); \
    u32x4 w = {r0[0], r1[0], r0[1], r1[1]}; OUT = *reinterpret_cast<bf16x8*>(&w); } while (0)
  PK4(p0, 0, pa0); PK4(p0, 8, pa1); PK4(p1, 0, pa2); PK4(p1, 8, pa3);
#undef PK4
}
__device__ __forceinline__ void qkt(f32x16& p0, f32x16& p1, const bf16_t* Ks, const bf16x8* qr, int r32, int hi) {
  p0 = f32x16{}; p1 = f32x16{};
  for (int d0 = 0; d0 < 8; ++d0) { int cb = (d0 * 16 + hi * 8) * 2;
    bf16x8 b0 = *reinterpret_cast<const bf16x8*>((const char*)Ks + KSWZ(r32, cb));
    bf16x8 b1 = *reinterpret_cast<const bf16x8*>((const char*)Ks + KSWZ(32 + r32, cb));
    p0 = __builtin_amdgcn_mfma_f32_32x32x16_bf16(b0, qr[d0], p0, 0, 0, 0);
    p1 = __builtin_amdgcn_mfma_f32_32x32x16_bf16(b1, qr[d0], p1, 0, 0, 0); }
}
__device__ __forceinline__ int v_st(int k, int c) { const int kk = (k & ~0xC) | ((k & 4) << 1) | ((k & 8) >> 1); return ((kk >> 3) * 4 + (c >> 5)) * 512 + ((kk & 7) * 32 + (c & 31)) * 2; }
__device__ __forceinline__ int v_rd_base(int lane) { return ((lane & 3) << 3) | (((lane >> 2) & 3) << 6) | (((lane >> 4) & 1) << 5) | (((lane >> 5) & 1) << 8); }
constexpr int v_rd_off(int d0, int ks, int half) { return d0 * 512 + ks * 4096 + half * 2048; }
template <int OFF> __device__ __forceinline__ s16x4 tr_read(int vb) {
  s16x4 r; asm volatile("ds_read_b64_tr_b16 %0, %1 offset:%2" : "=&v"(r) : "v"(vb), "i"(OFF) : "memory"); return r;
}
template <int D0> __device__ __forceinline__ void pv_one(f32x16& od, int vb, bf16x8 pa0, bf16x8 pa1, bf16x8 pa2, bf16x8 pa3) {
  const s16x4 l0 = tr_read<v_rd_off(D0, 0, 0)>(vb), h0 = tr_read<v_rd_off(D0, 0, 1)>(vb), l1 = tr_read<v_rd_off(D0, 1, 0)>(vb), h1 = tr_read<v_rd_off(D0, 1, 1)>(vb);
  const s16x4 l2 = tr_read<v_rd_off(D0, 2, 0)>(vb), h2 = tr_read<v_rd_off(D0, 2, 1)>(vb), l3 = tr_read<v_rd_off(D0, 3, 0)>(vb), h3 = tr_read<v_rd_off(D0, 3, 1)>(vb);
  asm volatile("s_waitcnt lgkmcnt(0)" ::: "memory"); SBAR();
#define PK(L, H) (bf16x8){L[0], L[1], L[2], L[3], H[0], H[1], H[2], H[3]}
  od = __builtin_amdgcn_mfma_f32_32x32x16_bf16(pa0, PK(l0, h0), od, 0, 0, 0);
  od = __builtin_amdgcn_mfma_f32_32x32x16_bf16(pa1, PK(l1, h1), od, 0, 0, 0);
  od = __builtin_amdgcn_mfma_f32_32x32x16_bf16(pa2, PK(l2, h2), od, 0, 0, 0);
  od = __builtin_amdgcn_mfma_f32_32x32x16_bf16(pa3, PK(l3, h3), od, 0, 0, 0);
#undef PK
}
__device__ __forceinline__ void pv_d0(f32x16* o, int vb, bf16x8 pa0, bf16x8 pa1, bf16x8 pa2, bf16x8 pa3) {
  pv_one<0>(o[0], vb, pa0, pa1, pa2, pa3); pv_one<1>(o[1], vb, pa0, pa1, pa2, pa3); pv_one<2>(o[2], vb, pa0, pa1, pa2, pa3); pv_one<3>(o[3], vb, pa0, pa1, pa2, pa3);
}
__device__ __forceinline__ void load_q(bf16x8* qr, const bf16_t* Qw, const float* qnw, int pos, int hi) {
  float qf[64]; float ssq = 0.f;
#pragma unroll
  for (int d0 = 0; d0 < 8; ++d0) { const u32x4 raw = *reinterpret_cast<const u32x4*>(Qw + d0 * 16);
#pragma unroll
    for (int i = 0; i < 4; ++i) { const float a = bflo(raw[i]), b = bfhi(raw[i]); qf[d0 * 8 + 2 * i] = a; qf[d0 * 8 + 2 * i + 1] = b; ssq += a * a + b * b; } }
  ssq += __shfl_xor(ssq, 32);
  const float rn = __builtin_amdgcn_rsqf(ssq * (1.f / 128.f) + EPS);
#pragma unroll
  for (int d0 = 0; d0 < 8; ++d0) { const f32x4 w0 = *reinterpret_cast<const f32x4*>(qnw + d0 * 16 + hi * 8), w1 = *reinterpret_cast<const f32x4*>(qnw + d0 * 16 + hi * 8 + 4);
#pragma unroll
    for (int i = 0; i < 4; ++i) { qf[d0 * 8 + i] *= rn * w0[i]; qf[d0 * 8 + 4 + i] *= rn * w1[i]; } }
  const float prow = (float)(pos / 64 - 16), pcol = (float)(pos % 64 - 32);
#pragma unroll
  for (int d0 = 0; d0 < 2; ++d0)
#pragma unroll
    for (int i = 0; i < 8; ++i) { const int j = d0 * 16 + hi * 8 + i;
      const float invf = __builtin_amdgcn_exp2f(-(float)j * 0.41524101186092029f);
      float rv = prow * invf * 0.15915494309189535f; rv -= rintf(rv);
      float s = __builtin_amdgcn_sinf(rv), c = __builtin_amdgcn_cosf(rv);
      float x1 = qf[d0 * 8 + i], x2 = qf[(d0 + 2) * 8 + i]; qf[d0 * 8 + i] = x1 * c - x2 * s; qf[(d0 + 2) * 8 + i] = x2 * c + x1 * s;
      rv = pcol * invf * 0.15915494309189535f; rv -= rintf(rv);
      s = __builtin_amdgcn_sinf(rv); c = __builtin_amdgcn_cosf(rv);
      x1 = qf[(d0 + 4) * 8 + i]; x2 = qf[(d0 + 6) * 8 + i]; qf[(d0 + 4) * 8 + i] = x1 * c - x2 * s; qf[(d0 + 6) * 8 + i] = x2 * c + x1 * s; }
#pragma unroll
  for (int d0 = 0; d0 < 8; ++d0) { u32x4 w = {cvt_pk_bf16(qf[d0 * 8 + 0], qf[d0 * 8 + 1]), cvt_pk_bf16(qf[d0 * 8 + 2], qf[d0 * 8 + 3]), cvt_pk_bf16(qf[d0 * 8 + 4], qf[d0 * 8 + 5]), cvt_pk_bf16(qf[d0 * 8 + 6], qf[d0 * 8 + 7])};
    qr[d0] = *reinterpret_cast<bf16x8*>(&w); }
}
__device__ __forceinline__ void attn_unit(const bf16_t* __restrict__ Qb, const bf16_t* __restrict__ Kh, const bf16_t* __restrict__ Vh,
                                          bf16_t* __restrict__ Ob, const float* qnw, const float* anw, int pos0, int seq, char* lds) {
  int tid_ = threadIdx.x; asm volatile("" : "+v"(tid_));
  asm volatile("" : "+s"(qnw), "+s"(anw));
  const int tid = tid_, wid = tid >> 6, lane = tid & 63, r32 = lane & 31, hi = lane >> 5;
  bf16_t* V_lds = (bf16_t*)lds; bf16_t* K_lds = (bf16_t*)(lds + 2 * SHM_V);
  float* ws = (float*)(lds + 2 * SHM_V + 2 * SHM_K) + wid * 64; float* li_l = ws; float* al_l = ws + 32;
  float m_reg = -1e30f, l_reg = 0; f32x16 o[4] = {}; bf16x8 qr[8];
  load_q(qr, Qb + (long)(wid * QBLK + r32) * LDQ + hi * 8, qnw, pos0 + wid * QBLK + r32, hi);
  const int sr = tid >> 4, sc = (tid & 15) * 8, vst0 = v_st(sr, sc), vst1 = v_st(32 + sr, sc);
  const int vb0 = (int)(uintptr_t)V_lds + v_rd_base(lane);
  struct { bf16x8 vs0, vs1, ks0, ks1; } sr_[2];
#define LD8(p) (*reinterpret_cast<const bf16x8*>(p))
#define SLOAD(i, k0) do { sr_[i].vs0 = LD8(&Vh[(long)((k0) + sr) * LDK + sc]); sr_[i].vs1 = LD8(&Vh[(long)((k0) + 32 + sr) * LDK + sc]); \
    sr_[i].ks0 = LD8(&Kh[(long)((k0) + sr) * LDK + sc]); sr_[i].ks1 = LD8(&Kh[(long)((k0) + 32 + sr) * LDK + sc]); } while (0)
#define SWRITE(b, i) do { *(bf16x8*)((char*)V_lds + (b) * SHM_V + vst0) = sr_[i].vs0;          \
    *(bf16x8*)((char*)V_lds + (b) * SHM_V + vst1) = sr_[i].vs1; int kc = sc * 2;               \
    *(bf16x8*)((char*)K_lds + (b) * SHM_K + KSWZ(sr, kc)) = sr_[i].ks0;                       \
    *(bf16x8*)((char*)K_lds + (b) * SHM_K + KSWZ(32 + sr, kc)) = sr_[i].ks1; } while (0)
#define SWAIT() asm volatile("s_waitcnt vmcnt(4)" ::: "memory")
#define RESC(a) do { if (__any((a) < 1.f)) { if (hi == 0) al_l[r32] = (a); asm volatile("s_waitcnt lgkmcnt(0)" ::: "memory"); \
    for (int d = 0; d < 4; ++d) for (int r = 0; r < 16; ++r) o[d][r] *= al_l[crow(r, hi)]; } } while (0)
  f32x16 pA0, pA1, pB0, pB1; float mnA, mnB, alA, alB; bf16x8 pa0, pa1, pa2, pa3; const int NT = seq / KVBLK;
  constexpr int SE = 0, SO = 1;
  SLOAD(SE, 0); asm volatile("s_waitcnt vmcnt(0)" ::: "memory"); SWRITE(0, SE); __syncthreads();
  qkt(pA0, pA1, K_lds, qr, r32, hi); partialSM(pA0, pA1, m_reg, mnA, alA);
  SLOAD(SO, KVBLK); if (2 < NT) SLOAD(SE, 2 * KVBLK);
  SWAIT(); SWRITE(1, SO); __syncthreads();
  for (int j = 1; j + 1 < NT; j += 2) {
    SBAR(); qkt(pB0, pB1, (bf16_t*)((char*)K_lds + SHM_K), qr, r32, hi);
    finishSM(pA0, pA1, alA, l_reg, pa0, pa1, pa2, pa3); SBAR();
    SLOAD(SO, (j + 2) * KVBLK); SBAR();
    pv_d0(o, vb0, pa0, pa1, pa2, pa3); partialSM(pB0, pB1, m_reg, mnB, alB);
    __syncthreads(); SWAIT(); SWRITE(0, SE);
    RESC(alB); __syncthreads();
    SBAR(); qkt(pA0, pA1, K_lds, qr, r32, hi);
    finishSM(pB0, pB1, alB, l_reg, pa0, pa1, pa2, pa3); SBAR();
    if (j + 3 < NT) SLOAD(SE, (j + 3) * KVBLK); SBAR();
    pv_d0(o, vb0 + (int)SHM_V, pa0, pa1, pa2, pa3); partialSM(pA0, pA1, m_reg, mnA, alA);
    __syncthreads(); SWAIT(); SWRITE(1, SO);
    RESC(alA); __syncthreads();
  }
  SBAR(); qkt(pB0, pB1, (bf16_t*)((char*)K_lds + SHM_K), qr, r32, hi);
  finishSM(pA0, pA1, alA, l_reg, pa0, pa1, pa2, pa3); SBAR();
  pv_d0(o, vb0, pa0, pa1, pa2, pa3); partialSM(pB0, pB1, m_reg, mnB, alB);
  __syncthreads(); RESC(alB);
  finishSM(pB0, pB1, alB, l_reg, pa0, pa1, pa2, pa3); SBAR();
  pv_d0(o, vb0 + (int)SHM_V, pa0, pa1, pa2, pa3);
  if (hi == 0) li_l[r32] = l_reg; asm volatile("s_waitcnt lgkmcnt(0)" ::: "memory");
  bf16_t* Ow = Ob + (long)(wid * QBLK) * LDO;
  char* ost = lds + 69632 + wid * 8704;
  float aw[4];
#pragma unroll
  for (int d0 = 0; d0 < 4; ++d0) aw[d0] = anw[d0 * 32 + r32];
#pragma unroll
  for (int r = 0; r < 16; ++r) { const int orow = crow(r, hi); const float rli = __builtin_amdgcn_rcpf(li_l[orow]);
    float ss = 0.f;
#pragma unroll
    for (int d0 = 0; d0 < 4; ++d0) { const float v = o[d0][r] * rli; o[d0][r] = v; ss += v * v; }
#pragma unroll
    for (int x = 1; x < 32; x <<= 1) ss += __shfl_xor(ss, x);
    const float rs = __builtin_amdgcn_rsqf(ss * (1.f / 128.f) + EPS);
#pragma unroll
    for (int d0 = 0; d0 < 4; ++d0) *(unsigned short*)(ost + orow * 272 + (d0 * 32 + r32) * 2) = f2bf(o[d0][r] * rs * aw[d0]); }
  asm volatile("s_waitcnt lgkmcnt(0)" ::: "memory");
#pragma unroll
  for (int q = 0; q < 8; ++q) { const int id = q * 64 + lane, row = id >> 4, ch = id & 15;
    const u32x4 w = *(const u32x4*)(ost + row * 272 + ch * 16);
    *(u32x4*)(Ow + (long)row * LDO + ch * 8) = w; }
  __syncthreads();
#undef LD8
#undef SLOAD
#undef SWRITE
#undef SWAIT
#undef RESC
}
}

struct Frame {
    LAS unsigned char* lds; int tid, lane, wave, G, bid;
    const float *x, *c, *w_ada, *b_ada, *w_in, *q_norm_w, *k_norm_w, *attn_norm_w, *hgrn_lb, *hgrn_norm_w, *w_out, *ln1_g, *ln1_b, *w_router, *b_router, *w1, *b1, *w2, *b2, *ln2_g, *ln2_b;
    float* out; unsigned char* ws;
};

__device__ __forceinline__ void p0_adaln(Frame& F) {
    LAS float* sc = (LAS float*)F.lds;
    LAS float* red = sc + 1024;
    float* modp = (float*)(F.ws + WS_MODP);
    for (int it = F.bid; it < 768; it += F.G) {
        const int cc = it % 96, ks = it / 96, c0 = cc * 128, k0 = ks * 256;
        __syncthreads();
        for (int i = F.tid; i < 1024; i += NTHR) { const int b = i >> 8, k = i & 255; const float v = F.c[b * 2048 + k0 + k]; sc[i] = v / (1.f + __expf(-v)); }
        __syncthreads();
        const int col4 = F.tid & 31, kr = F.tid >> 5;
        f32x4 a0 = {0, 0, 0, 0}, a1 = a0, a2 = a0, a3 = a0;
#pragma unroll 8
        for (int i = 0; i < 16; ++i) { const int k = kr + 16 * i; const f32x4 w = __builtin_nontemporal_load((const f32x4*)(F.w_ada + (size_t)(k0 + k) * 12288 + c0 + 4 * col4));
            a0 += w * sc[k]; a1 += w * sc[256 + k]; a2 += w * sc[512 + k]; a3 += w * sc[768 + k]; }
        *(LAS f32x4*)(red + (kr * 4 + 0) * 128 + 4 * col4) = a0; *(LAS f32x4*)(red + (kr * 4 + 1) * 128 + 4 * col4) = a1;
        *(LAS f32x4*)(red + (kr * 4 + 2) * 128 + 4 * col4) = a2; *(LAS f32x4*)(red + (kr * 4 + 3) * 128 + 4 * col4) = a3;
        __syncthreads();
        { const int b = F.tid >> 7, col = F.tid & 127; float s = 0.f;
#pragma unroll
          for (int r = 0; r < 16; ++r) s += red[(r * 4 + b) * 128 + col];
          modp[(size_t)(ks * 4 + b) * 12288 + c0 + col] = s; }
    }
    __syncthreads();
}
struct TrItem { const float* src; bf16_t* dst; int N; };
__device__ __forceinline__ TrItem tr_decode(Frame& F, int it, int& k0, int& n0, int& drow0) {
    TrItem t; int kt, ntile;
    if (it < 832) { t.src = F.w_in; t.N = PW; t.dst = (bf16_t*)(F.ws + WS_WIN_T); ntile = 52; kt = it / ntile; n0 = (it % ntile) * 128; drow0 = n0; }
    else if (it < 1088) { it -= 832; t.src = F.w_out; t.N = 2048; t.dst = (bf16_t*)(F.ws + WS_WOUT_T); ntile = 16; kt = it / ntile; n0 = (it % ntile) * 128; drow0 = n0; }
    else if (it < 1088 + 16384) { it -= 1088; const int e = it >> 9; it &= 511; t.src = F.w1 + (size_t)e * 2048 * 4096; t.N = 4096; t.dst = (bf16_t*)(F.ws + WS_W1T + (size_t)e * 4096 * 2048);
        kt = it >> 5; n0 = (it & 31) * 128; drow0 = n0 < 2048 ? (n0 >> 7) * 256 : ((n0 - 2048) >> 7) * 256 + 128; }
    else { it -= 1088 + 16384; const int e = it >> 8; it &= 255; t.src = F.w2 + (size_t)e * 2048 * 2048; t.N = 2048; t.dst = (bf16_t*)(F.ws + WS_W2T + (size_t)e * 2048 * 2048);
        kt = it >> 4; n0 = (it & 15) * 128; drow0 = n0; }
    k0 = kt * 128; return t;
}
struct TrParm { const float* src; unsigned char* dst; int N, k0, n0, dr0; };
__device__ __forceinline__ TrParm tr_parm(Frame& F, int it) { TrParm q; int k0, n0, dr0; const TrItem t = tr_decode(F, it, k0, n0, dr0); q.src = t.src; q.dst = (unsigned char*)t.dst; q.N = t.N; q.k0 = k0; q.n0 = n0; q.dr0 = dr0; return q; }
template <bool FP8>
__device__ __forceinline__ void tr_emit(Frame& F, const f32x4 (&cur)[8], const TrParm& q, LAS unsigned char* tl, int n4, int kg) {
    if constexpr (FP8) {
#pragma unroll
        for (int i = 0; i < 4; ++i) { u32x2 w; w.x = pk4_fp8(cur[0][i] * W_SCALE, cur[1][i] * W_SCALE, cur[2][i] * W_SCALE, cur[3][i] * W_SCALE); w.y = pk4_fp8(cur[4][i] * W_SCALE, cur[5][i] * W_SCALE, cur[6][i] * W_SCALE, cur[7][i] * W_SCALE);
            const int n = 4 * n4 + i; *(LAS u32x2*)(tl + n * 128 + ((kg ^ (2 * (n4 & 7))) * 8)) = w; }
        __syncthreads();
#pragma unroll
        for (int qq = 0; qq < 2; ++qq) { const int id = F.tid + NTHR * qq, n = id >> 3, pc = id & 7, kgl = (2 * pc) ^ (2 * ((n >> 2) & 7));
            const u32x4 w = *(LAS u32x4*)(tl + n * 128 + pc * 16);
            __builtin_nontemporal_store(w, (u32x4*)(q.dst + (size_t)(q.dr0 + n) * 2048 + q.k0 + 8 * kgl)); }
    } else {
#pragma unroll
        for (int i = 0; i < 4; ++i) { u32x4 w; w.x = cvt_pk_bf16(cur[0][i], cur[1][i]); w.y = cvt_pk_bf16(cur[2][i], cur[3][i]); w.z = cvt_pk_bf16(cur[4][i], cur[5][i]); w.w = cvt_pk_bf16(cur[6][i], cur[7][i]);
            const int n = 4 * n4 + i; *(LAS u32x4*)(tl + n * 256 + ((kg ^ (n4 & 15)) * 16)) = w; }
        __syncthreads();
#pragma unroll
        for (int qq = 0; qq < 4; ++qq) { const int id = F.tid + NTHR * qq, n = id >> 4, pc = id & 15, kgl = pc ^ ((n >> 2) & 15);
            const u32x4 w = *(LAS u32x4*)(tl + n * 256 + pc * 16);
            *(u32x4*)(q.dst + ((size_t)(q.dr0 + n) * 2048 + q.k0 + 8 * kgl) * 2) = w; }
    }
}
#define TR_LOAD(buf, q) do { _Pragma("unroll") for (int j_ = 0; j_ < 8; ++j_) buf[j_] = __builtin_nontemporal_load((const f32x4*)((q).src + (size_t)((q).k0 + 8 * kg + j_) * (q).N + (q).n0 + 4 * n4)); } while (0)
template <bool FP8>
__device__ __forceinline__ void conv_items(Frame& F, int it0, int it1, int idx = -1, int stride = 0) {
    const int n4 = F.tid & 31, kg = F.tid >> 5, G = stride > 0 ? stride : F.G;
    int nx = it0 + (idx >= 0 ? idx : F.bid); if (nx >= it1) return;
    TrParm qa = tr_parm(F, nx), qb = qa, qc = qa, qd = qa; f32x4 a[8], b[8], c[8], d[8];
    bool va = true, vb, vc, vd;
    TR_LOAD(a, qa); nx += G;
    vb = nx < it1; if (vb) { qb = tr_parm(F, nx); TR_LOAD(b, qb); } nx += G;
    vc = nx < it1; if (vc) { qc = tr_parm(F, nx); TR_LOAD(c, qc); } nx += G;
    vd = nx < it1; if (vd) { qd = tr_parm(F, nx); TR_LOAD(d, qd); } nx += G;
    for (;;) {
        tr_emit<FP8>(F, a, qa, F.lds, n4, kg);
        va = nx < it1; if (va) { qa = tr_parm(F, nx); TR_LOAD(a, qa); } nx += G;
        if (!vb) break;
        tr_emit<FP8>(F, b, qb, F.lds + 32768, n4, kg);
        vb = nx < it1; if (vb) { qb = tr_parm(F, nx); TR_LOAD(b, qb); } nx += G;
        if (!vc) break;
        tr_emit<FP8>(F, c, qc, F.lds, n4, kg);
        vc = nx < it1; if (vc) { qc = tr_parm(F, nx); TR_LOAD(c, qc); } nx += G;
        if (!vd) break;
        tr_emit<FP8>(F, d, qd, F.lds + 32768, n4, kg);
        vd = nx < it1; if (vd) { qd = tr_parm(F, nx); TR_LOAD(d, qd); } nx += G;
        if (!va) break;
    }
    __syncthreads();
}
struct TrX { const char* sl; unsigned char* sd; };
template <bool W2>
__device__ __forceinline__ TrX tr_parm_x(Frame& F, int it) {
    TrX q;
    if constexpr (!W2) { it -= 1088; const int e = it >> 9, r = it & 511, nn = r & 31, k0 = (r >> 5) * 128, dr0 = (nn & 15) * 256 + (nn >> 4) * 128;
        q.sl = (const char*)(F.w1 + (size_t)e * 2048 * 4096 + (size_t)k0 * 4096 + nn * 128); q.sd = F.ws + WS_W1T + (size_t)e * 4096 * 2048 + (size_t)dr0 * 2048 + k0; }
    else { it -= 1088 + 16384; const int e = it >> 8, r = it & 255, nn = r & 15, k0 = (r >> 4) * 128;
        q.sl = (const char*)(F.w2 + (size_t)e * 2048 * 2048 + (size_t)k0 * 2048 + nn * 128); q.sd = F.ws + WS_W2T + (size_t)e * 2048 * 2048 + (size_t)nn * 128 * 2048 + k0; }
    return q;
}
__device__ __forceinline__ unsigned pk4_fp8u(f32x2 lo, f32x2 hi) { int w; asm("" : "=v"(w)); w = __builtin_amdgcn_cvt_pk_fp8_f32(lo[0], lo[1], w, false); w = __builtin_amdgcn_cvt_pk_fp8_f32(hi[0], hi[1], w, true); return (unsigned)w; }
template <bool W2>
__device__ __forceinline__ void tra_load(f32x4 (&buf)[8], const TrX& q, unsigned voffL) {
    constexpr size_t RB = (W2 ? 2048 : 4096) * 4;
#pragma unroll
    for (int j = 0; j < 8; ++j) { const char* sb = q.sl + j * RB; asm volatile("global_load_dwordx4 %0, %1, %2 nt" : "=v"(buf[j]) : "v"(voffL), "s"(sb) : "memory"); }
}
#define TRA_WAIT(N, buf) asm volatile("s_waitcnt vmcnt(" #N ")" : "+v"(buf[0]), "+v"(buf[1]), "+v"(buf[2]), "+v"(buf[3]), "+v"(buf[4]), "+v"(buf[5]), "+v"(buf[6]), "+v"(buf[7]) :: "memory")
__device__ __forceinline__ void tra_emit(const f32x4 (&cur)[8], const TrX& q, LAS unsigned char* tl, unsigned ldsw, unsigned ldsr, unsigned voffS0, unsigned voffS1) {
    f32x4 sc[8];
#pragma unroll
    for (int j = 0; j < 8; ++j) sc[j] = cur[j] * W_SCALE;
#pragma unroll
    for (int i = 0; i < 4; ++i) { u32x2 w; w.x = pk4_fp8u((f32x2){sc[0][i], sc[1][i]}, (f32x2){sc[2][i], sc[3][i]}); w.y = pk4_fp8u((f32x2){sc[4][i], sc[5][i]}, (f32x2){sc[6][i], sc[7][i]});
        *(LAS u32x2*)(tl + ldsw + i * 128) = w; }
    __syncthreads();
    const u32x4 w0 = *(LAS u32x4*)(tl + ldsr), w1 = *(LAS u32x4*)(tl + ldsr + 8192);
    asm volatile("global_store_dwordx4 %0, %1, %2 nt" :: "v"(voffS0), "v"(w0), "s"(q.sd) : "memory");
    asm volatile("global_store_dwordx4 %0, %1, %2 nt" :: "v"(voffS1), "v"(w1), "s"(q.sd) : "memory");
}
template <bool W2>
__device__ __forceinline__ void conv_pipe(Frame& F, int it0, int it1, int idx = -1, int stride = 0) {
    const int n4 = F.tid & 31, kg = F.tid >> 5, G = stride > 0 ? stride : F.G;
    const int first = it0 + (idx >= 0 ? idx : F.bid); if (first >= it1) return;
    const int n = (it1 - first + G - 1) / G;
    if (n < 8) { conv_items<true>(F, it0, it1, idx, stride); return; }
    const unsigned voffL = (unsigned)((8 * kg) * (W2 ? 2048 : 4096) + 4 * n4) * 4u;
    const unsigned ldsw = (unsigned)(4 * n4 * 128 + ((kg ^ (2 * (n4 & 7))) * 8)), ldsr = (unsigned)F.tid * 16u;
    unsigned voffS0, voffS1; { const int nr = F.tid >> 3, pc = F.tid & 7; voffS0 = (unsigned)(nr * 2048 + 8 * ((2 * pc) ^ (2 * ((nr >> 2) & 7)))); const int nr1 = nr + 64; voffS1 = (unsigned)(nr1 * 2048 + 8 * ((2 * pc) ^ (2 * ((nr1 >> 2) & 7)))); }
    LAS unsigned char* const t0 = F.lds; LAS unsigned char* const t1 = F.lds + 32768;
    f32x4 a[8], b[8], c[8], d[8];
    TrX qa = tr_parm_x<W2>(F, first), qb = tr_parm_x<W2>(F, first + G), qc = tr_parm_x<W2>(F, first + 2 * G), qd = tr_parm_x<W2>(F, first + 3 * G);
    tra_load<W2>(a, qa, voffL); tra_load<W2>(b, qb, voffL); tra_load<W2>(c, qc, voffL); tra_load<W2>(d, qd, voffL);
    int nx = first + 4 * G, left = n - 8;
#define TRA_STEP(N, buf, q, tl, nxt) do { TRA_WAIT(N, buf); tra_emit(buf, q, tl, ldsw, ldsr, voffS0, voffS1); q = tr_parm_x<W2>(F, nxt); tra_load<W2>(buf, q, voffL); } while (0)
    TRA_STEP(24, a, qa, t0, nx); TRA_STEP(26, b, qb, t1, nx + G); TRA_STEP(28, c, qc, t0, nx + 2 * G); TRA_STEP(30, d, qd, t1, nx + 3 * G);
    nx += 4 * G;
    while (left >= 4) {
        TRA_STEP(30, a, qa, t0, nx); TRA_STEP(30, b, qb, t1, nx + G); TRA_STEP(30, c, qc, t0, nx + 2 * G); TRA_STEP(30, d, qd, t1, nx + 3 * G);
        nx += 4 * G; left -= 4;
    }
    TRA_WAIT(30, a); tra_emit(a, qa, t0, ldsw, ldsr, voffS0, voffS1); if (left > 0) { qa = tr_parm_x<W2>(F, nx);         tra_load<W2>(a, qa, voffL); }
    TRA_WAIT(22, b); tra_emit(b, qb, t1, ldsw, ldsr, voffS0, voffS1); if (left > 1) { qb = tr_parm_x<W2>(F, nx + G);     tra_load<W2>(b, qb, voffL); }
    TRA_WAIT(14, c); tra_emit(c, qc, t0, ldsw, ldsr, voffS0, voffS1); if (left > 2) { qc = tr_parm_x<W2>(F, nx + 2 * G); tra_load<W2>(c, qc, voffL); }
    TRA_WAIT(6, d);  tra_emit(d, qd, t1, ldsw, ldsr, voffS0, voffS1);
    if (left > 0) { TRA_WAIT(6, a); tra_emit(a, qa, t0, ldsw, ldsr, voffS0, voffS1); }
    if (left > 1) { TRA_WAIT(6, b); tra_emit(b, qb, t1, ldsw, ldsr, voffS0, voffS1); }
    if (left > 2) { TRA_WAIT(6, c); tra_emit(c, qc, t0, ldsw, ldsr, voffS0, voffS1); }
#undef TRA_STEP
    __syncthreads();
}
constexpr int CVQ_W2T = 1536;
constexpr int CV0 = 1088;
constexpr int CVQ_P0 = 0, CVQ_P2 = 7168, CVQ_P2T = 3456, CVQ_P3 = 512, CVQ_P4 = 3584, CVQ_P5 = 512, CVQ_P6 = 1152;
static_assert(CVQ_P0 + CVQ_P2 + CVQ_P2T + CVQ_P3 + CVQ_P4 + CVQ_P5 + CVQ_P6 == 16384, "w1 conversion quotas");
constexpr int CV_P2 = CV0 + CVQ_P0, CV_P2T = CV_P2 + CVQ_P2, CV_P3 = CV_P2T + CVQ_P2T, CV_P4 = CV_P3 + CVQ_P3, CV_P5 = CV_P4 + CVQ_P4, CV_P6 = CV_P5 + CVQ_P5, CV_W2 = CV_P6 + CVQ_P6, CV_END = CV_W2 + 8192;
__device__ __forceinline__ void p0_router_w(Frame& F) {
    bf16_t* hi = (bf16_t*)(F.ws + WS_WRT); bf16_t* lo = hi + 32 * 2048;
    for (int i = F.bid * NTHR + F.tid; i < 2048 * 32; i += F.G * NTHR) { const int k = i >> 5, e = i & 31; const float w = F.w_router[i];
        const unsigned short h = f2bf(w); hi[e * 2048 + k] = h; lo[e * 2048 + k] = f2bf(w - bf2f(h)); }
}

__device__ __forceinline__ void p1_ln_mod(Frame& F) {
    const float* modp = (const float*)(F.ws + WS_MODP); float* mod = (float*)(F.ws + WS_MOD);
    for (int i = F.bid * NTHR + F.tid; i < 4 * 12288; i += F.G * NTHR) { float s = F.b_ada[i % 12288];
#pragma unroll
        for (int ks = 0; ks < 8; ++ks) s += modp[(size_t)ks * 49152 + i];
        mod[i] = s; }
    LAS float* sh = (LAS float*)F.lds; LAS float* sc = sh + 2048;
    bf16_t* H = (bf16_t*)(F.ws + WS_H);
    for (int rt = F.bid; rt < 256; rt += F.G) {
        const int b = rt >> 6;
        __syncthreads();
        for (int cidx = F.tid; cidx < 4096; cidx += NTHR) { const int col = b * 12288 + cidx; float s = F.b_ada[cidx];
#pragma unroll
            for (int ks = 0; ks < 8; ++ks) s += modp[(size_t)ks * 49152 + col];
            if (cidx < 2048) sh[cidx] = s; else sc[cidx - 2048] = 1.f + s; }
        __syncthreads();
        for (int r = 0; r < 4; ++r) { const int row = rt * 32 + F.wave * 4 + r;
            const f32x4* xr = (const f32x4*)(F.x + (size_t)row * DM) + F.lane;
            f32x4 v[8]; float s = 0.f;
#pragma unroll
            for (int j = 0; j < 8; ++j) { v[j] = __builtin_nontemporal_load(xr + 64 * j); s += (v[j][0] + v[j][1]) + (v[j][2] + v[j][3]); }
            const float mean = wave_sum(s) * (1.f / DM); float s2 = 0.f;
#pragma unroll
            for (int j = 0; j < 8; ++j) { v[j] = v[j] - mean; s2 += (v[j][0] * v[j][0] + v[j][1] * v[j][1]) + (v[j][2] * v[j][2] + v[j][3] * v[j][3]); }
            const float rstd = __builtin_amdgcn_rsqf(wave_sum(s2) * (1.f / DM) + EPS);
            u32x2* o8 = (u32x2*)(H + (size_t)row * DM) + F.lane;
#pragma unroll
            for (int j = 0; j < 8; ++j) { const f32x4 a = *(LAS f32x4*)(sc + 4 * F.lane + 256 * j), bsh = *(LAS f32x4*)(sh + 4 * F.lane + 256 * j);
                const f32x4 h = v[j] * rstd * a + bsh; u32x2 w; w.x = cvt_pk_bf16(h[0], h[1]); w.y = cvt_pk_bf16(h[2], h[3]); o8[64 * j] = w; }
        }
    }
    __syncthreads();
}

__device__ __forceinline__ void p3_kprep(Frame& F) {
    const bf16_t* PROJ = (const bf16_t*)(F.ws + WS_PROJ); bf16_t* KV = (bf16_t*)(F.ws + WS_KV);
    const int l = F.lane & 31, kvh = F.lane >> 5;
    const float kw0 = F.k_norm_w[l], kw1 = F.k_norm_w[l + 32], kw2 = F.k_norm_w[64 + l], kw3 = F.k_norm_w[96 + l];
    const float invf = __builtin_amdgcn_exp2f(-(float)l * 0.41524101186092029f);
    for (int m0 = (F.bid * NWAVES + F.wave) * 4; m0 < MTOK; m0 += F.G * NWAVES * 4) {
        unsigned short kx[4][4], vx[4][4];
#pragma unroll
        for (int q = 0; q < 4; ++q) { const bf16_t* src = PROJ + (size_t)(m0 + q) * PW + C_K + kvh * 128; const bf16_t* sv = PROJ + (size_t)(m0 + q) * PW + C_V + kvh * 128;
#pragma unroll
            for (int i = 0; i < 4; ++i) { kx[q][i] = src[l + 32 * i]; vx[q][i] = sv[l + 32 * i]; } }
#pragma unroll
        for (int q = 0; q < 4; ++q) { const int m = m0 + q;
            float x0 = bf2f(kx[q][0]), x1 = bf2f(kx[q][1]), x2 = bf2f(kx[q][2]), x3 = bf2f(kx[q][3]);
            float ss = x0 * x0 + x1 * x1 + x2 * x2 + x3 * x3;
#pragma unroll
            for (int o = 1; o < 32; o <<= 1) ss += __shfl_xor(ss, o);
            const float rn = __builtin_amdgcn_rsqf(ss * (1.f / 128.f) + EPS);
            x0 *= rn * kw0; x1 *= rn * kw1; x2 *= rn * kw2; x3 *= rn * kw3;
            const int t = m & 2047; const float prow = (float)(t / 64 - 16), pcol = (float)(t % 64 - 32);
            float rv = prow * invf * 0.15915494309189535f; rv -= rintf(rv);
            float sn = __builtin_amdgcn_sinf(rv), c = __builtin_amdgcn_cosf(rv);
            const float y0 = x0 * c - x1 * sn, y1 = x1 * c + x0 * sn;
            rv = pcol * invf * 0.15915494309189535f; rv -= rintf(rv);
            sn = __builtin_amdgcn_sinf(rv); c = __builtin_amdgcn_cosf(rv);
            const float y2 = x2 * c - x3 * sn, y3 = x3 * c + x2 * sn;
            bf16_t* dk = KV + (size_t)m * 512 + kvh * 128;
            dk[l] = f2bf(y0); dk[l + 32] = f2bf(y1); dk[64 + l] = f2bf(y2); dk[96 + l] = f2bf(y3);
            bf16_t* dv = KV + (size_t)m * 512 + 256 + kvh * 128;
            dv[l] = vx[q][0]; dv[l + 32] = vx[q][1]; dv[l + 64] = vx[q][2]; dv[l + 96] = vx[q][3]; }
    }
}

template <int DIR>
__device__ __forceinline__ void gate_scan(const LAS unsigned char* zraw  , float lb, LAS float* segbuf, int d, int seg, float (&bb)[16], float (&kk)[16], float& total) {
    float lf[16];
#pragma unroll
    for (int ii = 0; ii < 16; ++ii) { const float z = bf2f(*(const LAS unsigned short*)(zraw + (16 * seg + ii) * 272 + d * 2)); const float fg = lb + (1.f - lb) * fast_sigmoid(z); lf[ii] = flog(fg); kk[ii] = 1.f - fg; }
    float run = 0.f;
    if (DIR == 0) {
#pragma unroll
        for (int ii = 0; ii < 16; ++ii) { run += lf[ii]; bb[ii] = run; }
    } else {
#pragma unroll
        for (int ii = 15; ii >= 0; --ii) { run += lf[ii]; bb[ii] = run; }
    }
    segbuf[seg * 128 + d] = run;
    __syncthreads();
    const float s0 = segbuf[d], s1 = segbuf[128 + d], s2 = segbuf[256 + d], s3 = segbuf[384 + d];
    total = (s0 + s1) + (s2 + s3);
    float off;
    if (DIR == 0) off = (seg > 0 ? s0 : 0.f) + (seg > 1 ? s1 : 0.f) + (seg > 2 ? s2 : 0.f);
    else off = (seg < 3 ? s3 : 0.f) + (seg < 2 ? s2 : 0.f) + (seg < 1 ? s1 : 0.f);
#pragma unroll
    for (int ii = 0; ii < 16; ++ii) bb[ii] += off;
    __syncthreads();
}
__device__ __forceinline__ void pack16_store(LAS unsigned char* p, const float (&v)[16]) {
    u32x4 w0, w1;
    w0.x = cvt_pk_bf16(v[0], v[1]); w0.y = cvt_pk_bf16(v[2], v[3]); w0.z = cvt_pk_bf16(v[4], v[5]); w0.w = cvt_pk_bf16(v[6], v[7]);
    w1.x = cvt_pk_bf16(v[8], v[9]); w1.y = cvt_pk_bf16(v[10], v[11]); w1.z = cvt_pk_bf16(v[12], v[13]); w1.w = cvt_pk_bf16(v[14], v[15]);
    *(LAS u32x4*)p = w0; *(LAS u32x4*)(p + 16) = w1;
}
__device__ __forceinline__ float hgrn_lower_bound(const float* hgrn_lb, int dir, int col) { const float a0 = hgrn_lb[dir * 2048 + col], a1 = hgrn_lb[dir * 2048 + 1024 + col]; return 1.f / (1.f + __expf(a1 - a0)); }

#define HG_TILE_LD(r0, r1, base) do { r0 = *(const u32x4*)((base) + (size_t)(F.tid >> 4) * PW + (F.tid & 15) * 8); r1 = *(const u32x4*)((base) + (size_t)((F.tid >> 4) + 32) * PW + (F.tid & 15) * 8); } while (0)
#define HG_TILE_LDNT(r0, r1, base) do { r0 = __builtin_nontemporal_load((const u32x4*)((base) + (size_t)(F.tid >> 4) * PW + (F.tid & 15) * 8)); r1 = __builtin_nontemporal_load((const u32x4*)((base) + (size_t)((F.tid >> 4) + 32) * PW + (F.tid & 15) * 8)); } while (0)
#define HG_TILE_ST(raw, r0, r1) do { *(LAS u32x4*)((raw) + (F.tid >> 4) * 272 + (F.tid & 15) * 16) = r0; *(LAS u32x4*)((raw) + ((F.tid >> 4) + 32) * 272 + (F.tid & 15) * 16) = r1; } while (0)
__device__ __forceinline__ void p3_hgrn_u(Frame& F, int ui0, int ui1) {
    const bf16_t* PROJ = (const bf16_t*)(F.ws + WS_PROJ);
    bf16_t* UT = (bf16_t*)(F.ws + WS_UT); float* DEC = (float*)(F.ws + WS_DECAY);
    LAS unsigned char* KDT = F.lds; LAS unsigned char* VT = F.lds + 18432; LAS float* SEG = (LAS float*)(F.lds + 36864);
    LAS unsigned char* RZ0 = F.lds + 40960; LAS unsigned char* RZ1 = RZ0 + 17408; LAS unsigned char* RV = RZ1 + 17408;
    const int d = F.tid & 127, seg = F.tid >> 7;
    const int we = F.wave >> 1, wd = F.wave & 1, fr = F.lane & 15, fq = F.lane >> 4;
    for (int ui = ui0; ui < ui1; ++ui) { const int u = F.bid + ui * F.G; if (u >= 1024) break;
        const int bh = u >> 5, n = u & 31, b = bh >> 3, h = bh & 7; const size_t m0 = (size_t)b * SEQ + n * 64;
        { u32x4 a0, a1, b0, b1, c0, c1; const bf16_t* base = PROJ + m0 * PW + h * 128;
          HG_TILE_LD(a0, a1, base + C_FF); HG_TILE_LD(b0, b1, base + C_FB); HG_TILE_LD(c0, c1, base + C_IN);
          HG_TILE_ST(RZ0, a0, a1); HG_TILE_ST(RZ1, b0, b1); HG_TILE_ST(RV, c0, c1); }
        __syncthreads();
        { float vv[16];
#pragma unroll
          for (int ii = 0; ii < 16; ++ii) vv[ii] = bf2f(*(const LAS unsigned short*)(RV + (16 * seg + ii) * 272 + d * 2));
          pack16_store(VT + d * 144 + seg * 32, vv); }
#pragma unroll
        for (int dir = 0; dir < 2; ++dir) {
            float bb[16], kk[16], total; const float lb = hgrn_lower_bound(F.hgrn_lb, dir, h * 128 + d);
            if (dir == 0) gate_scan<0>(RZ0, lb, SEG, d, seg, bb, kk, total); else gate_scan<1>(RZ1, lb, SEG, d, seg, bb, kk, total);
            float kd[16];
#pragma unroll
            for (int ii = 0; ii < 16; ++ii) kd[ii] = kk[ii] * fexp(total - bb[ii]);
            pack16_store(KDT + d * 144 + seg * 32, kd);
            const int ud = u * 2 + dir;
            if (seg == 0) DEC[(size_t)ud * 128 + d] = fexp(total);
            __syncthreads();
            f32x4 acc[2][4];
#pragma unroll
            for (int te = 0; te < 2; ++te)
#pragma unroll
                for (int td = 0; td < 4; ++td) acc[te][td] = (f32x4){0.f, 0.f, 0.f, 0.f};
#pragma unroll
            for (int ks = 0; ks < 2; ++ks) {
                bf16x8 bv[2], av[4];
#pragma unroll
                for (int te = 0; te < 2; ++te) bv[te] = *(const LAS bf16x8*)(VT + (32 * we + 16 * te + fr) * 144 + (ks * 4 + fq) * 16);
#pragma unroll
                for (int td = 0; td < 4; ++td) av[td] = *(const LAS bf16x8*)(KDT + (64 * wd + 16 * td + fr) * 144 + (ks * 4 + fq) * 16);
#pragma unroll
                for (int te = 0; te < 2; ++te)
#pragma unroll
                    for (int td = 0; td < 4; ++td) acc[te][td] = __builtin_amdgcn_mfma_f32_16x16x32_bf16(av[td], bv[te], acc[te][td], 0, 0, 0);
            }
            bf16_t* ut = UT + (size_t)ud * 16384;
#pragma unroll
            for (int te = 0; te < 2; ++te)
#pragma unroll
                for (int td = 0; td < 4; ++td) { u32x2 w; w.x = cvt_pk_bf16_safe(acc[te][td][0], acc[te][td][1]); w.y = cvt_pk_bf16_safe(acc[te][td][2], acc[te][td][3]);
                    *(u32x2*)(ut + (size_t)(32 * we + 16 * te + fr) * 128 + 64 * wd + 16 * td + 4 * fq) = w; }
            __syncthreads();
        }
    }
}

__device__ __forceinline__ void p4_scan(Frame& F) {
    const bf16_t* UT = (const bf16_t*)(F.ws + WS_UT); const float* DEC = (const float*)(F.ws + WS_DECAY); bf16_t* SP = (bf16_t*)(F.ws + WS_SPREV);
    LAS float* DL = (LAS float*)F.lds;
    const int el = F.tid >> 5, d4 = F.tid & 31;
    for (int item = F.bid; item < 512; item += F.G) {
        const int sq = item >> 3, e = (item & 7) * 16 + el, bh = sq >> 1, dir = sq & 1;
        u32x2 uw[32];
#pragma unroll
        for (int n = 0; n < 32; ++n) { const size_t ud = (size_t)(bh * 32 + n) * 2 + dir; uw[n] = __builtin_nontemporal_load((const u32x2*)(UT + ud * 16384 + e * 128 + 4 * d4)); }
        __syncthreads();
#pragma unroll
        for (int q = 0; q < 2; ++q) { const int id = F.tid + NTHR * q, n = id >> 5, c4 = id & 31; const size_t ud = (size_t)(bh * 32 + n) * 2 + dir;
            *(LAS f32x4*)(DL + n * 128 + 4 * c4) = *(const f32x4*)(DEC + ud * 128 + 4 * c4); }
        __syncthreads();
        f32x4 st = {0.f, 0.f, 0.f, 0.f};
#pragma unroll
        for (int j = 0; j < 32; ++j) { const int n = dir == 0 ? j : 31 - j; const size_t ud = (size_t)(bh * 32 + n) * 2 + dir;
            u32x2 w; w.x = cvt_pk_bf16_safe(st[0], st[1]); w.y = cvt_pk_bf16_safe(st[2], st[3]);
            *(u32x2*)(SP + ud * 16384 + e * 128 + 4 * d4) = w;
            const u32x2 un = dir == 0 ? uw[j] : uw[31 - j];
            const f32x4 dd = *(const LAS f32x4*)(DL + n * 128 + 4 * d4);
            st = dd * st + (f32x4){bflo(un.x), bfhi(un.x), bflo(un.y), bfhi(un.y)}; }
    }
    __syncthreads();
}

__device__ __forceinline__ void p5_hgrn_out(Frame& F, int ui0, int ui1) {
    const bf16_t* PROJ = (const bf16_t*)(F.ws + WS_PROJ); const bf16_t* SPREV = (const bf16_t*)(F.ws + WS_SPREV); bf16_t* MIXED = (bf16_t*)(F.ws + WS_MIXED);
    LAS unsigned char* QD = F.lds; LAS unsigned char* KD = F.lds + 17408; LAS unsigned char* RZ0 = F.lds + 34816; LAS unsigned char* RZ1 = F.lds + 52224;
    LAS unsigned char* PP = F.lds + 69632; LAS unsigned char* VT = F.lds + 78848; LAS unsigned char* SPL = F.lds + 97280;
    LAS float* SEG = (LAS float*)(F.lds + 132096); LAS float* SSQ = (LAS float*)(F.lds + 134144);
    LAS unsigned char* RQ = QD; LAS unsigned char* RV = KD;
    const int d = F.tid & 127, seg = F.tid >> 7, fr = F.lane & 15, fq = F.lane >> 4;
    const int it = F.wave & 3, eh = F.wave >> 2;
    for (int ui = ui0; ui < ui1; ++ui) { const int u = F.bid + ui * F.G; if (u >= 1024) break;
        const int bh = u >> 5, n = u & 31, b = bh >> 3, h = bh & 7; const size_t m0 = (size_t)b * SEQ + n * 64;
        const int i = 16 * it + fr;
        u32x4 sp1[4]; u32x2 graw[4]; f32x4 nwv[4];
        { u32x4 a0, a1, b0, b1, c0, c1, d0, d1, sp0[4]; const bf16_t* base = PROJ + m0 * PW + h * 128;
          HG_TILE_LDNT(a0, a1, base + C_FF); HG_TILE_LDNT(b0, b1, base + C_FB); HG_TILE_LDNT(c0, c1, base + C_QR); HG_TILE_LDNT(d0, d1, base + C_IN);
          const bf16_t* spa = SPREV + (size_t)(u * 2) * 16384;
#pragma unroll
          for (int q = 0; q < 4; ++q) { const int id = F.tid + NTHR * q; sp0[q] = __builtin_nontemporal_load((const u32x4*)(spa + (id >> 4) * 128 + (id & 15) * 8)); }
#pragma unroll
          for (int q = 0; q < 4; ++q) { const int id = F.tid + NTHR * q; sp1[q] = __builtin_nontemporal_load((const u32x4*)(spa + 16384 + (id >> 4) * 128 + (id & 15) * 8)); }
#pragma unroll
          for (int te = 0; te < 4; ++te) { graw[te] = *(const u32x2*)(PROJ + (m0 + i) * PW + C_GO + h * 128 + 64 * eh + 16 * te + 4 * fq); nwv[te] = *(const f32x4*)(F.hgrn_norm_w + h * 128 + 64 * eh + 16 * te + 4 * fq); }
          HG_TILE_ST(RZ0, a0, a1); HG_TILE_ST(RZ1, b0, b1); HG_TILE_ST(RQ, c0, c1); HG_TILE_ST(RV, d0, d1);
#pragma unroll
          for (int q = 0; q < 4; ++q) { const int id = F.tid + NTHR * q; *(LAS u32x4*)(SPL + (id >> 4) * 272 + (id & 15) * 16) = sp0[q]; } }
        __syncthreads();
        float qs[16];
        { float vv[16];
#pragma unroll
          for (int ii = 0; ii < 16; ++ii) { vv[ii] = bf2f(*(const LAS unsigned short*)(RV + (16 * seg + ii) * 272 + d * 2)); const float q = bf2f(*(const LAS unsigned short*)(RQ + (16 * seg + ii) * 272 + d * 2)); qs[ii] = q * fast_sigmoid(q); }
          pack16_store(VT + d * 144 + seg * 32, vv); }
        f32x4 o[4];
#pragma unroll
        for (int te = 0; te < 4; ++te) o[te] = (f32x4){0.f, 0.f, 0.f, 0.f};
#pragma unroll
        for (int dir = 0; dir < 2; ++dir) {
            float bb[16], kk[16], total; const float lb = hgrn_lower_bound(F.hgrn_lb, dir, h * 128 + d);
            if (dir == 0) gate_scan<0>(RZ0, lb, SEG, d, seg, bb, kk, total); else gate_scan<1>(RZ1, lb, SEG, d, seg, bb, kk, total);
#pragma unroll
            for (int ii = 0; ii < 16; ++ii) { const int ir = 16 * seg + ii;
                *(LAS unsigned short*)(QD + ir * 272 + d * 2) = f2bf(qs[ii] * fexp(bb[ii]));
                *(LAS unsigned short*)(KD + ir * 272 + d * 2) = f2bf(kk[ii] * fexp(-bb[ii])); }
            if (dir == 1) {
#pragma unroll
                for (int q = 0; q < 4; ++q) { const int id = F.tid + NTHR * q; *(LAS u32x4*)(SPL + (id >> 4) * 272 + (id & 15) * 16) = sp1[q]; } }
            __syncthreads();
#pragma unroll
            for (int jj = 0; jj < 2; ++jj) { const int jt = 2 * eh + jj; f32x4 sacc = {0.f, 0.f, 0.f, 0.f};
#pragma unroll
                for (int ks = 0; ks < 4; ++ks) { const bf16x8 a = *(const LAS bf16x8*)(KD + (16 * jt + fr) * 272 + (ks * 4 + fq) * 16), bq = *(const LAS bf16x8*)(QD + (16 * it + fr) * 272 + (ks * 4 + fq) * 16);
                    sacc = __builtin_amdgcn_mfma_f32_16x16x32_bf16(a, bq, sacc, 0, 0, 0); }
                const int j0 = 16 * jt + 4 * fq; float pv[4];
#pragma unroll
                for (int r = 0; r < 4; ++r) { const int j = j0 + r; const bool keep = dir == 0 ? (j <= i) : (j >= i); pv[r] = keep ? sacc[r] : 0.f; }
                u32x2 w; w.x = cvt_pk_bf16(pv[0], pv[1]); w.y = cvt_pk_bf16(pv[2], pv[3]);
                *(LAS u32x2*)(PP + i * 144 + j0 * 2) = w; }
            __syncthreads();
#pragma unroll
            for (int ks = 0; ks < 2; ++ks) { const bf16x8 bp = *(const LAS bf16x8*)(PP + (16 * it + fr) * 144 + (ks * 4 + fq) * 16);
#pragma unroll
                for (int te = 0; te < 4; ++te) { const bf16x8 a = *(const LAS bf16x8*)(VT + (64 * eh + 16 * te + fr) * 144 + (ks * 4 + fq) * 16);
                    o[te] = __builtin_amdgcn_mfma_f32_16x16x32_bf16(a, bp, o[te], 0, 0, 0); } }
#pragma unroll
            for (int ks = 0; ks < 4; ++ks) { const bf16x8 bq = *(const LAS bf16x8*)(QD + (16 * it + fr) * 272 + (ks * 4 + fq) * 16);
#pragma unroll
                for (int te = 0; te < 4; ++te) { const bf16x8 a = *(const LAS bf16x8*)(SPL + (64 * eh + 16 * te + fr) * 272 + (ks * 4 + fq) * 16);
                    o[te] = __builtin_amdgcn_mfma_f32_16x16x32_bf16(a, bq, o[te], 0, 0, 0); } }
            __syncthreads();
        }
        float ss = 0.f;
#pragma unroll
        for (int te = 0; te < 4; ++te) ss += (o[te][0] * o[te][0] + o[te][1] * o[te][1]) + (o[te][2] * o[te][2] + o[te][3] * o[te][3]);
        ss += __shfl_xor(ss, 16); ss += __shfl_xor(ss, 32);
        if (fq == 0) SSQ[eh * 64 + i] = ss;
        __syncthreads();
        const float rs = __builtin_amdgcn_rsqf((SSQ[i] + SSQ[64 + i]) * (1.f / 128.f) + EPS);
#pragma unroll
        for (int te = 0; te < 4; ++te) { const int e = 64 * eh + 16 * te + 4 * fq; const f32x4 nw = nwv[te];
            const float g0 = bflo(graw[te].x), g1 = bfhi(graw[te].x), g2 = bflo(graw[te].y), g3 = bfhi(graw[te].y);
            u32x2 w; w.x = cvt_pk_bf16(o[te][0] * rs * nw[0] * g0 * fast_sigmoid(g0), o[te][1] * rs * nw[1] * g1 * fast_sigmoid(g1));
            w.y = cvt_pk_bf16(o[te][2] * rs * nw[2] * g2 * fast_sigmoid(g2), o[te][3] * rs * nw[3] * g3 * fast_sigmoid(g3));
            *(u32x2*)(MIXED + (m0 + i) * DM + 1024 + h * 128 + e) = w; }
        __syncthreads();
    }
}

__device__ __forceinline__ void p7_post_mixer(Frame& F) {
    const float* mod = (const float*)(F.ws + WS_MOD); const bf16_t* Y1 = (const bf16_t*)(F.ws + WS_Y1); bf16_t* X1 = (bf16_t*)(F.ws + WS_X1); unsigned char* H2 = F.ws + WS_H2;
    const bf16_t* WRH = (const bf16_t*)(F.ws + WS_WRT); const bf16_t* WRL = WRH + 32 * 2048;
    int* SLOT = (int*)(F.ws + WS_ROUTE + RT_SLOT); float* SGATE = (float*)(F.ws + WS_ROUTE + RT_SGATE); unsigned* ECNT = (unsigned*)(F.ws + WS_CTL + CTL_ECNT); unsigned char* XS = F.ws + WS_XS;
    LAS unsigned char* HTH = F.lds; LAS unsigned char* HTL = F.lds + 65792;
    LAS float* RED = (LAS float*)(F.lds + 131584); LAS float* LOG = (LAS float*)(F.lds + 147968); LAS int* LE = (LAS int*)(F.lds + 152064); LAS int* LR = LE + 128; LAS float* LG = (LAS float*)(LR + 128); LAS int* EB = (LAS int*)(LG + 128);
    const int fr = F.lane & 15, fq = F.lane >> 4;
    for (int rt = F.bid; rt < 256; rt += F.G) {
        const int b = rt >> 6; const float* mb = mod + (size_t)b * 12288;
        for (int pass = 0; pass < 2; ++pass) {
            for (int rr = 0; rr < 2; ++rr) { const int lr = 2 * F.wave + rr, row = rt * 32 + pass * 16 + lr;
                const f32x4* xr = (const f32x4*)(F.x + (size_t)row * DM) + F.lane; const u32x2* yr = (const u32x2*)(Y1 + (size_t)row * DM) + F.lane;
                f32x4 v[8]; float s = 0.f;
#pragma unroll
                for (int j = 0; j < 8; ++j) { const f32x4 g1 = *((const f32x4*)(mb + 4096) + F.lane + 64 * j); const u32x2 yw = yr[64 * j]; const f32x4 yv = {bflo(yw.x), bfhi(yw.x), bflo(yw.y), bfhi(yw.y)}; v[j] = __builtin_nontemporal_load(xr + 64 * j) * DN_ALPHA + g1 * yv; s += (v[j][0] + v[j][1]) + (v[j][2] + v[j][3]); }
                float mean = wave_sum(s) * (1.f / DM), s2 = 0.f;
#pragma unroll
                for (int j = 0; j < 8; ++j) { v[j] = v[j] - mean; s2 += (v[j][0] * v[j][0] + v[j][1] * v[j][1]) + (v[j][2] * v[j][2] + v[j][3] * v[j][3]); }
                float rstd = __builtin_amdgcn_rsqf(wave_sum(s2) * (1.f / DM) + EPS);
                s = 0.f;
                f32x4 pg[8], pb[8];
#pragma unroll
                for (int j = 0; j < 8; ++j) { pg[j] = *((const f32x4*)F.ln1_g + F.lane + 64 * j); pb[j] = *((const f32x4*)F.ln1_b + F.lane + 64 * j); }
#pragma unroll
                for (int j = 0; j < 8; ++j) { const f32x4 g = pg[j], bb = pb[j];
                    v[j] = v[j] * rstd * g + bb; { u32x2 xw; xw.x = cvt_pk_bf16(v[j][0], v[j][1]); xw.y = cvt_pk_bf16(v[j][2], v[j][3]); __builtin_nontemporal_store(xw, (u32x2*)(X1 + (size_t)row * DM) + F.lane + 64 * j); } s += (v[j][0] + v[j][1]) + (v[j][2] + v[j][3]); }
                mean = wave_sum(s) * (1.f / DM); s2 = 0.f;
#pragma unroll
                for (int j = 0; j < 8; ++j) { v[j] = v[j] - mean; s2 += (v[j][0] * v[j][0] + v[j][1] * v[j][1]) + (v[j][2] * v[j][2] + v[j][3] * v[j][3]); }
                rstd = __builtin_amdgcn_rsqf(wave_sum(s2) * (1.f / DM) + EPS);
#pragma unroll
                for (int j = 0; j < 8; ++j) { pg[j] = *((const f32x4*)(mb + 6144) + F.lane + 64 * j); pb[j] = *((const f32x4*)(mb + 8192) + F.lane + 64 * j); }
#pragma unroll
                for (int j = 0; j < 8; ++j) { const f32x4 sh = pg[j], sc = pb[j];
                    const f32x4 h = v[j] * rstd * (sc + 1.f) + sh;
                    u32x2 wh; wh.x = cvt_pk_bf16(h[0], h[1]); wh.y = cvt_pk_bf16(h[2], h[3]);
                    u32x2 wl; wl.x = cvt_pk_bf16(h[0] - bflo(wh.x), h[1] - bfhi(wh.x)); wl.y = cvt_pk_bf16(h[2] - bflo(wh.y), h[3] - bfhi(wh.y));
                    *((unsigned*)(H2 + (size_t)row * DM) + F.lane + 64 * j) = pk4_fp8(h[0], h[1], h[2], h[3]);
                    *(LAS u32x2*)(HTH + lr * 4112 + (4 * F.lane + 256 * j) * 2) = wh; *(LAS u32x2*)(HTL + lr * 4112 + (4 * F.lane + 256 * j) * 2) = wl; }
            }
            __syncthreads();
            { f32x4 acc[2] = {{0.f, 0.f, 0.f, 0.f}, {0.f, 0.f, 0.f, 0.f}};
#pragma unroll 2
              for (int ks = 0; ks < 8; ++ks) { const int k0 = 256 * F.wave + 32 * ks + 8 * fq;
                  const bf16x8 ah = *(const LAS bf16x8*)(HTH + fr * 4112 + k0 * 2), al = *(const LAS bf16x8*)(HTL + fr * 4112 + k0 * 2);
#pragma unroll
                  for (int et = 0; et < 2; ++et) { const bf16x8 bh = *(const bf16x8*)(WRH + (size_t)(et * 16 + fr) * 2048 + k0), bl = *(const bf16x8*)(WRL + (size_t)(et * 16 + fr) * 2048 + k0);
                      acc[et] = __builtin_amdgcn_mfma_f32_16x16x32_bf16(ah, bh, acc[et], 0, 0, 0);
                      acc[et] = __builtin_amdgcn_mfma_f32_16x16x32_bf16(al, bh, acc[et], 0, 0, 0);
                      acc[et] = __builtin_amdgcn_mfma_f32_16x16x32_bf16(ah, bl, acc[et], 0, 0, 0); } }
#pragma unroll
              for (int et = 0; et < 2; ++et)
#pragma unroll
                  for (int j = 0; j < 4; ++j) RED[(F.wave * 16 + 4 * fq + j) * 32 + et * 16 + fr] = acc[et][j]; }
            __syncthreads();
            { const int tok = F.tid >> 5, e = F.tid & 31; float s = F.b_router[e];
#pragma unroll
              for (int w = 0; w < 8; ++w) s += RED[(w * 16 + tok) * 32 + e];
              LOG[(pass * 16 + tok) * 32 + e] = s; }
            __syncthreads();
        }
        if (F.tid < 32) { const int t = rt * 32 + F.tid; unsigned taken = 0u; float tv[4]; int tix[4];
#pragma unroll
            for (int k = 0; k < 4; ++k) { float best = -3.0e38f; int bi = 0;
                for (int e = 0; e < 32; ++e) { const float v = LOG[F.tid * 32 + e]; if (!((taken >> e) & 1u) && v > best) { best = v; bi = e; } }
                taken |= 1u << bi; tv[k] = best; tix[k] = bi; }
            float ex[4], sum = 0.f;
#pragma unroll
            for (int k = 0; k < 4; ++k) { ex[k] = __expf(tv[k] - tv[0]); sum += ex[k]; }
            const float inv = 1.f / sum;
#pragma unroll
            for (int k = 0; k < 4; ++k) { LG[F.tid * 4 + k] = ex[k] * inv; LE[F.tid * 4 + k] = tix[k]; } }
        __syncthreads();
        if (F.tid < 32) { int cnt = 0; for (int a = 0; a < 128; ++a) if (LE[a] == F.tid) { LR[a] = cnt; ++cnt; }
            EB[F.tid] = cnt > 0 ? (int)__hip_atomic_fetch_add(ECNT + F.tid, (unsigned)cnt, __ATOMIC_RELAXED, __HIP_MEMORY_SCOPE_AGENT) : 0; }
        asm volatile("s_waitcnt vmcnt(0)" ::: "memory");
        __syncthreads();
        if (F.tid < 128) { const int e = LE[F.tid], slot = e * ECAP + EB[e] + LR[F.tid]; SLOT[rt * 128 + F.tid] = slot; SGATE[slot] = LG[F.tid]; LE[F.tid] = slot; }
        __syncthreads();
        { u32x4 rv[4][2];
#pragma unroll
          for (int i = 0; i < 4; ++i) { const u32x4* src = (const u32x4*)(H2 + (size_t)(rt * 32 + F.wave * 4 + i) * DM) + F.lane; rv[i][0] = __builtin_nontemporal_load(src); rv[i][1] = __builtin_nontemporal_load(src + 64); }
#pragma unroll
          for (int i = 0; i < 4; ++i)
#pragma unroll
              for (int k = 0; k < 4; ++k) { u32x4* dst = (u32x4*)(XS + (size_t)LE[(F.wave * 4 + i) * 4 + k] * DM) + F.lane; dst[0] = rv[i][0]; dst[64] = rv[i][1]; } }
        __syncthreads();
    }
}

__device__ __forceinline__ void route_tables(Frame& F) {
    const unsigned* ECNT = (const unsigned*)(F.ws + WS_CTL + CTL_ECNT); LAS int* tab = (LAS int*)(F.lds + LDS_TAB_OFF);
    __syncthreads();
    if (F.tid < 32) tab[F.tid] = (int)ECNT[F.tid];
    __syncthreads();
    if (F.tid == 0) { int t = 0;
        for (int g = 0; g < 8; ++g) {
            for (int j = 0; j < 4; ++j) { const int cnt = tab[4 * g + j], nt = (cnt + 255) >> 8, hf = (nt > 0 && cnt - (nt - 1) * 256 <= 128) ? 1 : 0; tab[64 + 8 * g + j] = t; t += nt - hf; }
            for (int j = 0; j < 4; ++j) { const int cnt = tab[4 * g + j], nt = (cnt + 255) >> 8, hf = (nt > 0 && cnt - (nt - 1) * 256 <= 128) ? 1 : 0; tab[64 + 8 * g + 4 + j] = t; t += hf; } }
        tab[128] = t; }
    __syncthreads();
}
__device__ __forceinline__ void p11_final(Frame& F) {
    const float* mod = (const float*)(F.ws + WS_MOD); const bf16_t* X1 = (const bf16_t*)(F.ws + WS_X1); const unsigned char* YB = F.ws + WS_YB; const int* SLOT = (const int*)(F.ws + WS_ROUTE + RT_SLOT);
    for (int row = F.bid * NWAVES + F.wave; row < MTOK; row += F.G * NWAVES) {
        const int b = row >> 11; const float* g2p = mod + (size_t)b * 12288 + 10240;
        const int s0 = SLOT[row * 4 + 0], s1 = SLOT[row * 4 + 1], s2i = SLOT[row * 4 + 2], s3 = SLOT[row * 4 + 3];
        const unsigned* y0 = (const unsigned*)(YB + (size_t)s0 * DM) + F.lane; const unsigned* y1 = (const unsigned*)(YB + (size_t)s1 * DM) + F.lane;
        const unsigned* y2 = (const unsigned*)(YB + (size_t)s2i * DM) + F.lane; const unsigned* y3 = (const unsigned*)(YB + (size_t)s3 * DM) + F.lane;
        const u32x2* xr = (const u32x2*)(X1 + (size_t)row * DM) + F.lane;
        f32x4 v[8]; float s = 0.f;
#pragma unroll
        for (int j = 0; j < 8; ++j) { const int a = (int)y0[64 * j], bq = (int)y1[64 * j], c = (int)y2[64 * j], dq = (int)y3[64 * j];
            const f32x2 a0 = __builtin_amdgcn_cvt_pk_f32_fp8(a, false), a1 = __builtin_amdgcn_cvt_pk_f32_fp8(a, true), b0 = __builtin_amdgcn_cvt_pk_f32_fp8(bq, false), b1 = __builtin_amdgcn_cvt_pk_f32_fp8(bq, true);
            const f32x2 c0 = __builtin_amdgcn_cvt_pk_f32_fp8(c, false), c1 = __builtin_amdgcn_cvt_pk_f32_fp8(c, true), d0 = __builtin_amdgcn_cvt_pk_f32_fp8(dq, false), d1 = __builtin_amdgcn_cvt_pk_f32_fp8(dq, true);
            f32x4 y; y[0] = ((a0.x + b0.x) + (c0.x + d0.x)) * (1.f / YB_SCALE); y[1] = ((a0.y + b0.y) + (c0.y + d0.y)) * (1.f / YB_SCALE);
            y[2] = ((a1.x + b1.x) + (c1.x + d1.x)) * (1.f / YB_SCALE); y[3] = ((a1.y + b1.y) + (c1.y + d1.y)) * (1.f / YB_SCALE);
            const f32x4 g2 = *((const f32x4*)g2p + F.lane + 64 * j);
            const u32x2 xw = xr[64 * j]; const f32x4 xv = {bflo(xw.x), bfhi(xw.x), bflo(xw.y), bfhi(xw.y)};
            v[j] = xv * DN_ALPHA + g2 * y; s += (v[j][0] + v[j][1]) + (v[j][2] + v[j][3]); }
        const float mean = wave_sum(s) * (1.f / DM); float s2 = 0.f;
#pragma unroll
        for (int j = 0; j < 8; ++j) { v[j] = v[j] - mean; s2 += (v[j][0] * v[j][0] + v[j][1] * v[j][1]) + (v[j][2] * v[j][2] + v[j][3] * v[j][3]); }
        const float rstd = __builtin_amdgcn_rsqf(wave_sum(s2) * (1.f / DM) + EPS);
        f32x4 pg[8], pb[8];
#pragma unroll
        for (int j = 0; j < 8; ++j) { pg[j] = *((const f32x4*)F.ln2_g + F.lane + 64 * j); pb[j] = *((const f32x4*)F.ln2_b + F.lane + 64 * j); }
#pragma unroll
        for (int j = 0; j < 8; ++j) __builtin_nontemporal_store(v[j] * rstd * pg[j] + pb[j], (f32x4*)(F.out + (size_t)row * DM) + F.lane + 64 * j);
    }
}

constexpr int NPHASE = 12;
struct Args { const float* in[21]; float* out; unsigned char* ws; int ph_lo, ph_hi; };
__global__ void __launch_bounds__(NTHR, 2) mega_fwd(Args args) {
    extern __shared__ __attribute__((aligned(16))) unsigned char lds_raw[];
    typedef const __attribute__((address_space(4))) Args* KArgP;
#define MKFRAME() Frame F; { int t_ = threadIdx.x; asm volatile("" : "+v"(t_)); KArgP ap = (KArgP)__builtin_amdgcn_kernarg_segment_ptr(); asm volatile("" : "+s"(ap)); \
    F.lds = (LAS unsigned char*)lds_raw; F.tid = t_; F.lane = t_ & 63; F.wave = __builtin_amdgcn_readfirstlane(t_ >> 6); F.G = gridDim.x; F.bid = blockIdx.x; \
    F.x = ap->in[0]; F.c = ap->in[1]; F.w_ada = ap->in[2]; F.b_ada = ap->in[3]; F.w_in = ap->in[4]; F.q_norm_w = ap->in[5]; F.k_norm_w = ap->in[6]; F.attn_norm_w = ap->in[7]; \
    F.hgrn_lb = ap->in[8]; F.hgrn_norm_w = ap->in[9]; F.w_out = ap->in[10]; F.ln1_g = ap->in[11]; F.ln1_b = ap->in[12]; F.w_router = ap->in[13]; F.b_router = ap->in[14]; \
    F.w1 = ap->in[15]; F.b1 = ap->in[16]; F.w2 = ap->in[17]; F.b2 = ap->in[18]; F.ln2_g = ap->in[19]; F.ln2_b = ap->in[20]; F.out = ap->out; F.ws = ap->ws; }
    for (int u = threadIdx.x; u < (LDS_BYTES - LDS_CTL_OFF) / 4; u += NTHR) ((LAS unsigned*)((LAS unsigned char*)lds_raw + LDS_CTL_OFF))[u] = 0u;
    __syncthreads();
#if MK_SPLIT
#define GRID_BAR() do { } while (0)
#else
    (void)xcd_barrier_post((unsigned*)(args.ws + WS_CTL) + 1024, (volatile LAS unsigned*)((LAS unsigned char*)lds_raw + LDS_CTL_OFF));
#define GRID_BAR() do { KArgP bp_ = (KArgP)__builtin_amdgcn_kernarg_segment_ptr(); asm volatile("" : "+s"(bp_)); XcdBarrier b_; b_.bar = (unsigned*)(bp_->ws + WS_CTL) + 1024; b_.x = xb_xcc_id(); b_.st = (volatile LAS unsigned*)((LAS unsigned char*)lds_raw + LDS_CTL_OFF); xcd_barrier(b_); } while (0)
#endif
#ifndef PH_MASK
#define PH_MASK 0xFFF
#endif
#define IN(k) ((((PH_MASK) >> (k)) & 1) && args.ph_lo <= (k) && (k) < args.ph_hi)
#define SEAM(k) do { if (IN(k) && IN((k) + 1 + ((k) == 7 ? 1 : 0))) GRID_BAR(); } while (0)
#define SG() (((int)blockIdx.x >> 3) & 3)
    if (IN(0)) { MKFRAME(); p0_adaln(F); p0_router_w(F); conv_items<false>(F, 0, 1088); conv_items<true>(F, CV0, CV_P2); } SEAM(0);
    if (IN(1)) { MKFRAME(); p1_ln_mod(F); } SEAM(1);
    if (IN(2)) { MKFRAME(); const int sg = SG(); pg8::PlainSched<4096> S; S.init(F.ws + WS_H, F.ws + WS_WIN_T, MTOK, PW, F.G, F.bid); pg8::EpiBf16Plain E{(bf16_t*)(F.ws + WS_PROJ), PW};
        S.window(0, sg); pg8::gemm_phase<pg8::EpiBf16Plain, pg8::PlainSched<4096>, false>(F.lds, S, E);
        conv_pipe<false>(F, CV_P2, CV_P2T);
        S.window(sg, 1 << 20); pg8::gemm_phase<pg8::EpiBf16Plain, pg8::PlainSched<4096>, false>(F.lds, S, E);
        { const int full = S.nwg / F.G, rem = S.nwg - full * F.G;
          if (rem > 0 && F.bid >= rem) conv_pipe<false>(F, CV_P2T, CV_P3, F.bid - rem, F.G - rem);
          else if (rem == 0) conv_pipe<false>(F, CV_P2T, CV_P3); } } SEAM(2);
    if (IN(3)) { MKFRAME(); const int sg = SG(); p3_kprep(F); p3_hgrn_u(F, 0, sg); conv_items<true>(F, CV_P3, CV_P4); p3_hgrn_u(F, sg, 1 << 20); } SEAM(3);
    if (IN(4)) { { MKFRAME(); if (SG() < 2) { conv_pipe<false>(F, CV_P4, CV_P5); p4_scan(F); } }
        { MKFRAME();
        const bf16_t* PROJ = (const bf16_t*)(F.ws + WS_PROJ); const bf16_t* KV = (const bf16_t*)(F.ws + WS_KV); bf16_t* MIXED = (bf16_t*)(F.ws + WS_MIXED);
        for (int u = F.bid; u < 256; u += F.G) { const int qb = u & 7, h = (u >> 3) & 7, b = u >> 6, kvh = h >> 2; const size_t m0 = (size_t)b * SEQ + qb * 256;
            att::attn_unit(PROJ + m0 * PW + C_Q + h * 128, KV + (size_t)b * SEQ * 512 + kvh * 128, KV + (size_t)b * SEQ * 512 + 256 + kvh * 128,
                           MIXED + m0 * DM + h * 128, F.q_norm_w, F.attn_norm_w + h * 128, qb * 256, SEQ, (char*)lds_raw); } }
        { MKFRAME(); if (SG() >= 2) { conv_pipe<false>(F, CV_P4, CV_P5); p4_scan(F); } }
    } SEAM(4);
    if (IN(5)) { MKFRAME(); const int sg = SG(); p5_hgrn_out(F, 0, sg); conv_items<true>(F, CV_P5, CV_P6); p5_hgrn_out(F, sg, 1 << 20); } SEAM(5);
    if (IN(6)) { MKFRAME(); const int sg = SG(); pg8::PlainSched<4096> S; S.init(F.ws + WS_MIXED, F.ws + WS_WOUT_T, MTOK, DM, F.G, F.bid); pg8::EpiBf16Plain E{(bf16_t*)(F.ws + WS_Y1), DM};
        if (sg < 2) conv_items<true>(F, CV_P6, CV_W2);
        pg8::gemm_phase<pg8::EpiBf16Plain, pg8::PlainSched<4096>, false>(F.lds, S, E);
        if (sg >= 2) conv_items<true>(F, CV_P6, CV_W2); } SEAM(6);
    if (IN(7)) { MKFRAME(); p7_post_mixer(F); } SEAM(7);
    if (IN(9)) { MKFRAME(); const int sg = SG(); route_tables(F); pg8::MoeSched<2048> S; S.init(F.ws + WS_XS, F.ws + WS_W1T, (const LAS int*)(F.lds + LDS_TAB_OFF) + 64, 16, F.G, F.bid);
        pg8::EpiSwiglu E{F.ws + WS_ACT, F.b1};
        const int rem9 = S.nwg % F.G, nshort = (rem9 > 0) ? F.G - rem9 : 0;
        const int w2t = (nshort * 12 < CVQ_W2T) ? nshort * 12 : CVQ_W2T;
        const int sg8 = ((int)blockIdx.x >> 3) & 7;
        S.window(0, sg8); pg8::gemm_phase<pg8::EpiSwiglu, pg8::MoeSched<2048>, true>(F.lds, S, E);
        conv_pipe<true>(F, CV_W2, CV_END - w2t);
        S.window(sg8, 1 << 20); pg8::gemm_phase<pg8::EpiSwiglu, pg8::MoeSched<2048>, true>(F.lds, S, E);
        if (w2t > 0 && F.bid >= rem9) conv_items<true>(F, CV_END - w2t, CV_END, F.bid - rem9, nshort); } SEAM(9);
    if (IN(10)) { MKFRAME(); route_tables(F); pg8::MoeSched<2048> S; S.init(F.ws + WS_ACT, F.ws + WS_W2T, (const LAS int*)(F.lds + LDS_TAB_OFF) + 64, 8, F.G, F.bid);
        pg8::EpiGate E{F.ws + WS_YB, F.b2, (const float*)(F.ws + WS_ROUTE + RT_SGATE)};
        pg8::gemm_phase<pg8::EpiGate, pg8::MoeSched<2048>, true>(F.lds, S, E); } SEAM(10);
    if (IN(11)) { MKFRAME(); p11_final(F); }
#undef IN
#undef SEAM
}

extern "C" void kernel_launch(void* const* d_in, const int* in_sizes, int n_in, void* d_out, int out_size, void* d_ws, size_t ws_size, hipStream_t stream) {
    static int grid = 0;
    if (grid == 0) {
        if (n_in != 21 || out_size != MTOK * DM || ws_size < WS_END) { fprintf(stderr, "kernel_launch: unexpected shapes (n_in %d out %d ws %zu, need ws >= %zu)\n", n_in, out_size, ws_size, (size_t)WS_END); grid = -1; return; }
        int dev = 0, cus = 0, per_cu = 0;
        if (hipGetDevice(&dev) != hipSuccess || hipDeviceGetAttribute(&cus, hipDeviceAttributeMultiprocessorCount, dev) != hipSuccess) { grid = -1; return; }
        if (hipFuncSetAttribute((const void*)mega_fwd, hipFuncAttributeMaxDynamicSharedMemorySize, LDS_BYTES) != hipSuccess) { fprintf(stderr, "kernel_launch: hipFuncSetAttribute failed\n"); grid = -1; return; }
        if (hipOccupancyMaxActiveBlocksPerMultiprocessor(&per_cu, (const void*)mega_fwd, NTHR, LDS_BYTES) != hipSuccess || per_cu < 1) { fprintf(stderr, "kernel_launch: occupancy query says %d\n", per_cu); (void)hipGetLastError(); }
        grid = cus;
    }
    if (grid < 0) return;
    (void)hipMemsetAsync((char*)d_ws + WS_CTL, 0, CTL_ZERO_BYTES, stream);
    Args a{};
    for (int i = 0; i < 21; ++i) a.in[i] = (const float*)d_in[i];
    a.out = (float*)d_out; a.ws = (unsigned char*)d_ws;
#if MK_SPLIT
#ifndef REP_MASK
#define REP_MASK 0
#endif
    for (int p = 0; p < NPHASE; ++p) { a.ph_lo = p; a.ph_hi = p + 1; hipLaunchKernelGGL(mega_fwd, dim3(grid), dim3(NTHR), LDS_BYTES, stream, a);
        if ((REP_MASK >> p) & 1) hipLaunchKernelGGL(mega_fwd, dim3(grid), dim3(NTHR), LDS_BYTES, stream, a); }
#else
    a.ph_lo = 0; a.ph_hi = NPHASE; hipLaunchKernelGGL(mega_fwd, dim3(grid), dim3(NTHR), LDS_BYTES, stream, a);
#endif
    const hipError_t le = hipPeekAtLastError();
    if (le != hipSuccess) fprintf(stderr, "kernel_launch: launch failed: %s\n", hipGetErrorName(le));
}
```
